# Optimizing an MI355X kernel written in HIP

```python
import math
import jax, jax.numpy as jnp
from jax import lax
import numpy as np

D_MODEL = 4096
BATCH = 2
SEQ = 4096
DEPTH = 4

N_MIXERS = 2
ROPE_THETA = 500000.0
EPS = 1e-6
Q_BLOCK = 128
D_FF = 4 * D_MODEL
PLE_DIM = 256

DIFF_HEAD_DIM = 128
DIFF_HEADS = D_MODEL // (2 * DIFF_HEAD_DIM)
DIFF_ROT = DIFF_HEAD_DIM // 4
DIFF_QK_WIDTH = DIFF_HEADS * 2 * DIFF_HEAD_DIM
DIFF_V_WIDTH = DIFF_HEADS * 2 * DIFF_HEAD_DIM
DIFF_IN_WIDTH = 2 * DIFF_QK_WIDTH + DIFF_V_WIDTH

MLA_HEADS = 32
MLA_NOPE = 128
MLA_ROPE = 64
MLA_V = 128
MLA_QK = MLA_NOPE + MLA_ROPE
MLA_Q_RANK = 1024
MLA_KV_RANK = 512
MLA_IN_WIDTH = MLA_Q_RANK + MLA_KV_RANK + MLA_ROPE

N_DIFF_LAYERS = (DEPTH + 1) // 2
N_MLA_LAYERS = DEPTH // 2

kernel_name = "hybrid_diffattn_mla_encoder"


def rms_norm(x, g):
    x32 = x.astype(jnp.float32)
    y = x32 * lax.rsqrt(jnp.mean(x32 * x32, axis=-1, keepdims=True) + EPS)
    return (y * g.astype(jnp.float32)).astype(x.dtype)


def rope_tables(positions, rot_dim):
    inv = ROPE_THETA ** (-jnp.arange(0, rot_dim, 2, dtype=jnp.float32) / rot_dim)
    ang = positions.astype(jnp.float32)[..., None] * inv
    return jnp.cos(ang), jnp.sin(ang)


def apply_rope(x, cos, sin):
    x32 = x.astype(jnp.float32)
    x1, x2 = jnp.split(x32, 2, axis=-1)
    out = jnp.concatenate([x1 * cos - x2 * sin, x2 * cos + x1 * sin], axis=-1)
    return out.astype(x.dtype)


def to_blocks(t):
    b, s = t.shape[0], t.shape[1]
    t = t.reshape((b, s // Q_BLOCK, Q_BLOCK) + t.shape[2:])
    return jnp.moveaxis(t, 1, 0)


def from_blocks(t):
    t = jnp.moveaxis(t, 0, 1)
    return t.reshape((t.shape[0], t.shape[1] * t.shape[2]) + t.shape[3:])


def diff_attention(h, w_in, w_out, g_q, g_k, lam, g_sub, cos, sin, lambda_init):
    b, s, _ = h.shape
    z = h @ w_in
    q, k, v = jnp.split(z, [DIFF_QK_WIDTH, 2 * DIFF_QK_WIDTH], axis=-1)
    q = q.reshape(b, s, DIFF_HEADS, 2, DIFF_HEAD_DIM)
    k = k.reshape(b, s, DIFF_HEADS, 2, DIFF_HEAD_DIM)
    v = v.reshape(b, s, DIFF_HEADS, 2 * DIFF_HEAD_DIM)
    c5 = cos[:, :, None, None, :]
    s5 = sin[:, :, None, None, :]
    q = rms_norm(q, g_q)
    k = rms_norm(k, g_k)
    q = jnp.concatenate([apply_rope(q[..., :DIFF_ROT], c5, s5), q[..., DIFF_ROT:]], axis=-1)
    k = jnp.concatenate([apply_rope(k[..., :DIFF_ROT], c5, s5), k[..., DIFF_ROT:]], axis=-1)
    lam32 = lam.astype(jnp.float32)
    lam_full = (jnp.exp(jnp.sum(lam32[0] * lam32[1]))
                - jnp.exp(jnp.sum(lam32[2] * lam32[3])) + lambda_init)
    scale = DIFF_HEAD_DIM ** -0.5

    def block(qb):
        sc = jnp.einsum('bqhcd,bkhcd->bhcqk', qb, k).astype(jnp.float32) * scale
        pr = jax.nn.softmax(sc, axis=-1)
        a = pr[:, :, 0] - lam_full * pr[:, :, 1]
        return jnp.einsum('bhqk,bkhe->bqhe', a.astype(v.dtype), v)

    o = from_blocks(lax.map(block, to_blocks(q)))
    o = rms_norm(o, g_sub) * (1.0 - lambda_init)
    return o.reshape(b, s, DIFF_V_WIDTH) @ w_out


def mla_attention(h, w_in, g_cq, g_ckv, w_uq, w_ukv, g_q, g_k, w_out, cos, sin):
    b, s, _ = h.shape
    z = h @ w_in
    c_q, c_kv, k_rope = jnp.split(z, [MLA_Q_RANK, MLA_Q_RANK + MLA_KV_RANK], axis=-1)
    q = (rms_norm(c_q, g_cq) @ w_uq).reshape(b, s, MLA_HEADS, MLA_QK)
    kv = (rms_norm(c_kv, g_ckv) @ w_ukv).reshape(b, s, MLA_HEADS, MLA_NOPE + MLA_V)
    k_nope, v = jnp.split(kv, [MLA_NOPE], axis=-1)
    q_nope = rms_norm(q[..., :MLA_NOPE], g_q[:MLA_NOPE])
    q_rope = rms_norm(q[..., MLA_NOPE:], g_q[MLA_NOPE:])
    k_nope = rms_norm(k_nope, g_k[:MLA_NOPE])
    k_rope = rms_norm(k_rope, g_k[MLA_NOPE:])
    q_rope = apply_rope(q_rope, cos[:, :, None, :], sin[:, :, None, :])
    k_rope = apply_rope(k_rope, cos, sin)
    q = jnp.concatenate([q_nope, q_rope], axis=-1)
    k = jnp.concatenate(
        [k_nope, jnp.broadcast_to(k_rope[:, :, None, :], (b, s, MLA_HEADS, MLA_ROPE))], axis=-1)
    scale = MLA_QK ** -0.5

    def block(qb):
        sc = jnp.einsum('bqhd,bkhd->bhqk', qb, k).astype(jnp.float32) * scale
        pr = jax.nn.softmax(sc, axis=-1).astype(v.dtype)
        return jnp.einsum('bhqk,bkhe->bqhe', pr, v)

    o = from_blocks(lax.map(block, to_blocks(q)))
    return o.reshape(b, s, MLA_HEADS * MLA_V) @ w_out


def sq_relu_mlp(h, w1, w2):
    a = jax.nn.relu(h @ w1)
    return (a * a) @ w2


def setup_inputs(seed: int = 0) -> dict:
    key = jax.random.key(seed)
    ks = jax.random.split(key, 24)
    f32 = jnp.float32

    def nrm(k, shape, fan_in):
        return jax.random.normal(k, shape, f32) * (fan_in ** -0.5)

    def gain(k, shape):
        return 1.0 + 0.01 * jax.random.normal(k, shape, f32)

    ND, NM = N_DIFF_LAYERS, N_MLA_LAYERS
    x = jax.random.normal(ks[0], (BATCH, SEQ, D_MODEL), f32)
    p = jax.random.normal(ks[1], (DEPTH, BATCH, SEQ, PLE_DIM), f32)
    positions = jnp.broadcast_to(jnp.arange(SEQ, dtype=jnp.int32), (BATCH, SEQ))
    return {
        "x": x,
        "p": p,
        "positions": positions,
        "g_mix": gain(ks[2], (DEPTH, D_MODEL)),
        "g_mlp": gain(ks[3], (DEPTH, D_MODEL)),
        "g_ple": gain(ks[4], (DEPTH, D_MODEL)),
        "w1": nrm(ks[5], (DEPTH, D_MODEL, D_FF), D_MODEL),
        "w2": nrm(ks[6], (DEPTH, D_FF, D_MODEL), D_FF),
        "w_gate": nrm(ks[7], (DEPTH, D_MODEL, D_MODEL), D_MODEL),
        "w_ple": nrm(ks[8], (DEPTH, PLE_DIM, D_MODEL), PLE_DIM),
        "diff_w_in": nrm(ks[9], (ND, D_MODEL, DIFF_IN_WIDTH), D_MODEL),
        "diff_w_out": nrm(ks[10], (ND, DIFF_V_WIDTH, D_MODEL), DIFF_V_WIDTH),
        "diff_g_q": gain(ks[11], (ND, DIFF_HEAD_DIM)),
        "diff_g_k": gain(ks[12], (ND, DIFF_HEAD_DIM)),
        "diff_lambda": 0.1 * jax.random.normal(ks[13], (ND, 4, DIFF_HEAD_DIM), f32),
        "diff_g_sub": gain(ks[14], (ND, 2 * DIFF_HEAD_DIM)),
        "mla_w_in": nrm(ks[15], (NM, D_MODEL, MLA_IN_WIDTH), D_MODEL),
        "mla_g_cq": gain(ks[16], (NM, MLA_Q_RANK)),
        "mla_g_ckv": gain(ks[17], (NM, MLA_KV_RANK)),
        "mla_w_uq": nrm(ks[18], (NM, MLA_Q_RANK, MLA_HEADS * MLA_QK), MLA_Q_RANK),
        "mla_w_ukv": nrm(ks[19], (NM, MLA_KV_RANK, MLA_HEADS * (MLA_NOPE + MLA_V)), MLA_KV_RANK),
        "mla_g_q": gain(ks[20], (NM, MLA_QK)),
        "mla_g_k": gain(ks[21], (NM, MLA_QK)),
        "mla_w_out": nrm(ks[22], (NM, MLA_HEADS * MLA_V, D_MODEL), MLA_HEADS * MLA_V),
    }


def reference(x, p, positions, g_mix, g_mlp, g_ple, w1, w2, w_gate, w_ple,
              diff_w_in, diff_w_out, diff_g_q, diff_g_k, diff_lambda, diff_g_sub,
              mla_w_in, mla_g_cq, mla_g_ckv, mla_w_uq, mla_w_ukv, mla_g_q, mla_g_k, mla_w_out):
    cos_d, sin_d = rope_tables(positions, DIFF_ROT)
    cos_m, sin_m = rope_tables(positions, MLA_ROPE)
    for i in range(DEPTH):
        j = i // N_MIXERS
        h = rms_norm(x, g_mix[i])
        if i % N_MIXERS == 0:
            lambda_init = 0.8 - 0.6 * math.exp(-0.3 * i)
            mix = diff_attention(h, diff_w_in[j], diff_w_out[j], diff_g_q[j], diff_g_k[j],
                                 diff_lambda[j], diff_g_sub[j], cos_d, sin_d, lambda_init)
        else:
            mix = mla_attention(h, mla_w_in[j], mla_g_cq[j], mla_g_ckv[j], mla_w_uq[j],
                                mla_w_ukv[j], mla_g_q[j], mla_g_k[j], mla_w_out[j], cos_m, sin_m)
        x = x + mix
        x = x + sq_relu_mlp(rms_norm(x, g_mlp[i]), w1[i], w2[i])
        gate = jax.nn.sigmoid(rms_norm(x, g_ple[i]) @ w_gate[i])
        x = x + gate * (p[i] @ w_ple[i])
    return x
```

```cpp
#include <hip/hip_runtime.h>
#include <cstdio>
#include <cstdint>
#define TIDTAB_LDS_OFF (151552 + 2048)
extern __shared__ __attribute__((aligned(16))) unsigned char tid_lds_alias[];
__device__ __forceinline__ unsigned hw_slot() { return (unsigned)__builtin_amdgcn_s_getreg((5 << 11) | 4) & 63u; }
__device__ __forceinline__ int my_tid() {
    const int wv = __builtin_amdgcn_readfirstlane(*(volatile __attribute__((address_space(3))) int*)((__attribute__((address_space(3))) unsigned char*)tid_lds_alias + TIDTAB_LDS_OFF + 4 * hw_slot()));
    int ln; asm volatile("v_mbcnt_lo_u32_b32 %0, -1, 0\n\tv_mbcnt_hi_u32_b32 %0, -1, %0" : "=v"(ln));
    return (wv << 6) | ln;
}
namespace pg8 {
#define PG8_LAS __attribute__((address_space(3)))
typedef unsigned short bf16_t;
typedef short bf16x8 __attribute__((ext_vector_type(8)));
typedef float f32x4 __attribute__((ext_vector_type(4)));
typedef unsigned u32x4 __attribute__((ext_vector_type(4)));
constexpr int BM = 256, BK = 64, HALF = 128, HTB = HALF * BK * 2  , STAGE_BYTES = 8 * HTB, NXCD = 8, WGM = 8;

__host__ __device__ __forceinline__ int lds_byte(int r, int c) { const int st = (r >> 4) * 2 + (c >> 5), rr = r & 15, cc = c & 31, ob = rr * 64 + cc * 2; return st * 1024 + (ob ^ (((ob >> 9) & 1) << 5)); }
__host__ __device__ __forceinline__ void stage_rc(int b, int& R, int& C) { const int st = b / 1024, sb = b % 1024, swz = sb ^ (((sb >> 9) & 1) << 5); R = (st >> 1) * 16 + swz / 64; C = (st & 1) * 32 + (swz % 64) / 2; }
__host__ __device__ __forceinline__ int perm32(int rho) { const int n = rho >> 4, i = rho & 15; return 8 * (i >> 2) + 4 * n + (i & 3); }

struct Unit { int pm, pn; };
struct Gemm { const bf16_t* A; const bf16_t* Bt; int M, N, K; };

struct StaticOrder {
    int nM, nN, nwg, G, c;
    __host__ __device__ void init(int M, int N, int G_, int c_) { nM = M / BM; nN = N / BM; nwg = nM * nN; G = G_; c = c_; }
    __host__ __device__ bool next(int i, Unit& u) const {
        const long L = (long)i * G + c; if (L >= nwg) return false;
        int wgid = (int)L; { const int q = nwg / NXCD, r = nwg % NXCD, xcd = wgid % NXCD, off = wgid / NXCD; wgid = (xcd < r ? xcd * (q + 1) : r * (q + 1) + (xcd - r) * q) + off; }
        const int nig = WGM * nN, gid = wgid / nig, fm = gid * WGM, gsz = (nM - fm) < WGM ? (nM - fm) : WGM;
        u.pm = fm + ((wgid % nig) % gsz); u.pn = (wgid % nig) / gsz; return true;
    }
    __device__ __forceinline__ void a_ready(const Unit&) const {}
    __device__ __forceinline__ void done(const Unit&) const {}
};
__device__ __forceinline__ unsigned cvt_pk_bf16(float lo, float hi) { unsigned r; asm volatile("v_cvt_pk_bf16_f32 %0, %1, %2" : "=v"(r) : "v"(lo), "v"(hi)); return r; }
typedef float f32x2 __attribute__((ext_vector_type(2)));
template <int M> __device__ __forceinline__ float xshfl(float v) { static_assert(M == 1 || M == 2 || M == 4 || M == 8 || M == 16, "xor mask");
    return __builtin_bit_cast(float, __builtin_amdgcn_ds_swizzle(__builtin_bit_cast(int, v), (M << 10) | 0x1f)); }
__device__ __forceinline__ float xadd32(float v) { const unsigned u = __builtin_bit_cast(unsigned, v); auto r = __builtin_amdgcn_permlane32_swap(u, u, false, false);
    return __builtin_bit_cast(float, (unsigned)r[0]) + __builtin_bit_cast(float, (unsigned)r[1]); }
__device__ __forceinline__ float xswap32(float v, int lane) { const unsigned u = __builtin_bit_cast(unsigned, v); auto r = __builtin_amdgcn_permlane32_swap(u, u, false, false);
    return __builtin_bit_cast(float, (unsigned)(lane < 32 ? r[1] : r[0])); }
__device__ __forceinline__ float row_rstd(const float* ss, int row, int fq) {
    const f32x4* p = (const f32x4*)(ss + (size_t)row * 64 + fq * 16); const f32x4 a = p[0], b = p[1], c = p[2], d = p[3];
    float s = (((a[0] + a[1]) + (a[2] + a[3])) + ((b[0] + b[1]) + (b[2] + b[3]))) + (((c[0] + c[1]) + (c[2] + c[3])) + ((d[0] + d[1]) + (d[2] + d[3])));
    s += xshfl<16>(s); s = xadd32(s);
    return 1.0f / sqrtf(s * (1.f / 4096.f) + 1e-6f);
}
struct RowScale { const PG8_LAS float* tab; int pm_tab; const float* ss;
    __device__ __forceinline__ float get(const Unit& u, int rloc, int fq) const { return (u.pm == pm_tab) ? tab[rloc] : __builtin_nanf(""); } };
template <int ACT, bool RS> struct EpiBf16 {
    static constexpr bool PERM = true, AFTER_DRAIN = false;
    bf16_t* O; int ldc; RowScale rsc;
    __device__ __forceinline__ void operator()(const f32x4 (&acc)[2][2][4][2], const Unit& u, int wr, int wc, int fr, int fq) const {
        const int row0 = u.pm * BM + wr * 64 + fr, col0 = u.pn * BM + wc * 32 + 8 * fq;
#pragma unroll
        for (int ai = 0; ai < 2; ++ai)
#pragma unroll
            for (int m = 0; m < 4; ++m) { bf16_t* rowp = O + (size_t)(row0 + ai * HALF + m * 16) * ldc + col0;
                float rs = 1.f; if (RS) rs = rsc.get(u, wr * 64 + fr + ai * HALF + m * 16, fq);
#pragma unroll
                for (int bj = 0; bj < 2; ++bj) { f32x4 v0 = acc[ai][bj][m][0], v1 = acc[ai][bj][m][1];
                    if (RS) { v0 = v0 * rs; v1 = v1 * rs; }
                    if (ACT == 1) {
#pragma unroll
                        for (int j = 0; j < 4; ++j) { const float a = fmaxf(v0[j], 0.f), b = fmaxf(v1[j], 0.f); v0[j] = a * a; v1[j] = b * b; } }
                    u32x4 w; w.x = cvt_pk_bf16(v0[0], v0[1]); w.y = cvt_pk_bf16(v0[2], v0[3]); w.z = cvt_pk_bf16(v1[0], v1[1]); w.w = cvt_pk_bf16(v1[2], v1[3]);
                    *(u32x4*)(rowp + bj * HALF) = w; } }
    }
};
struct EpiF32 {
    static constexpr bool PERM = false, AFTER_DRAIN = false;
    float* C; int ldc; RowScale rsc;
    __device__ __forceinline__ void operator()(const f32x4 (&acc)[2][2][4][2], const Unit& u, int wr, int wc, int fr, int fq) const {
        const int row0 = u.pm * BM + wr * 64 + fr, col0 = u.pn * BM + wc * 32 + 4 * fq;
#pragma unroll
        for (int ai = 0; ai < 2; ++ai)
#pragma unroll
            for (int m = 0; m < 4; ++m) { float* rowp = C + (size_t)(row0 + ai * HALF + m * 16) * ldc + col0; const float rs = rsc.get(u, wr * 64 + fr + ai * HALF + m * 16, fq);
#pragma unroll
                for (int bj = 0; bj < 2; ++bj)
#pragma unroll
                    for (int n = 0; n < 2; ++n) *(f32x4*)(rowp + bj * HALF + n * 16) = acc[ai][bj][m][n] * rs; }
    }
};
typedef unsigned u32x2e __attribute__((ext_vector_type(2)));
struct EpiRes {
    static constexpr bool PERM = false, AFTER_DRAIN = false;
    const float* base; float* out; int ldc; bf16_t* xb; float* ssout;
    __device__ __forceinline__ void operator()(const f32x4 (&acc)[2][2][4][2], const Unit& u, int wr, int wc, int fr, int fq) const {
        const int row0 = u.pm * BM + wr * 64 + fr, col0 = u.pn * BM + wc * 32 + 4 * fq;
#pragma unroll
        for (int aim = 0; aim < 4; ++aim) { const int ai = aim >> 1, mh = aim & 1;
            f32x4 bs[2][2][2];
#pragma unroll
            for (int mm = 0; mm < 2; ++mm) { const int m = 2 * mh + mm; const size_t off = (size_t)(row0 + ai * HALF + m * 16) * ldc + col0;
#pragma unroll
                for (int bj = 0; bj < 2; ++bj)
#pragma unroll
                    for (int n = 0; n < 2; ++n) bs[mm][bj][n] = *(const f32x4*)(base + off + bj * HALF + n * 16); }
            asm volatile("" ::: "memory");
#pragma unroll
            for (int mm = 0; mm < 2; ++mm) { const int m = 2 * mh + mm; const size_t off = (size_t)(row0 + ai * HALF + m * 16) * ldc + col0;
                float q = 0.f;
#pragma unroll
                for (int bj = 0; bj < 2; ++bj)
#pragma unroll
                    for (int n = 0; n < 2; ++n) { const f32x4 o = bs[mm][bj][n] + acc[ai][bj][m][n]; *(f32x4*)(out + off + bj * HALF + n * 16) = o;
                        q += (o[0] * o[0] + o[1] * o[1]) + (o[2] * o[2] + o[3] * o[3]);
                        u32x2e w; w.x = cvt_pk_bf16(o[0], o[1]); w.y = cvt_pk_bf16(o[2], o[3]); *(u32x2e*)(xb + off + bj * HALF + n * 16) = w; }
                q += xshfl<16>(q); q = xadd32(q);
                if (fq == 0) ssout[(size_t)(row0 + ai * HALF + m * 16) * 64 + u.pn * 4 + wc] = q; }
            asm volatile("" ::: "memory"); }
    }
};
struct EpiGate {
    static constexpr bool PERM = false, AFTER_DRAIN = false;
    const float* base; float* out; const bf16_t* ple; int ldc; RowScale rsc; bf16_t* xb; float* ssout;
    __device__ __forceinline__ void operator()(const f32x4 (&acc)[2][2][4][2], const Unit& u, int wr, int wc, int fr, int fq) const {
        typedef unsigned u32x2v __attribute__((ext_vector_type(2)));
        const int row0 = u.pm * BM + wr * 64 + fr, col0 = u.pn * BM + wc * 32 + 4 * fq;
#pragma unroll
        for (int aim = 0; aim < 4; ++aim) { const int ai = aim >> 1, mh = aim & 1;
            f32x4 bs[2][2][2]; u32x2v pl[2][2][2];
#pragma unroll
            for (int mm = 0; mm < 2; ++mm) { const int m = 2 * mh + mm; const size_t off = (size_t)(row0 + ai * HALF + m * 16) * ldc + col0;
#pragma unroll
                for (int bj = 0; bj < 2; ++bj)
#pragma unroll
                    for (int n = 0; n < 2; ++n) { bs[mm][bj][n] = *(const f32x4*)(base + off + bj * HALF + n * 16); pl[mm][bj][n] = *(const u32x2v*)(ple + off + bj * HALF + n * 16); } }
            asm volatile("" ::: "memory");
#pragma unroll
            for (int mm = 0; mm < 2; ++mm) { const int m = 2 * mh + mm; const size_t off = (size_t)(row0 + ai * HALF + m * 16) * ldc + col0;
                const float rs = rsc.get(u, wr * 64 + fr + ai * HALF + m * 16, fq) * -1.4426950408889634f; float q = 0.f;
#pragma unroll
                for (int bj = 0; bj < 2; ++bj)
#pragma unroll
                    for (int n = 0; n < 2; ++n) { const f32x4 a = acc[ai][bj][m][n] * rs; f32x4 o; const u32x2v pw = pl[mm][bj][n]; const f32x4 b = bs[mm][bj][n];
                        const float p0 = __uint_as_float(pw.x << 16), p1 = __uint_as_float(pw.x & 0xffff0000u), p2 = __uint_as_float(pw.y << 16), p3 = __uint_as_float(pw.y & 0xffff0000u);
                        o[0] = b[0] + p0 * __builtin_amdgcn_rcpf(1.f + __builtin_amdgcn_exp2f(a[0]));
                        o[1] = b[1] + p1 * __builtin_amdgcn_rcpf(1.f + __builtin_amdgcn_exp2f(a[1]));
                        o[2] = b[2] + p2 * __builtin_amdgcn_rcpf(1.f + __builtin_amdgcn_exp2f(a[2]));
                        o[3] = b[3] + p3 * __builtin_amdgcn_rcpf(1.f + __builtin_amdgcn_exp2f(a[3]));
                        *(f32x4*)(out + off + bj * HALF + n * 16) = o;
                        q += (o[0] * o[0] + o[1] * o[1]) + (o[2] * o[2] + o[3] * o[3]);
                        u32x2e w; w.x = cvt_pk_bf16(o[0], o[1]); w.y = cvt_pk_bf16(o[2], o[3]); *(u32x2e*)(xb + off + bj * HALF + n * 16) = w; }
                q += xshfl<16>(q); q = xadd32(q);
                if (fq == 0) ssout[(size_t)(row0 + ai * HALF + m * 16) * 64 + u.pn * 4 + wc] = q; }
            asm volatile("" ::: "memory"); }
    }
};


__device__ __forceinline__ void unpack_bf8(const u32x4 r, float (&x)[8]) { x[0] = __uint_as_float(r.x << 16); x[1] = __uint_as_float(r.x & 0xffff0000u); x[2] = __uint_as_float(r.y << 16); x[3] = __uint_as_float(r.y & 0xffff0000u);
    x[4] = __uint_as_float(r.z << 16); x[5] = __uint_as_float(r.z & 0xffff0000u); x[6] = __uint_as_float(r.w << 16); x[7] = __uint_as_float(r.w & 0xffff0000u); }
struct EpiResB {
    static constexpr bool PERM = true, AFTER_DRAIN = false;
    const bf16_t* xin; bf16_t* xout; int ldc; float* ssout; unsigned char* x8; float asc;
    __device__ __forceinline__ void operator()(const f32x4 (&acc)[2][2][4][2], const Unit& u, int wr, int wc, int fr, int fq) const {
        const int row0 = u.pm * BM + wr * 64 + fr, col0 = u.pn * BM + wc * 32 + 8 * fq;
#pragma unroll
        for (int ai = 0; ai < 2; ++ai) {
            u32x4 bs[4][2];
#pragma unroll
            for (int m = 0; m < 4; ++m)
#pragma unroll
                for (int bj = 0; bj < 2; ++bj) bs[m][bj] = *(const u32x4*)(xin + (size_t)(row0 + ai * HALF + m * 16) * ldc + col0 + bj * HALF);
            asm volatile("" ::: "memory");
#pragma unroll
            for (int m = 0; m < 4; ++m) { const size_t off = (size_t)(row0 + ai * HALF + m * 16) * ldc + col0; float q = 0.f;
#pragma unroll
                for (int bj = 0; bj < 2; ++bj) { float b[8]; unpack_bf8(bs[m][bj], b); const f32x4 a0 = acc[ai][bj][m][0], a1 = acc[ai][bj][m][1];
                    const float o0 = b[0] + a0[0] * asc, o1 = b[1] + a0[1] * asc, o2 = b[2] + a0[2] * asc, o3 = b[3] + a0[3] * asc, o4 = b[4] + a1[0] * asc, o5 = b[5] + a1[1] * asc, o6 = b[6] + a1[2] * asc, o7 = b[7] + a1[3] * asc;
                    q += ((o0 * o0 + o1 * o1) + (o2 * o2 + o3 * o3)) + ((o4 * o4 + o5 * o5) + (o6 * o6 + o7 * o7));
                    u32x4 w; w.x = cvt_pk_bf16(o0, o1); w.y = cvt_pk_bf16(o2, o3); w.z = cvt_pk_bf16(o4, o5); w.w = cvt_pk_bf16(o6, o7); *(u32x4*)(xout + off + bj * HALF) = w;
                    if (x8) { int e0 = 0, e1 = 0; e0 = __builtin_amdgcn_cvt_pk_fp8_f32(o0, o1, e0, false); e0 = __builtin_amdgcn_cvt_pk_fp8_f32(o2, o3, e0, true); e1 = __builtin_amdgcn_cvt_pk_fp8_f32(o4, o5, e1, false); e1 = __builtin_amdgcn_cvt_pk_fp8_f32(o6, o7, e1, true);
                        u32x2e w8; w8.x = (unsigned)e0; w8.y = (unsigned)e1; *(u32x2e*)(x8 + off + bj * HALF) = w8; } }
                q += xshfl<16>(q); q = xadd32(q);
                if (fq == 0) ssout[(size_t)(row0 + ai * HALF + m * 16) * 64 + u.pn * 4 + wc] = q; }
            asm volatile("" ::: "memory"); }
    }
};
template <bool FINAL> struct EpiGateB {
    static constexpr bool PERM = true, AFTER_DRAIN = false;
    const bf16_t* xin; const bf16_t* ple; int ldc; RowScale rsc; bf16_t* xout; float* ssout; float* fout; float asc;
    __device__ __forceinline__ void operator()(const f32x4 (&acc)[2][2][4][2], const Unit& u, int wr, int wc, int fr, int fq) const {
        const int row0 = u.pm * BM + wr * 64 + fr, col0 = u.pn * BM + wc * 32 + 8 * fq;
#pragma unroll
        for (int aim = 0; aim < 4; ++aim) { const int ai = aim >> 1, mh = aim & 1;
            u32x4 bs[2][2], pl[2][2];
#pragma unroll
            for (int mm = 0; mm < 2; ++mm)
#pragma unroll
                for (int bj = 0; bj < 2; ++bj) { const size_t o_ = (size_t)(row0 + ai * HALF + (2 * mh + mm) * 16) * ldc + col0 + bj * HALF; bs[mm][bj] = *(const u32x4*)(xin + o_); pl[mm][bj] = *(const u32x4*)(ple + o_); }
            asm volatile("" ::: "memory");
#pragma unroll
            for (int mm = 0; mm < 2; ++mm) { const int m = 2 * mh + mm; const size_t off = (size_t)(row0 + ai * HALF + m * 16) * ldc + col0;
                const float rs = rsc.get(u, wr * 64 + fr + ai * HALF + m * 16, fq) * -1.4426950408889634f * asc; float q = 0.f;
#pragma unroll
                for (int bj = 0; bj < 2; ++bj) { float b[8], p[8], o[8]; unpack_bf8(bs[mm][bj], b); unpack_bf8(pl[mm][bj], p); const f32x4 a0 = acc[ai][bj][m][0] * rs, a1 = acc[ai][bj][m][1] * rs;
#pragma unroll
                    for (int j = 0; j < 4; ++j) { o[j] = b[j] + p[j] * __builtin_amdgcn_rcpf(1.f + __builtin_amdgcn_exp2f(a0[j])); o[4 + j] = b[4 + j] + p[4 + j] * __builtin_amdgcn_rcpf(1.f + __builtin_amdgcn_exp2f(a1[j])); }
                    if (FINAL) { *(f32x4*)(fout + off + bj * HALF) = (f32x4){o[0], o[1], o[2], o[3]}; *(f32x4*)(fout + off + bj * HALF + 4) = (f32x4){o[4], o[5], o[6], o[7]}; }
                    else { q += ((o[0] * o[0] + o[1] * o[1]) + (o[2] * o[2] + o[3] * o[3])) + ((o[4] * o[4] + o[5] * o[5]) + (o[6] * o[6] + o[7] * o[7]));
                        u32x4 w; w.x = cvt_pk_bf16(o[0], o[1]); w.y = cvt_pk_bf16(o[2], o[3]); w.z = cvt_pk_bf16(o[4], o[5]); w.w = cvt_pk_bf16(o[6], o[7]); *(u32x4*)(xout + off + bj * HALF) = w; } }
                if (!FINAL) { q += xshfl<16>(q); q = xadd32(q);
                    if (fq == 0) ssout[(size_t)(row0 + ai * HALF + m * 16) * 64 + u.pn * 4 + wc] = q; } }
            asm volatile("" ::: "memory"); }
    }
};


template <int MODE> struct EpiKN {
    static constexpr bool PERM = true, AFTER_DRAIN = false;
    bf16_t* O; int ldc; RowScale rsc; const float* gk; const float* cs; const float* sn; PG8_LAS float* xt;
    __device__ __forceinline__ void operator()(const f32x4 (&acc)[2][2][4][2], const Unit& u, int wr, int wc, int fr, int fq) const {
        int frl = fr; asm volatile("" : "+v"(frl));
        const int col0 = u.pn * BM + wc * 32 + 8 * fq;
        const bool kn = (MODE == 0) ? true : (u.pn >= 16 && u.pn < 32);
        constexpr int NBJ = (MODE == 0) ? 1 : 2;
        if (kn) {
#pragma unroll
            for (int ai = 0; ai < 2; ++ai)
#pragma unroll
                for (int m = 0; m < 4; ++m) { const int rl = wr * 64 + frl + ai * HALF + m * 16; float rs = 1.f; if (MODE == 1) rs = rsc.get(u, rl, fq);
#pragma unroll
                    for (int bj = 0; bj < NBJ; ++bj) { const f32x4 a0 = acc[ai][bj][m][0] * rs, a1 = acc[ai][bj][m][1] * rs;
                        float q = ((a0[0] * a0[0] + a0[1] * a0[1]) + (a0[2] * a0[2] + a0[3] * a0[3])) + ((a1[0] * a1[0] + a1[1] * a1[1]) + (a1[2] * a1[2] + a1[3] * a1[3]));
                        q += xshfl<16>(q); q = xadd32(q);
                        if (fq == 0) xt[(rl * 2 + bj) * 4 + wc] = q; } }
            asm volatile("s_waitcnt lgkmcnt(0)" ::: "memory"); __builtin_amdgcn_s_barrier(); asm volatile("" ::: "memory");
        }
#pragma unroll
        for (int ai = 0; ai < 2; ++ai)
#pragma unroll
            for (int m = 0; m < 4; ++m) { const int rl = wr * 64 + frl + ai * HALF + m * 16; bf16_t* rowp = O + (size_t)(u.pm * BM + rl) * ldc + col0;
                float rs = 1.f; if (MODE == 1) rs = rsc.get(u, rl, fq);
                float c8[8], s8[8];
                if (MODE == 1 && kn && wc == 0) { const f32x4 c0 = *(const f32x4*)(cs + (size_t)(u.pm * BM + rl) * 16 + 8 * (fq & 1)), c1 = *(const f32x4*)(cs + (size_t)(u.pm * BM + rl) * 16 + 8 * (fq & 1) + 4);
                    const f32x4 s0 = *(const f32x4*)(sn + (size_t)(u.pm * BM + rl) * 16 + 8 * (fq & 1)), s1 = *(const f32x4*)(sn + (size_t)(u.pm * BM + rl) * 16 + 8 * (fq & 1) + 4);
#pragma unroll
                    for (int t = 0; t < 4; ++t) { c8[t] = c0[t]; c8[4 + t] = c1[t]; s8[t] = s0[t]; s8[4 + t] = s1[t]; } }
#pragma unroll
                for (int bj = 0; bj < 2; ++bj) { float v[8]; { const f32x4 a0 = acc[ai][bj][m][0] * rs, a1 = acc[ai][bj][m][1] * rs;
#pragma unroll
                        for (int t = 0; t < 4; ++t) { v[t] = a0[t]; v[4 + t] = a1[t]; } }
                    if (kn && bj < NBJ) { const f32x4 p = *(const PG8_LAS f32x4*)(xt + (rl * 2 + bj) * 4); const float hr = __builtin_amdgcn_rsqf(((p[0] + p[1]) + (p[2] + p[3])) * (1.f / 128.f) + 1e-6f);
                        const f32x4 g0 = *(const f32x4*)(gk + wc * 32 + 8 * fq), g1 = *(const f32x4*)(gk + wc * 32 + 8 * fq + 4);
#pragma unroll
                        for (int t = 0; t < 4; ++t) { v[t] = v[t] * hr * g0[t]; v[4 + t] = v[4 + t] * hr * g1[t]; }
                        if (MODE == 1 && wc == 0) {
#pragma unroll
                            for (int t = 0; t < 8; ++t) { const float pr = xswap32(v[t], fq * 16 + frl); v[t] = (fq < 2) ? v[t] * c8[t] - pr * s8[t] : v[t] * c8[t] + pr * s8[t]; } } }
                    u32x4 w; w.x = cvt_pk_bf16(v[0], v[1]); w.y = cvt_pk_bf16(v[2], v[3]); w.z = cvt_pk_bf16(v[4], v[5]); w.w = cvt_pk_bf16(v[6], v[7]);
                    *(u32x4*)(rowp + bj * HALF) = w; }
                asm volatile("" ::: "memory"); }
    }
};
#ifndef STAGE_OFF32
#define STAGE_OFF32 1
#endif
typedef int i32x4g __attribute__((ext_vector_type(4)));
typedef int i32x8g __attribute__((ext_vector_type(8)));
template <class Epi, class Sched, bool ALIGN_EPI = false, bool SP2 = false, bool F8 = false>
__device__ __forceinline__ void gemm_phase(PG8_LAS unsigned char* lds, const Gemm g, const Sched& S, const Epi& E) {
    int tid = my_tid(); asm volatile("" : "+v"(tid));
    const int wid = __builtin_amdgcn_readfirstlane(tid >> 6), lane = tid & 63, wr = wid >> 2, wc = wid & 3, fr = lane & 15, fq = lane >> 4;
    const int K = g.K, nt = K / BK;
    unsigned voffA[2], voffB[2];
#pragma unroll
    for (int i = 0; i < 2; ++i) { int R, C; stage_rc(tid * 16 + i * 8192, R, C); const int Rb = Epi::PERM ? ((R & ~31) + perm32(R & 31)) : R;
        voffA[i] = (unsigned)(R * K + C) * 2u; voffB[i] = (unsigned)(Rb * K + C) * 2u; }
    const size_t kstep = (size_t)(BK * 2);
    const size_t hstep = (size_t)HALF * K * 2;
    const size_t tstep = 2 * hstep;
    const unsigned ldsw = (unsigned)wid * 1024u;
    const int aoff = lds_byte(wr * 64 + fr, fq * 8), boff = lds_byte(wc * 32 + fr, fq * 8);
#define PG8_SA(b, h) (((b) * 2 + (h)) * HTB)
#define PG8_SB(b, h) ((4 + (b) * 2 + (h)) * HTB)
#define PG8_STAGE(bufoff, gbase, voff) do { _Pragma("unroll") for (int _i = 0; _i < 2; ++_i) { unsigned vo_ = (voff)[_i]; if (F8 || STAGE_OFF32) asm volatile("" : "+v"(vo_));   \
        __builtin_amdgcn_global_load_lds((const unsigned*)((const char*)(gbase) + vo_), (PG8_LAS unsigned*)(lds + (bufoff) + ldsw + _i * 8192), 16, 0, 0); } } while (0)
#define PG8_LDA(dst, b, h) do { _Pragma("unroll") for (int m = 0; m < 4; ++m) _Pragma("unroll") for (int k = 0; k < 2; ++k) dst[m][k] = *(const PG8_LAS bf16x8*)(lds + PG8_SA(b, h) + aoff + m * 2048 + k * 1024); } while (0)
#define PG8_LDB(dst, b, h) do { _Pragma("unroll") for (int n = 0; n < 2; ++n) _Pragma("unroll") for (int k = 0; k < 2; ++k) dst[n][k] = *(const PG8_LAS bf16x8*)(lds + PG8_SB(b, h) + boff + n * 2048 + k * 1024); } while (0)
#define PG8_MMA(ai, bj, At, Bt) do { __builtin_amdgcn_s_setprio(1); \
      if constexpr (F8) { _Pragma("unroll") for (int m = 0; m < 4; ++m) _Pragma("unroll") for (int n = 0; n < 2; ++n) { \
          const i32x8g a8_ = __builtin_shufflevector(__builtin_bit_cast(i32x4g, At[m][0]), __builtin_bit_cast(i32x4g, At[m][1]), 0, 1, 2, 3, 4, 5, 6, 7), b8_ = __builtin_shufflevector(__builtin_bit_cast(i32x4g, Bt[n][0]), __builtin_bit_cast(i32x4g, Bt[n][1]), 0, 1, 2, 3, 4, 5, 6, 7); \
          acc[ai][bj][m][n] = __builtin_amdgcn_mfma_scale_f32_16x16x128_f8f6f4(b8_, a8_, acc[ai][bj][m][n], 0, 0, 0, 0, 0, 0); } } \
      else { _Pragma("unroll") for (int m = 0; m < 4; ++m) _Pragma("unroll") for (int n = 0; n < 2; ++n) _Pragma("unroll") for (int k = 0; k < 2; ++k) \
        acc[ai][bj][m][n] = __builtin_amdgcn_mfma_f32_16x16x32_bf16(Bt[n][k], At[m][k], acc[ai][bj][m][n], 0, 0, 0); } \
      __builtin_amdgcn_s_setprio(0); } while (0)
#define PG8_WAIT_V(n) asm volatile("s_waitcnt vmcnt(" #n ")" ::: "memory")
#define PG8_WAIT_L(n) asm volatile("s_waitcnt lgkmcnt(" #n ")" ::: "memory")
#define PG8_BAR __builtin_amdgcn_s_barrier()
#define PG8_SCHED __builtin_amdgcn_sched_barrier(0)
    Unit cur, nxt; int ui = 0;
    if (!S.next(0, cur)) return;
    f32x4 acc[2][2][4][2];
#pragma unroll
    for (int a = 0; a < 2; ++a)
#pragma unroll
        for (int b = 0; b < 2; ++b)
#pragma unroll
            for (int m = 0; m < 4; ++m)
#pragma unroll
                for (int n = 0; n < 2; ++n) acc[a][b][m][n] = (f32x4){0.f, 0.f, 0.f, 0.f};
    bf16x8 At[4][2], B0[2][2], B1[2][2];
    const char* cA = (const char*)g.A + (size_t)cur.pm * tstep; const char* cB = (const char*)g.Bt + (size_t)cur.pn * tstep;
    S.a_ready(cur);
    if constexpr (SP2) {
        PG8_STAGE(PG8_SB(0, 0), cB, voffB); PG8_STAGE(PG8_SB(0, 1), cB + hstep, voffB); PG8_STAGE(PG8_SA(0, 0), cA, voffA); PG8_STAGE(PG8_SA(0, 1), cA + hstep, voffA);
        if (wr == 1) PG8_BAR;
        PG8_WAIT_V(2); PG8_BAR;
        PG8_STAGE(PG8_SB(1, 0), cB + kstep, voffB); PG8_STAGE(PG8_SA(1, 0), cA + kstep, voffA); PG8_STAGE(PG8_SB(1, 1), cB + hstep + kstep, voffB);
        PG8_WAIT_V(6); PG8_BAR;
    } else {
        PG8_STAGE(PG8_SB(0, 0), cB, voffB); PG8_STAGE(PG8_SA(0, 0), cA, voffA); PG8_STAGE(PG8_SB(0, 1), cB + hstep, voffB); PG8_STAGE(PG8_SA(0, 1), cA + hstep, voffA);
        if (wr == 1) PG8_BAR;
        PG8_WAIT_V(4); PG8_BAR;
        PG8_STAGE(PG8_SB(1, 0), cB + kstep, voffB); PG8_STAGE(PG8_SA(1, 0), cA + kstep, voffA); PG8_STAGE(PG8_SB(1, 1), cB + hstep + kstep, voffB);
        PG8_WAIT_V(6); PG8_BAR;
    }
    for (;;) {
        const bool has_next = S.next(ui + 1, nxt);
        const char* nA = has_next ? (const char*)g.A + (size_t)nxt.pm * tstep : cA; const char* nB = has_next ? (const char*)g.Bt + (size_t)nxt.pn * tstep : cB;
        for (int t = 0; t < nt; t += 2) {
            const bool last = (t == nt - 2);
            const char* a1 = cA + (size_t)(t + 1) * kstep;
            const char* a2 = last ? nA : cA + (size_t)(t + 2) * kstep; const char* b2 = last ? nB : cB + (size_t)(t + 2) * kstep;
            const char* a3 = a2 + kstep; const char* b3 = b2 + kstep;
            if (last && has_next) S.a_ready(nxt);
            if constexpr (SP2) {
            PG8_LDB(B0, 0, 0); PG8_LDB(B1, 0, 1); PG8_SCHED; PG8_LDA(At, 0, 0); PG8_STAGE(PG8_SA(1, 1), a1 + hstep, voffA);
            PG8_WAIT_V(8); PG8_WAIT_L(0); PG8_BAR; PG8_MMA(0, 0, At, B0); PG8_MMA(0, 1, At, B1); PG8_BAR; PG8_SCHED;
            PG8_LDA(At, 0, 1); PG8_STAGE(PG8_SB(0, 0), b2, voffB); PG8_STAGE(PG8_SB(0, 1), b2 + hstep, voffB); PG8_STAGE(PG8_SA(0, 0), a2, voffA);
            PG8_WAIT_V(8); PG8_WAIT_L(0); PG8_BAR; PG8_MMA(1, 0, At, B0); PG8_MMA(1, 1, At, B1); PG8_BAR; PG8_SCHED;
            PG8_LDB(B0, 1, 0); PG8_LDB(B1, 1, 1); PG8_SCHED; PG8_LDA(At, 1, 0); PG8_STAGE(PG8_SA(0, 1), a2 + hstep, voffA);
            PG8_WAIT_V(8); PG8_WAIT_L(0); PG8_BAR; PG8_MMA(0, 0, At, B0); PG8_MMA(0, 1, At, B1); PG8_BAR; PG8_SCHED;
            PG8_LDA(At, 1, 1); PG8_STAGE(PG8_SB(1, 0), b3, voffB); PG8_STAGE(PG8_SB(1, 1), b3 + hstep, voffB); PG8_STAGE(PG8_SA(1, 0), a3, voffA);
            PG8_WAIT_V(8); PG8_WAIT_L(0); PG8_BAR; PG8_MMA(1, 0, At, B0); PG8_MMA(1, 1, At, B1); PG8_BAR; PG8_SCHED;
            } else {
            PG8_LDB(B0, 0, 0); PG8_SCHED; PG8_LDA(At, 0, 0); PG8_STAGE(PG8_SA(1, 1), a1 + hstep, voffA);
            PG8_WAIT_L(8); PG8_BAR; PG8_WAIT_L(0); PG8_MMA(0, 0, At, B0); PG8_BAR; PG8_SCHED;
            PG8_LDB(B1, 0, 1); PG8_STAGE(PG8_SB(0, 0), b2, voffB);
            PG8_BAR; PG8_WAIT_L(0); PG8_MMA(0, 1, At, B1); PG8_BAR;
            PG8_LDA(At, 0, 1); PG8_STAGE(PG8_SA(0, 0), a2, voffA);
            PG8_BAR; PG8_WAIT_L(0); PG8_MMA(1, 0, At, B0); PG8_BAR; PG8_SCHED;
            PG8_STAGE(PG8_SB(0, 1), b2 + hstep, voffB);
            PG8_WAIT_V(6); PG8_BAR; PG8_MMA(1, 1, At, B1); PG8_BAR;
            PG8_LDB(B0, 1, 0); PG8_SCHED; PG8_LDA(At, 1, 0); PG8_STAGE(PG8_SA(0, 1), a2 + hstep, voffA);
            PG8_WAIT_L(8); PG8_BAR; PG8_WAIT_L(0); PG8_MMA(0, 0, At, B0); PG8_BAR; PG8_SCHED;
            PG8_LDB(B1, 1, 1); PG8_STAGE(PG8_SB(1, 0), b3, voffB);
            PG8_BAR; PG8_WAIT_L(0); PG8_MMA(0, 1, At, B1); PG8_BAR;
            PG8_LDA(At, 1, 1); PG8_STAGE(PG8_SA(1, 0), a3, voffA);
            PG8_BAR; PG8_WAIT_L(0); PG8_MMA(1, 0, At, B0); PG8_BAR; PG8_SCHED;
            PG8_STAGE(PG8_SB(1, 1), b3 + hstep, voffB);
            PG8_WAIT_V(6); PG8_BAR; PG8_MMA(1, 1, At, B1); PG8_BAR;
            }
        }
        if constexpr (ALIGN_EPI) { if (wr == 0) PG8_BAR; }
        if constexpr (!Epi::AFTER_DRAIN) { int te_ = my_tid(); asm volatile("" : "+v"(te_));
            E(acc, cur, wr, wc, te_ & 15, (te_ >> 4) & 3); S.done(cur); }
        if (!has_next) break;
#pragma unroll
        for (int a = 0; a < 2; ++a)
#pragma unroll
            for (int b = 0; b < 2; ++b)
#pragma unroll
                for (int m = 0; m < 4; ++m)
#pragma unroll
                    for (int n = 0; n < 2; ++n) acc[a][b][m][n] = (f32x4){0.f, 0.f, 0.f, 0.f};
        cur = nxt; cA = nA; cB = nB; ++ui;
        if constexpr (ALIGN_EPI) { if (wr == 1) PG8_BAR; }
    }
    PG8_WAIT_V(0);
    if constexpr (!ALIGN_EPI) { if (wr == 0) PG8_BAR; }
    PG8_BAR;
    if constexpr (Epi::AFTER_DRAIN) { E.fused(acc, cur, wr, wc, fr, fq, lds, wid, lane); S.done(cur); }
#undef PG8_SA
#undef PG8_SB
#undef PG8_STAGE
#undef PG8_LDA
#undef PG8_LDB
#undef PG8_MMA
#undef PG8_WAIT_V
#undef PG8_WAIT_L
#undef PG8_BAR
#undef PG8_SCHED
}
}
#ifndef ATT_STAGGER
#define ATT_STAGGER 1
#endif
#ifndef MLA_STAGGER
#define MLA_STAGGER 0
#endif
#ifndef PV_LA
#define PV_LA 2
#endif
#ifndef ATT_STATIC_PRIO
#define ATT_STATIC_PRIO 0
#endif
#ifndef QK_FRESH_ADDR
#define QK_FRESH_ADDR 0
#endif
#ifndef SM_GUARD
#define SM_GUARD 1
#endif
#ifndef SM_NOSHIFT
#define SM_NOSHIFT 1
#endif
namespace att {
typedef unsigned short bf16_t;
using bf16x8 = __attribute__((ext_vector_type(8))) short;
using s16x4  = __attribute__((ext_vector_type(4))) short;
using f32x16 = __attribute__((ext_vector_type(16))) float;
using u32x4  = __attribute__((ext_vector_type(4))) unsigned;
constexpr int D = 128, NW = 8, QBLK = 32, KVBLK = 64;
constexpr int SHM_V = KVBLK * D * 2, SHM_K = KVBLK * D * 2, SHM_KR = KVBLK * 64 * 2;
constexpr int OFF_V = 0, OFF_K = 2 * SHM_V, OFF_KR = OFF_K + 2 * SHM_K, OFF_WS = OFF_KR + 2 * SHM_KR, OFF_QR = OFF_WS + NW * 64 * 4, LDS_BYTES = OFF_QR + NW * 4096;
constexpr float THR = 8.f;
#define KX(row) ((((row) & 3) << 2) | (((row) >> 2) & 3))
#define KSWZ(row, colB) ((row) * 256 + ((colB) ^ (KX(row) << 4)))
#define KRX(row) (((row) >> 1) & 7)
#define KRSWZ(row, colB) ((row) * 128 + ((colB) ^ (KRX(row) << 4)))
#define SBAR() __builtin_amdgcn_sched_barrier(0)
__device__ __forceinline__ int crow(int r, int hi) { return (r & 3) + 8 * (r >> 2) + 4 * hi; }
__device__ __forceinline__ unsigned cvtpk(float lo, float hi) {
  unsigned r; asm volatile("v_cvt_pk_bf16_f32 %0, %1, %2" : "=v"(r) : "v"(lo), "v"(hi)); return r;
}
template <class Cfg>
__device__ __forceinline__ void partialSM(f32x16& p0, f32x16& p1, float& m_reg, float& mn, float& alpha) {
  constexpr float C = Cfg::SCALE * 1.4426950408889634f;
  float pmax = p0[0];
#pragma unroll
  for (int r = 1; r < 16; ++r) pmax = fmaxf(pmax, p0[r]);
#pragma unroll
  for (int r = 0; r < 16; ++r) pmax = fmaxf(pmax, p1[r]);
  { auto rr = __builtin_amdgcn_permlane32_swap(__float_as_uint(pmax), __float_as_uint(pmax), false, false);
    pmax = fmaxf(__uint_as_float(rr[0]), __uint_as_float(rr[1])); }
  if (__builtin_expect(__all(pmax - m_reg <= THR / Cfg::SCALE), 1)) { mn = m_reg; alpha = 1.f; }
  else { mn = fmaxf(m_reg, pmax); alpha = __builtin_amdgcn_exp2f((m_reg - mn) * C); m_reg = mn; }
  float mnC = -mn * C;
#pragma unroll
  for (int r = 0; r < 16; ++r) p0[r] = fmaf(p0[r], C, mnC);
#pragma unroll
  for (int r = 0; r < 16; ++r) p1[r] = fmaf(p1[r], C, mnC);
#pragma unroll
  for (int r = 0; r < 16; ++r) p0[r] = __builtin_amdgcn_exp2f(p0[r]);
}
template <class Cfg>
__device__ __forceinline__ void partialSM_ns(f32x16& p0, f32x16& p1, float& m_reg, float& mn, float& alpha) {
  mn = m_reg; alpha = 1.f; SBAR();
#if SM_GUARD
  if (__builtin_expect(m_reg != 0.f, 0)) {
#pragma unroll
    for (int r = 0; r < 16; ++r) { p0[r] -= m_reg; p1[r] -= m_reg; } }
#endif
#pragma unroll
  for (int r = 0; r < 16; ++r) p0[r] = __builtin_amdgcn_exp2f(p0[r]);
}
template <bool NS = false> __device__ __forceinline__ void finishSM(f32x16& p0, f32x16& p1, float alpha, float& l_reg, bf16x8& pa0, bf16x8& pa1, bf16x8& pa2, bf16x8& pa3) {
#pragma unroll
  for (int r = 0; r < 16; ++r) p1[r] = __builtin_amdgcn_exp2f(p1[r]);
  float ps = 0;
#pragma unroll
  for (int r = 0; r < 16; ++r) ps += p0[r];
#pragma unroll
  for (int r = 0; r < 16; ++r) ps += p1[r];
  if constexpr (NS) l_reg += ps;
  else { auto rr = __builtin_amdgcn_permlane32_swap(__float_as_uint(ps), __float_as_uint(ps), false, false);
    ps = __uint_as_float(rr[0]) + __uint_as_float(rr[1]);
    l_reg = l_reg * alpha + ps; }
#define PK4(P, BASE, OUT) do { unsigned a0 = cvtpk(P[BASE + 0], P[BASE + 1]), a1 = cvtpk(P[BASE + 2], P[BASE + 3]);   \
    unsigned b0 = cvtpk(P[BASE + 4], P[BASE + 5]), b1 = cvtpk(P[BASE + 6], P[BASE + 7]);                              \
    auto r0 = __builtin_amdgcn_permlane32_swap(a0, b0, false, false); auto r1 = __builtin_amdgcn_permlane32_swap(a1, b1, false, false); \
    u32x4 w = {r0[0], r1[0], r0[1], r1[1]}; OUT = *reinterpret_cast<bf16x8*>(&w); } while (0)
  PK4(p0, 0, pa0); PK4(p0, 8, pa1); PK4(p1, 0, pa2); PK4(p1, 8, pa3);
#undef PK4
}
template <int NROPE>
__device__ __forceinline__ void qkt(f32x16& p0, f32x16& p1, const char* Ks, const char* Krs, const bf16x8* qr, const char* qrl, int r32, int hi) {
  p0 = f32x16{}; p1 = f32x16{};
#pragma unroll
  for (int d0 = 0; d0 < 8; ++d0) { int cb = (d0 * 16 + hi * 8) * 2;
    bf16x8 b0 = *reinterpret_cast<const bf16x8*>(Ks + KSWZ(r32, cb));
    bf16x8 b1 = *reinterpret_cast<const bf16x8*>(Ks + KSWZ(32 + r32, cb));
    p0 = __builtin_amdgcn_mfma_f32_32x32x16_bf16(b0, qr[d0], p0, 0, 0, 0);
    p1 = __builtin_amdgcn_mfma_f32_32x32x16_bf16(b1, qr[d0], p1, 0, 0, 0); }
  if constexpr (NROPE > 0) {
#pragma unroll
    for (int d0 = 0; d0 < NROPE / 16; ++d0) { int cb = (d0 * 16 + hi * 8) * 2;
      bf16x8 b0 = *reinterpret_cast<const bf16x8*>(Krs + KRSWZ(r32, cb));
      bf16x8 b1 = *reinterpret_cast<const bf16x8*>(Krs + KRSWZ(32 + r32, cb));
      bf16x8 qq = *reinterpret_cast<const bf16x8*>(qrl + KRSWZ(r32, cb));
      p0 = __builtin_amdgcn_mfma_f32_32x32x16_bf16(b0, qq, p0, 0, 0, 0);
      p1 = __builtin_amdgcn_mfma_f32_32x32x16_bf16(b1, qq, p1, 0, 0, 0); }
  }
}
__device__ __forceinline__ int v_st(int k, int c) { const int kk = (k & ~0xC) | ((k & 4) << 1) | ((k & 8) >> 1); return ((kk >> 3) * 4 + (c >> 5)) * 512 + ((kk & 7) * 32 + (c & 31)) * 2; }
__device__ __forceinline__ int v_rd_base(int lane) { return ((lane & 3) << 3) | (((lane >> 2) & 3) << 6) | (((lane >> 4) & 1) << 5) | (((lane >> 5) & 1) << 8); }
constexpr int v_rd_off(int d0, int ks, int half) { return d0 * 512 + ks * 4096 + half * 2048; }
template <int OFF> __device__ __forceinline__ s16x4 tr_read(int vb) {
  s16x4 r; asm volatile("ds_read_b64_tr_b16 %0, %1 offset:%2" : "=&v"(r) : "v"(vb), "i"(OFF) : "memory"); return r;
}
template <int D0> __device__ __forceinline__ void pv_one(f32x16& od, int vb, bf16x8 pa0, bf16x8 pa1, bf16x8 pa2, bf16x8 pa3) {
  const s16x4 l0 = tr_read<v_rd_off(D0, 0, 0)>(vb), h0 = tr_read<v_rd_off(D0, 0, 1)>(vb), l1 = tr_read<v_rd_off(D0, 1, 0)>(vb), h1 = tr_read<v_rd_off(D0, 1, 1)>(vb);
  const s16x4 l2 = tr_read<v_rd_off(D0, 2, 0)>(vb), h2 = tr_read<v_rd_off(D0, 2, 1)>(vb), l3 = tr_read<v_rd_off(D0, 3, 0)>(vb), h3 = tr_read<v_rd_off(D0, 3, 1)>(vb);
  asm volatile("s_waitcnt lgkmcnt(0)" ::: "memory"); SBAR();
#define PK(L, H) (bf16x8){L[0], L[1], L[2], L[3], H[0], H[1], H[2], H[3]}
  od = __builtin_amdgcn_mfma_f32_32x32x16_bf16(pa0, PK(l0, h0), od, 0, 0, 0);
  od = __builtin_amdgcn_mfma_f32_32x32x16_bf16(pa1, PK(l1, h1), od, 0, 0, 0);
  od = __builtin_amdgcn_mfma_f32_32x32x16_bf16(pa2, PK(l2, h2), od, 0, 0, 0);
  od = __builtin_amdgcn_mfma_f32_32x32x16_bf16(pa3, PK(l3, h3), od, 0, 0, 0);
#undef PK
}
__device__ __forceinline__ void pv_d0(f32x16* o, int vb, bf16x8 pa0, bf16x8 pa1, bf16x8 pa2, bf16x8 pa3) {
  pv_one<0>(o[0], vb, pa0, pa1, pa2, pa3); pv_one<1>(o[1], vb, pa0, pa1, pa2, pa3); pv_one<2>(o[2], vb, pa0, pa1, pa2, pa3); pv_one<3>(o[3], vb, pa0, pa1, pa2, pa3);
}

#define TR8(D0, L0, H0, L1, H1, L2, H2, L3, H3) const s16x4 L0 = tr_read<v_rd_off(D0, 0, 0)>(vb), H0 = tr_read<v_rd_off(D0, 0, 1)>(vb), L1 = tr_read<v_rd_off(D0, 1, 0)>(vb), H1 = tr_read<v_rd_off(D0, 1, 1)>(vb), \
    L2 = tr_read<v_rd_off(D0, 2, 0)>(vb), H2 = tr_read<v_rd_off(D0, 2, 1)>(vb), L3 = tr_read<v_rd_off(D0, 3, 0)>(vb), H3 = tr_read<v_rd_off(D0, 3, 1)>(vb)
#define PKV(L, H) (bf16x8){L[0], L[1], L[2], L[3], H[0], H[1], H[2], H[3]}
#define MM4(OD, L0, H0, L1, H1, L2, H2, L3, H3) do { OD = __builtin_amdgcn_mfma_f32_32x32x16_bf16(pa0, PKV(L0, H0), OD, 0, 0, 0); OD = __builtin_amdgcn_mfma_f32_32x32x16_bf16(pa1, PKV(L1, H1), OD, 0, 0, 0); \
    OD = __builtin_amdgcn_mfma_f32_32x32x16_bf16(pa2, PKV(L2, H2), OD, 0, 0, 0); OD = __builtin_amdgcn_mfma_f32_32x32x16_bf16(pa3, PKV(L3, H3), OD, 0, 0, 0); } while (0)
__device__ __forceinline__ void pv_d0p(f32x16* o, int vb, bf16x8 pa0, bf16x8 pa1, bf16x8 pa2, bf16x8 pa3) {
  TR8(0, a0, a1, a2, a3, a4, a5, a6, a7);
  TR8(1, b0, b1, b2, b3, b4, b5, b6, b7);
  asm volatile("s_waitcnt lgkmcnt(8)" ::: "memory"); __builtin_amdgcn_sched_barrier(0);
  MM4(o[0], a0, a1, a2, a3, a4, a5, a6, a7);
  TR8(2, c0, c1, c2, c3, c4, c5, c6, c7);
  asm volatile("s_waitcnt lgkmcnt(8)" ::: "memory"); __builtin_amdgcn_sched_barrier(0);
  MM4(o[1], b0, b1, b2, b3, b4, b5, b6, b7);
  TR8(3, d0, d1, d2, d3, d4, d5, d6, d7);
  asm volatile("s_waitcnt lgkmcnt(8)" ::: "memory"); __builtin_amdgcn_sched_barrier(0);
  MM4(o[2], c0, c1, c2, c3, c4, c5, c6, c7);
  asm volatile("s_waitcnt lgkmcnt(0)" ::: "memory"); __builtin_amdgcn_sched_barrier(0);
  MM4(o[3], d0, d1, d2, d3, d4, d5, d6, d7);
}
#undef TR8
#undef PKV
#undef MM4
template <int ND0> __device__ __forceinline__ void pv_nd(f32x16* o, int vb, bf16x8 pa0, bf16x8 pa1, bf16x8 pa2, bf16x8 pa3) {
  pv_one<0>(o[0], vb, pa0, pa1, pa2, pa3); pv_one<1>(o[1], vb, pa0, pa1, pa2, pa3);
  if constexpr (ND0 == 4) { pv_one<2>(o[2], vb, pa0, pa1, pa2, pa3); pv_one<3>(o[3], vb, pa0, pa1, pa2, pa3); }
}
constexpr int PA_LDS_BYTES = 2 * SHM_K + 4 * SHM_V + 16384 + 2048;
__device__ __forceinline__ void store_o(float* p, float v) { *p = v; }
__device__ __forceinline__ void store_o(bf16_t* p, float v) { unsigned u = __float_as_uint(v); u += 0x7fffu + ((u >> 16) & 1u); *p = (bf16_t)(u >> 16); }
struct QNorm { const float* g; const float* cs; const float* sn; float shift; };
__device__ __forceinline__ void up8(const bf16x8 v, float (&x)[8]) {
#pragma unroll
  for (int j = 0; j < 8; ++j) x[j] = __uint_as_float(((unsigned)(unsigned short)v[j]) << 16); }
__device__ __forceinline__ bf16x8 pk8(const float (&y)[8]) { u32x4 w = {cvtpk(y[0], y[1]), cvtpk(y[2], y[3]), cvtpk(y[4], y[5]), cvtpk(y[6], y[7])}; return *reinterpret_cast<bf16x8*>(&w); }
__device__ __forceinline__ float hsum32(float v) { const unsigned u = __float_as_uint(v); auto r = __builtin_amdgcn_permlane32_swap(u, u, false, false); return __uint_as_float(r[0]) + __uint_as_float(r[1]); }
template <bool ROT16> __device__ __forceinline__ void qnorm_nope(bf16x8 (&qr)[8], const float* g, const float* cs, const float* sn, int hi, float qs = 1.f) {
  float ss = 0.f;
#pragma unroll
  for (int d0 = 0; d0 < 8; ++d0) { float x[8]; up8(qr[d0], x);
#pragma unroll
    for (int t = 0; t < 8; ++t) ss += x[t] * x[t]; }
  const float rstd = __builtin_amdgcn_rsqf(hsum32(ss) * (1.f / 128.f) + 1e-6f) * qs;
  if (ROT16) { float u[8], w[8]; up8(qr[0], u); up8(qr[1], w);
#pragma unroll
    for (int t = 0; t < 8; ++t) { const float c = cs[hi * 8 + t], s = sn[hi * 8 + t], a = u[t] * rstd * g[hi * 8 + t], b = w[t] * rstd * g[16 + hi * 8 + t]; u[t] = a * c - b * s; w[t] = b * c + a * s; }
    qr[0] = pk8(u); qr[1] = pk8(w); }
#pragma unroll
  for (int d0 = (ROT16 ? 2 : 0); d0 < 8; ++d0) { float x[8]; up8(qr[d0], x);
#pragma unroll
    for (int t = 0; t < 8; ++t) x[t] = x[t] * rstd * g[d0 * 16 + hi * 8 + t];
    qr[d0] = pk8(x); }
}
__device__ __forceinline__ void qnorm_rope(bf16x8 (&qrr)[4], const float* g, const float* cs, const float* sn, int hi, float qs = 1.f) {
  float ss = 0.f;
#pragma unroll
  for (int d0 = 0; d0 < 4; ++d0) { float x[8]; up8(qrr[d0], x);
#pragma unroll
    for (int t = 0; t < 8; ++t) ss += x[t] * x[t]; }
  const float rstd = __builtin_amdgcn_rsqf(hsum32(ss) * (1.f / 64.f) + 1e-6f) * qs;
#pragma unroll
  for (int d0 = 0; d0 < 2; ++d0) { float u[8], w[8]; up8(qrr[d0], u); up8(qrr[d0 + 2], w);
#pragma unroll
    for (int t = 0; t < 8; ++t) { const float c = cs[d0 * 16 + hi * 8 + t], s = sn[d0 * 16 + hi * 8 + t], a = u[t] * rstd * g[d0 * 16 + hi * 8 + t], b = w[t] * rstd * g[(d0 + 2) * 16 + hi * 8 + t]; u[t] = a * c - b * s; w[t] = b * c + a * s; }
    qrr[d0] = pk8(u); qrr[d0 + 2] = pk8(w); }
}

template <class Cfg>
__device__ __forceinline__ void attn_unit(const bf16_t* __restrict__ Qb, const bf16_t* __restrict__ Kh, const bf16_t* __restrict__ Vh,
                                          const bf16_t* __restrict__ Qr, const bf16_t* __restrict__ Kr, typename Cfg::OutT* __restrict__ Ob, int seq, char* lds) {
  constexpr int LDQ = Cfg::LDQ, LDK = Cfg::LDK, LDV = Cfg::LDV, LDO = Cfg::LDO, LDKR = Cfg::LDKR, NROPE = Cfg::NROPE, SDEPTH = Cfg::SDEPTH;
  static_assert(SDEPTH == 1 || SDEPTH == 2, "SDEPTH is 1 or 2");
  int tid = my_tid(); asm volatile("" : "+v"(tid));
  const int wid = tid >> 6, lane = tid & 63, r32 = lane & 31, hi = lane >> 5;
  char* V_lds = lds + OFF_V; char* K_lds = lds + OFF_K; char* KR_lds = lds + OFF_KR;
  float* ws = (float*)(lds + OFF_WS) + wid * 64; float* li_l = ws; float* al_l = ws + 32;
  float m_reg = -1e30f, l_reg = 0; f32x16 o[4] = {}; bf16x8 qr[8]; const char* qrl = lds + OFF_QR + wid * 4096;
  const bf16_t* Qw = Qb + (long)(wid * QBLK + r32) * LDQ + hi * 8;
#pragma unroll
  for (int d0 = 0; d0 < 8; ++d0) qr[d0] = *reinterpret_cast<const bf16x8*>(Qw + d0 * 16);
  if constexpr (NROPE > 0) {
    const bf16_t* Qrw = Qr + (long)(wid * QBLK + r32) * LDQ + hi * 8;
#pragma unroll
    for (int d0 = 0; d0 < 4; ++d0) *(bf16x8*)(lds + OFF_QR + wid * 4096 + KRSWZ(r32, (d0 * 16 + hi * 8) * 2)) = *reinterpret_cast<const bf16x8*>(Qrw + d0 * 16);
  }
  const int sr = tid >> 4, sc = (tid & 15) * 8, vst0 = v_st(sr, sc), vst1 = v_st(32 + sr, sc);
  const int krr = tid >> 3, krc = (tid & 7) * 8;
  const int vb0 = (int)(uintptr_t)V_lds + v_rd_base(lane);
  struct { bf16x8 vs0, vs1, ks0, ks1, kr; } sr_[SDEPTH];
#define SLOAD(i, k0) do { sr_[i].vs0 = *reinterpret_cast<const bf16x8*>(&Vh[(long)((k0) + sr) * LDV + sc]); sr_[i].vs1 = *reinterpret_cast<const bf16x8*>(&Vh[(long)((k0) + 32 + sr) * LDV + sc]); \
    sr_[i].ks0 = *reinterpret_cast<const bf16x8*>(&Kh[(long)((k0) + sr) * LDK + sc]); sr_[i].ks1 = *reinterpret_cast<const bf16x8*>(&Kh[(long)((k0) + 32 + sr) * LDK + sc]); \
    if constexpr (NROPE > 0) sr_[i].kr = *reinterpret_cast<const bf16x8*>(&Kr[(long)((k0) + krr) * LDKR + krc]); } while (0)
#define SWRITE(b, i) do { *(bf16x8*)(V_lds + (b) * SHM_V + vst0) = sr_[i].vs0;          \
    *(bf16x8*)(V_lds + (b) * SHM_V + vst1) = sr_[i].vs1; int kc = sc * 2;               \
    *(bf16x8*)(K_lds + (b) * SHM_K + KSWZ(sr, kc)) = sr_[i].ks0;                       \
    *(bf16x8*)(K_lds + (b) * SHM_K + KSWZ(32 + sr, kc)) = sr_[i].ks1;                  \
    if constexpr (NROPE > 0) *(bf16x8*)(KR_lds + (b) * SHM_KR + KRSWZ(krr, krc * 2)) = sr_[i].kr; } while (0)
#define SWAIT() do { if constexpr (SDEPTH == 1) asm volatile("s_waitcnt vmcnt(0)" ::: "memory"); else if constexpr (NROPE > 0) asm volatile("s_waitcnt vmcnt(5)" ::: "memory"); else asm volatile("s_waitcnt vmcnt(4)" ::: "memory"); } while (0)
#define RESC(a) do { if (__any((a) < 1.f)) { if (hi == 0) al_l[r32] = (a); asm volatile("s_waitcnt lgkmcnt(0)" ::: "memory"); \
    _Pragma("unroll") for (int d = 0; d < 4; ++d) _Pragma("unroll") for (int r = 0; r < 16; ++r) o[d][r] *= al_l[crow(r, hi)]; } } while (0)
  f32x16 pA0, pA1, pB0, pB1; float mnA, mnB, alA, alB; bf16x8 pa0, pa1, pa2, pa3; const int NT = seq / KVBLK;
  constexpr int SE = 0, SO = SDEPTH - 1;
  SLOAD(SE, 0); asm volatile("s_waitcnt vmcnt(0)" ::: "memory"); SWRITE(0, SE); __syncthreads();
  qkt<NROPE>(pA0, pA1, K_lds, KR_lds, qr, qrl, r32, hi); partialSM<Cfg>(pA0, pA1, m_reg, mnA, alA);
  SLOAD(SO, KVBLK); if constexpr (SDEPTH == 2) { if (2 < NT) SLOAD(SE, 2 * KVBLK); }
  SWAIT(); SWRITE(1, SO); __syncthreads();
  for (int j = 1; j + 1 < NT; j += 2) {
    SBAR(); qkt<NROPE>(pB0, pB1, K_lds + SHM_K, KR_lds + SHM_KR, qr, qrl, r32, hi);
    finishSM(pA0, pA1, alA, l_reg, pa0, pa1, pa2, pa3); SBAR();
    SLOAD(SO, (j + SDEPTH) * KVBLK); SBAR();
    pv_d0(o, vb0, pa0, pa1, pa2, pa3); partialSM<Cfg>(pB0, pB1, m_reg, mnB, alB);
    __syncthreads(); SWAIT(); SWRITE(0, SE);
    RESC(alB); __syncthreads();
    SBAR(); qkt<NROPE>(pA0, pA1, K_lds, KR_lds, qr, qrl, r32, hi);
    finishSM(pB0, pB1, alB, l_reg, pa0, pa1, pa2, pa3); SBAR();
    if (SDEPTH == 1 || j + 3 < NT) SLOAD(SE, (j + 1 + SDEPTH) * KVBLK); SBAR();
    pv_d0(o, vb0 + SHM_V, pa0, pa1, pa2, pa3); partialSM<Cfg>(pA0, pA1, m_reg, mnA, alA);
    __syncthreads(); SWAIT(); SWRITE(1, SO);
    RESC(alA); __syncthreads();
  }
  SBAR(); qkt<NROPE>(pB0, pB1, K_lds + SHM_K, KR_lds + SHM_KR, qr, qrl, r32, hi);
  finishSM(pA0, pA1, alA, l_reg, pa0, pa1, pa2, pa3); SBAR();
  pv_d0(o, vb0, pa0, pa1, pa2, pa3); partialSM<Cfg>(pB0, pB1, m_reg, mnB, alB);
  __syncthreads(); RESC(alB);
  finishSM(pB0, pB1, alB, l_reg, pa0, pa1, pa2, pa3); SBAR();
  pv_d0(o, vb0 + SHM_V, pa0, pa1, pa2, pa3);
  if (hi == 0) li_l[r32] = l_reg; asm volatile("s_waitcnt lgkmcnt(0)" ::: "memory");
  float rli[16];
#pragma unroll
  for (int r = 0; r < 16; ++r) rli[r] = __builtin_amdgcn_rcpf(li_l[crow(r, hi)]);
  typename Cfg::OutT* Ow = Ob + (long)(wid * QBLK) * LDO;
#pragma unroll
  for (int r = 0; r < 16; ++r) { int orow = crow(r, hi);
#pragma unroll
    for (int d0 = 0; d0 < 4; ++d0) store_o(Ow + (long)orow * LDO + d0 * 32 + r32, o[d0][r] * rli[r]); }
#undef SLOAD
#undef SWRITE
#undef SWAIT
#undef RESC
}

#define KX(row) ((((row) & 3) << 2) | (((row) >> 2) & 3))
#define KSWZ(row, colB) ((row) * 256 + ((colB) ^ (KX(row) << 4)))
#define KRX(row) (((row) >> 1) & 7)
#define KRSWZ(row, colB) ((row) * 128 + ((colB) ^ (KRX(row) << 4)))
#define SBAR() __builtin_amdgcn_sched_barrier(0)
#define ATT_LAS __attribute__((address_space(3)))
constexpr int D_OFF_K = 0, D_OFF_V = 3 * SHM_K, D_OFF_KR = D_OFF_V + 3 * SHM_V, D_OFF_WS = D_OFF_KR + 3 * SHM_KR, DMA_LDS_BYTES = D_OFF_WS + NW * 64 * 4;
template <int NROPE>
__device__ __forceinline__ void qkt_r(f32x16& p0, f32x16& p1, const char* Ks, const char* Krs, const bf16x8* qr, const bf16x8* qrr, int r32_, int hi) {
  int r32 = r32_; if (QK_FRESH_ADDR) asm volatile("" : "+v"(r32));
  p0 = f32x16{}; p1 = f32x16{};
#pragma unroll
  for (int d0 = 0; d0 < 8; ++d0) { int cb = (d0 * 16 + hi * 8) * 2;
    bf16x8 b0 = *reinterpret_cast<const bf16x8*>(Ks + KSWZ(r32, cb));
    bf16x8 b1 = *reinterpret_cast<const bf16x8*>(Ks + KSWZ(32 + r32, cb));
    p0 = __builtin_amdgcn_mfma_f32_32x32x16_bf16(b0, qr[d0], p0, 0, 0, 0);
    p1 = __builtin_amdgcn_mfma_f32_32x32x16_bf16(b1, qr[d0], p1, 0, 0, 0); }
  if constexpr (NROPE > 0) {
#pragma unroll
    for (int d0 = 0; d0 < NROPE / 16; ++d0) { int cb = (d0 * 16 + hi * 8) * 2;
      bf16x8 b0 = *reinterpret_cast<const bf16x8*>(Krs + KRSWZ(r32, cb));
      bf16x8 b1 = *reinterpret_cast<const bf16x8*>(Krs + KRSWZ(32 + r32, cb));
      p0 = __builtin_amdgcn_mfma_f32_32x32x16_bf16(b0, qrr[d0], p0, 0, 0, 0);
      p1 = __builtin_amdgcn_mfma_f32_32x32x16_bf16(b1, qrr[d0], p1, 0, 0, 0); }
  }
}
#define PV_FN(...) do { if constexpr (Cfg::PVPIPE) pv_d0p(__VA_ARGS__); else pv_d0(__VA_ARGS__); } while (0)
template <class Cfg>
__device__ __forceinline__ void attn_unit_dma(const bf16_t* __restrict__ Qb, const bf16_t* __restrict__ Kh, const bf16_t* __restrict__ Vh,
                                              const bf16_t* __restrict__ Qr, const bf16_t* __restrict__ Kr, typename Cfg::OutT* __restrict__ Ob, int seq, char* lds, ATT_LAS unsigned char* ldsl, const QNorm qn) {
  constexpr int LDQ = Cfg::LDQ, LDK = Cfg::LDK, LDV = Cfg::LDV, LDO = Cfg::LDO, LDKR = Cfg::LDKR, NROPE = Cfg::NROPE;
  int tid = my_tid(); asm volatile("" : "+v"(tid));
  const int wid = __builtin_amdgcn_readfirstlane(tid >> 6), lane = tid & 63, r32 = lane & 31, hi = lane >> 5;
  char* V_lds = lds + D_OFF_V; char* K_lds = lds + D_OFF_K; char* KR_lds = lds + D_OFF_KR;
  float* ws = (float*)(lds + D_OFF_WS) + wid * 64; float* li_l = ws; float* al_l = ws + 32;
  float m_reg = -1e30f, l_reg = 0; f32x16 o[4] = {}; bf16x8 qr[8]; bf16x8 qrr[4];
  constexpr float QS = 1.f;
  const bf16_t* Qw = Qb + (long)(wid * QBLK + r32) * LDQ + hi * 8;
#pragma unroll
  for (int d0 = 0; d0 < 8; ++d0) qr[d0] = *reinterpret_cast<const bf16x8*>(Qw + d0 * 16);
#pragma unroll
  for (int d0 = 0; d0 < 4; ++d0) qrr[d0] = bf16x8{};
  if constexpr (NROPE > 0) { const bf16_t* Qrw = Qr + (long)(wid * QBLK + r32) * LDQ + hi * 8;
#pragma unroll
    for (int d0 = 0; d0 < 4; ++d0) qrr[d0] = *reinterpret_cast<const bf16x8*>(Qrw + d0 * 16); }
  if constexpr (Cfg::QNORM) {
    if constexpr (NROPE > 0) { qnorm_nope<false>(qr, qn.g, nullptr, nullptr, hi, QS); qnorm_rope(qrr, qn.g + 128, qn.cs + (wid * QBLK + r32) * 32, qn.sn + (wid * QBLK + r32) * 32, hi, QS); }
    else qnorm_nope<true>(qr, qn.g, qn.cs + (wid * QBLK + r32) * 16, qn.sn + (wid * QBLK + r32) * 16, hi, QS); }
  unsigned koff[2], voff[2], kroff = 0;
#pragma unroll
  for (int i = 0; i < 2; ++i) { const int q = wid * 2 + i;
    { const int R = 4 * q + (lane >> 4), g = (lane & 15) ^ KX(R); koff[i] = (unsigned)(R * LDK * 2 + g * 16); }
    { const int kk = (q >> 1) * 8 + ((lane & 31) >> 2), k = (kk & ~0xC) | ((kk & 4) << 1) | ((kk & 8) >> 1), c = (2 * (q & 1) + (lane >> 5)) * 32 + (lane & 3) * 8;
      voff[i] = (unsigned)(k * LDV * 2 + c * 2); } }
  if constexpr (NROPE > 0) { const int R = 8 * wid + (lane >> 3), g = (lane & 7) ^ KRX(R); kroff = (unsigned)(R * LDKR * 2 + g * 16); }
  const int vb0 = (int)(uintptr_t)V_lds + v_rd_base(lane);
#define DMA_TILE(t, s) do { const char* kb_ = (const char*)Kh + (size_t)(t) * (KVBLK * LDK * 2); const char* vb_ = (const char*)Vh + (size_t)(t) * (KVBLK * LDV * 2); \
    _Pragma("unroll") for (int i_ = 0; i_ < 2; ++i_) { \
      __builtin_amdgcn_global_load_lds((const unsigned*)(kb_ + koff[i_]), (ATT_LAS unsigned*)(ldsl + D_OFF_K + (s) * SHM_K + (wid * 2 + i_) * 1024), 16, 0, 0); \
      __builtin_amdgcn_global_load_lds((const unsigned*)(vb_ + voff[i_]), (ATT_LAS unsigned*)(ldsl + D_OFF_V + (s) * SHM_V + (wid * 2 + i_) * 1024), 16, 0, 0); } \
    if constexpr (NROPE > 0) { const char* rb_ = (const char*)Kr + (size_t)(t) * (KVBLK * LDKR * 2); \
      __builtin_amdgcn_global_load_lds((const unsigned*)(rb_ + kroff), (ATT_LAS unsigned*)(ldsl + D_OFF_KR + (s) * SHM_KR + wid * 1024), 16, 0, 0); } } while (0)
#define DWAITBAR() do { asm volatile("s_waitcnt vmcnt(0)" ::: "memory"); __builtin_amdgcn_s_barrier(); asm volatile("" ::: "memory"); } while (0)
#define RESC(a) do { if (__any((a) < 1.f)) { if (hi == 0) al_l[r32] = (a); asm volatile("s_waitcnt lgkmcnt(0)" ::: "memory"); \
    _Pragma("unroll") for (int d = 0; d < 4; ++d) _Pragma("unroll") for (int r = 0; r < 16; ++r) o[d][r] *= al_l[crow(r, hi)]; } } while (0)
  f32x16 pA0, pA1, pB0, pB1; float mnA, mnB, alA, alB; bf16x8 pa0, pa1, pa2, pa3; const int NT = seq / KVBLK;
  if (ATT_STATIC_PRIO && wid >= 4) __builtin_amdgcn_s_setprio(1);
  DMA_TILE(0, 0); DMA_TILE(1, 1); DWAITBAR();
  qkt_r<NROPE>(pA0, pA1, K_lds, KR_lds, qr, qrr, r32, hi); partialSM<Cfg>(pA0, pA1, m_reg, mnA, alA);
  if (2 < NT) DMA_TILE(2, 2);
  int s_m1 = 0, s_0 = 1, s_p1 = 2;
  for (int t = 1; t + 1 < NT; t += 2) {
    SBAR(); qkt_r<NROPE>(pB0, pB1, K_lds + s_0 * SHM_K, KR_lds + s_0 * SHM_KR, qr, qrr, r32, hi);
    finishSM(pA0, pA1, alA, l_reg, pa0, pa1, pa2, pa3); SBAR();
    PV_FN(o, vb0 + s_m1 * SHM_V, pa0, pa1, pa2, pa3); partialSM<Cfg>(pB0, pB1, m_reg, mnB, alB);
    DWAITBAR();
    if (t + 2 < NT) DMA_TILE(t + 2, s_m1);
    RESC(alB);
    SBAR(); qkt_r<NROPE>(pA0, pA1, K_lds + s_p1 * SHM_K, KR_lds + s_p1 * SHM_KR, qr, qrr, r32, hi);
    finishSM(pB0, pB1, alB, l_reg, pa0, pa1, pa2, pa3); SBAR();
    PV_FN(o, vb0 + s_0 * SHM_V, pa0, pa1, pa2, pa3); partialSM<Cfg>(pA0, pA1, m_reg, mnA, alA);
    DWAITBAR();
    if (t + 3 < NT) DMA_TILE(t + 3, s_0);
    RESC(alA);
    { const int a_ = s_m1; s_m1 = s_p1; s_p1 = s_0; s_0 = a_; }
  }
  SBAR(); qkt_r<NROPE>(pB0, pB1, K_lds + s_0 * SHM_K, KR_lds + s_0 * SHM_KR, qr, qrr, r32, hi);
  finishSM(pA0, pA1, alA, l_reg, pa0, pa1, pa2, pa3); SBAR();
  PV_FN(o, vb0 + s_m1 * SHM_V, pa0, pa1, pa2, pa3); partialSM<Cfg>(pB0, pB1, m_reg, mnB, alB);
  RESC(alB);
  finishSM(pB0, pB1, alB, l_reg, pa0, pa1, pa2, pa3); SBAR();
  PV_FN(o, vb0 + s_0 * SHM_V, pa0, pa1, pa2, pa3);
  if (hi == 0) li_l[r32] = l_reg; asm volatile("s_waitcnt lgkmcnt(0)" ::: "memory");
  float rli[16];
#pragma unroll
  for (int r = 0; r < 16; ++r) rli[r] = __builtin_amdgcn_rcpf(li_l[crow(r, hi)]);
  int r32e = r32, hie = hi; asm volatile("" : "+v"(r32e), "+v"(hie));
  typename Cfg::OutT* Ow = Ob + (long)(wid * QBLK) * LDO;
#pragma unroll
  for (int r = 0; r < 16; ++r) { int orow = crow(r, hie);
#pragma unroll
    for (int d0 = 0; d0 < 4; ++d0) store_o(Ow + (long)orow * LDO + d0 * 32 + r32e, o[d0][r] * rli[r]); }
  if (ATT_STATIC_PRIO) __builtin_amdgcn_s_setprio(0);
  __builtin_amdgcn_s_barrier();
#undef DMA_TILE
#undef DWAITBAR
#undef RESC
}
#undef KSWZ
#undef KRSWZ
#undef KX
#undef KRX
#undef SBAR
#define KX(row) ((((row) & 3) << 2) | (((row) >> 2) & 3))
#define KSWZ(row, colB) ((row) * 256 + ((colB) ^ (KX(row) << 4)))
#define KRX(row) (((row) >> 1) & 7)
#define KRSWZ(row, colB) ((row) * 128 + ((colB) ^ (KRX(row) << 4)))
#define SBAR() __builtin_amdgcn_sched_barrier(0)

template <class Cfg>
__device__ __forceinline__ void attn_unit_pa(const bf16_t* __restrict__ Qb, const bf16_t* __restrict__ Kh, const bf16_t* __restrict__ Vh,
                                             const bf16_t* __restrict__ Qr, const bf16_t* __restrict__ Kr, typename Cfg::OutT* __restrict__ Ob, int seq, char* lds) {
  constexpr int LDQ = Cfg::LDQ, LDK = Cfg::LDK, LDV = Cfg::LDV, LDO = Cfg::LDO, LDKR = Cfg::LDKR, NROPE = Cfg::NROPE, VW = Cfg::VW;
  constexpr int NVH = VW / 128, ND0 = VW / 64;
  static_assert(VW == 128 || VW == 256, "VW is 128 or 256");
  constexpr int P_OFF_K = 0, P_OFF_KR = 2 * SHM_K, P_OFF_V = P_OFF_KR + (NROPE > 0 ? 2 * SHM_KR : 0), P_OFF_PX = P_OFF_V + 2 * NVH * SHM_V, P_OFF_AX = P_OFF_PX + 16384, P_OFF_LX = P_OFF_AX + 1024, P_OFF_QR = P_OFF_LX + 1024;
  static_assert(P_OFF_QR + (NROPE > 0 ? 16384 : 0) <= PA_LDS_BYTES, "pair-alternating body: LDS map");
  int tid = my_tid(); asm volatile("" : "+v"(tid));
  const int wid = __builtin_amdgcn_readfirstlane(tid >> 6), lane = tid & 63, r32 = lane & 31, hi = lane >> 5, rg = wid & 3, e = wid >> 2;
  char* K_lds = lds + P_OFF_K; char* KR_lds = lds + P_OFF_KR; char* V_lds = lds + P_OFF_V;
  char* PX = lds + P_OFF_PX + rg * 4096 + lane * 16;
  float* AX = (float*)(lds + P_OFF_AX) + rg * 64;
  float* LX = (float*)(lds + P_OFF_LX) + rg * 64;
  const char* qrl = lds + P_OFF_QR + rg * 4096;
  float m_reg = -1e30f, l_reg = 0; f32x16 o[ND0]; bf16x8 qr[8];
#pragma unroll
  for (int d = 0; d < ND0; ++d) o[d] = f32x16{};
  const bf16_t* Qw = Qb + (long)(rg * QBLK + r32) * LDQ + hi * 8;
#pragma unroll
  for (int d0 = 0; d0 < 8; ++d0) qr[d0] = *reinterpret_cast<const bf16x8*>(Qw + d0 * 16);
  if constexpr (NROPE > 0) { if (e == 0) { const bf16_t* Qrw = Qr + (long)(rg * QBLK + r32) * LDQ + hi * 8;
#pragma unroll
      for (int d0 = 0; d0 < 4; ++d0) *(bf16x8*)(lds + P_OFF_QR + rg * 4096 + KRSWZ(r32, (d0 * 16 + hi * 8) * 2)) = *reinterpret_cast<const bf16x8*>(Qrw + d0 * 16); } }
  const int sr = tid >> 4, sc = (tid & 15) * 8, vst0 = v_st(sr, sc), vst1 = v_st(32 + sr, sc);
  const int krr = tid >> 3, krc = (tid & 7) * 8;
  const int vb0 = (int)(uintptr_t)V_lds + v_rd_base(lane) + ((e * ND0) >> 2) * SHM_V + ((e * ND0) & 3) * 512;
  struct { bf16x8 k0, k1, kr, v[2 * NVH]; } st;
#define PLOAD(kt, vt) do { st.k0 = *reinterpret_cast<const bf16x8*>(&Kh[(long)((kt) * KVBLK + sr) * LDK + sc]); st.k1 = *reinterpret_cast<const bf16x8*>(&Kh[(long)((kt) * KVBLK + 32 + sr) * LDK + sc]); \
    if constexpr (NROPE > 0) st.kr = *reinterpret_cast<const bf16x8*>(&Kr[(long)((kt) * KVBLK + krr) * LDKR + krc]); \
    _Pragma("unroll") for (int vh = 0; vh < NVH; ++vh) { st.v[2 * vh] = *reinterpret_cast<const bf16x8*>(&Vh[(long)((vt) * KVBLK + sr) * LDV + vh * 128 + sc]); \
      st.v[2 * vh + 1] = *reinterpret_cast<const bf16x8*>(&Vh[(long)((vt) * KVBLK + 32 + sr) * LDV + vh * 128 + sc]); } } while (0)
#define PWRITE(kb, vbuf) do { *(bf16x8*)(K_lds + (kb) * SHM_K + KSWZ(sr, sc * 2)) = st.k0; *(bf16x8*)(K_lds + (kb) * SHM_K + KSWZ(32 + sr, sc * 2)) = st.k1; \
    if constexpr (NROPE > 0) *(bf16x8*)(KR_lds + (kb) * SHM_KR + KRSWZ(krr, krc * 2)) = st.kr; \
    _Pragma("unroll") for (int vh = 0; vh < NVH; ++vh) { *(bf16x8*)(V_lds + ((vbuf) * NVH + vh) * SHM_V + vst0) = st.v[2 * vh]; *(bf16x8*)(V_lds + ((vbuf) * NVH + vh) * SHM_V + vst1) = st.v[2 * vh + 1]; } } while (0)
  f32x16 p0, p1; float mn, alpha; bf16x8 pa0, pa1, pa2, pa3; const int NT = seq / KVBLK;
  PLOAD(0, 0); PWRITE(0, 0); PLOAD(1, 0); PWRITE(1, 0); __syncthreads();
  if (e == 0) qkt<NROPE>(p0, p1, K_lds, KR_lds, qr, qrl, r32, hi);
  PLOAD(2 < NT ? 2 : NT - 1, 1);
#define PSLOT(j, PE) do { \
    if (e == (PE)) { partialSM<Cfg>(p0, p1, m_reg, mn, alpha); finishSM(p0, p1, alpha, l_reg, pa0, pa1, pa2, pa3); \
      *(bf16x8*)(PX) = pa0; *(bf16x8*)(PX + 1024) = pa1; *(bf16x8*)(PX + 2048) = pa2; *(bf16x8*)(PX + 3072) = pa3; \
      if (hi == 0) { AX[2 * r32] = alpha; AX[2 * r32 + 1] = mn; } } \
    else { if ((j) + 1 < NT) qkt<NROPE>(p0, p1, K_lds + (((j) + 1) & 1) * SHM_K, KR_lds + (((j) + 1) & 1) * SHM_KR, qr, qrl, r32, hi); } \
    __syncthreads(); SBAR(); \
    { const float al = AX[2 * r32], mm = AX[2 * r32 + 1]; \
      if (e != (PE)) { pa0 = *(const bf16x8*)(PX); pa1 = *(const bf16x8*)(PX + 1024); pa2 = *(const bf16x8*)(PX + 2048); pa3 = *(const bf16x8*)(PX + 3072); m_reg = mm; l_reg *= al; } \
      if (__any(al < 1.f)) { _Pragma("unroll") for (int r = 0; r < 16; ++r) { const float ar = AX[2 * crow(r, hi)]; _Pragma("unroll") for (int d = 0; d < ND0; ++d) o[d][r] *= ar; } } } \
    SBAR(); pv_nd<ND0>(o, vb0 + ((j) & 1) * NVH * SHM_V, pa0, pa1, pa2, pa3); SBAR(); \
    if ((j) + 1 < NT) { PWRITE((j) & 1, ((j) + 1) & 1); const int kt_ = (j) + 3 < NT ? (j) + 3 : NT - 1, vt_ = (j) + 2 < NT ? (j) + 2 : NT - 1; PLOAD(kt_, vt_); } \
    __syncthreads(); SBAR(); } while (0)
  for (int j = 0; j < NT; j += 2) { PSLOT(j, 0); PSLOT(j + 1, 1); }
  if (hi == 0) LX[e * 32 + r32] = l_reg;
  __syncthreads();
  float rli[16];
#pragma unroll
  for (int r = 0; r < 16; ++r) rli[r] = __builtin_amdgcn_rcpf(LX[crow(r, hi)] + LX[32 + crow(r, hi)]);
  typename Cfg::OutT* Ow = Ob + (long)(rg * QBLK) * LDO + e * (VW / 2);
#pragma unroll
  for (int r = 0; r < 16; ++r) { int orow = crow(r, hi);
#pragma unroll
    for (int d0 = 0; d0 < ND0; ++d0) store_o(Ow + (long)orow * LDO + d0 * 32 + r32, o[d0][r] * rli[r]); }
#undef PLOAD
#undef PWRITE
#undef PSLOT
}

constexpr int PD_OFF_K = 0, PD_OFF_V = 3 * SHM_K, PD_OFF_PX = PD_OFF_V + 4 * SHM_V, PD_OFF_AX = PD_OFF_PX + 16384, PD_OFF_LX = PD_OFF_AX + 1024, PAD_LDS_BYTES = PD_OFF_LX + 1024;
template <class Cfg>
__device__ __forceinline__ void attn_unit_pad(const bf16_t* __restrict__ Qb, const bf16_t* __restrict__ Kh, const bf16_t* __restrict__ Vh, typename Cfg::OutT* __restrict__ Ob, int seq, char* lds, ATT_LAS unsigned char* ldsl) {
  constexpr int LDQ = Cfg::LDQ, LDK = Cfg::LDK, LDV = Cfg::LDV, LDO = Cfg::LDO, VW = Cfg::VW, ND0 = 4;
  static_assert(VW == 256 && Cfg::NROPE == 0, "attn_unit_pad: 256 value columns, no rope");
  int tid = my_tid(); asm volatile("" : "+v"(tid));
  const int wid = __builtin_amdgcn_readfirstlane(tid >> 6), lane = tid & 63, r32 = lane & 31, hi = lane >> 5, rg = wid & 3, e = wid >> 2;
  char* K_lds = lds + PD_OFF_K; char* V_lds = lds + PD_OFF_V;
  char* PX = lds + PD_OFF_PX + rg * 4096 + lane * 16;
  float* AX = (float*)(lds + PD_OFF_AX) + rg * 64;
  float* LX = (float*)(lds + PD_OFF_LX) + rg * 64;
  float m_reg = -1e30f, l_reg = 0; f32x16 o[ND0]; bf16x8 qr[8];
#pragma unroll
  for (int d = 0; d < ND0; ++d) o[d] = f32x16{};
  const bf16_t* Qw = Qb + (long)(rg * QBLK + r32) * LDQ + hi * 8;
#pragma unroll
  for (int d0 = 0; d0 < 8; ++d0) qr[d0] = *reinterpret_cast<const bf16x8*>(Qw + d0 * 16);
  unsigned koff[2], voff[4];
#pragma unroll
  for (int i = 0; i < 2; ++i) { const int q = wid * 2 + i, R = 4 * q + (lane >> 4), g = (lane & 15) ^ KX(R); koff[i] = (unsigned)(R * LDK * 2 + g * 16); }
#pragma unroll
  for (int i = 0; i < 4; ++i) { const int qq = wid * 4 + i, vh = qq >> 4, q = qq & 15;
    const int kk = (q >> 1) * 8 + ((lane & 31) >> 2), k = (kk & ~0xC) | ((kk & 4) << 1) | ((kk & 8) >> 1), c = vh * 128 + (2 * (q & 1) + (lane >> 5)) * 32 + (lane & 3) * 8;
    voff[i] = (unsigned)(k * LDV * 2 + c * 2); }
  const int vb0 = (int)(uintptr_t)V_lds + v_rd_base(lane) + e * SHM_V;
#define PD_DMA_K(t, s) do { const char* kb_ = (const char*)Kh + (size_t)(t) * (KVBLK * LDK * 2); _Pragma("unroll") for (int i_ = 0; i_ < 2; ++i_) \
    __builtin_amdgcn_global_load_lds((const unsigned*)(kb_ + koff[i_]), (ATT_LAS unsigned*)(ldsl + PD_OFF_K + (s) * SHM_K + (wid * 2 + i_) * 1024), 16, 0, 0); } while (0)
#define PD_DMA_V(t, s) do { const char* vb_ = (const char*)Vh + (size_t)(t) * (KVBLK * LDV * 2); _Pragma("unroll") for (int i_ = 0; i_ < 4; ++i_) \
    __builtin_amdgcn_global_load_lds((const unsigned*)(vb_ + voff[i_]), (ATT_LAS unsigned*)(ldsl + PD_OFF_V + (s) * 2 * SHM_V + (wid * 4 + i_) * 1024), 16, 0, 0); } while (0)
#define PD_BAR() do { __builtin_amdgcn_s_barrier(); asm volatile("" ::: "memory"); } while (0)
  f32x16 p0, p1; float mn, alpha; bf16x8 pa0, pa1, pa2, pa3; const int NT = seq / KVBLK;
  PD_DMA_K(0, 0); PD_DMA_K(1, 1); PD_DMA_K(2, 2); PD_DMA_V(0, 0);
  asm volatile("s_waitcnt vmcnt(0)" ::: "memory"); PD_BAR();
  if (e == 0) qkt_r<0>(p0, p1, K_lds, K_lds, qr, qr, r32, hi);
  asm volatile("s_waitcnt lgkmcnt(0)" ::: "memory"); PD_BAR();
  int ks0 = 0, ks1 = 1, ks2 = 2;
#define PDSLOT(j, PE) do { \
    { const int tv_ = (j) + 1 < NT ? (j) + 1 : NT - 1, tk_ = (j) + 3 < NT ? (j) + 3 : NT - 1; PD_DMA_V(tv_, 1 - (PE)); PD_DMA_K(tk_, ks0); }     \
    if (e == (PE)) { partialSM<Cfg>(p0, p1, m_reg, mn, alpha); finishSM(p0, p1, alpha, l_reg, pa0, pa1, pa2, pa3); \
      *(bf16x8*)(PX) = pa0; *(bf16x8*)(PX + 1024) = pa1; *(bf16x8*)(PX + 2048) = pa2; *(bf16x8*)(PX + 3072) = pa3; \
      if (hi == 0) { AX[2 * r32] = alpha; AX[2 * r32 + 1] = mn; } } \
    else { if ((j) + 1 < NT) qkt_r<0>(p0, p1, K_lds + ks1 * SHM_K, K_lds, qr, qr, r32, hi); } \
    asm volatile("s_waitcnt vmcnt(6) lgkmcnt(0)" ::: "memory"); PD_BAR();                       \
    { const float al = AX[2 * r32], mm = AX[2 * r32 + 1]; \
      if (e != (PE)) { pa0 = *(const bf16x8*)(PX); pa1 = *(const bf16x8*)(PX + 1024); pa2 = *(const bf16x8*)(PX + 2048); pa3 = *(const bf16x8*)(PX + 3072); m_reg = mm; l_reg *= al; } \
      if (__any(al < 1.f)) { _Pragma("unroll") for (int r = 0; r < 16; ++r) { const float ar = AX[2 * crow(r, hi)]; _Pragma("unroll") for (int d = 0; d < ND0; ++d) o[d][r] *= ar; } } } \
    pv_d0p(o, vb0 + (PE) * 2 * SHM_V, pa0, pa1, pa2, pa3); \
    asm volatile("s_waitcnt lgkmcnt(0)" ::: "memory"); PD_BAR(); \
    { const int a_ = ks0; ks0 = ks1; ks1 = ks2; ks2 = a_; } } while (0)
  for (int j = 0; j < NT; j += 2) { PDSLOT(j, 0); PDSLOT(j + 1, 1); }
  asm volatile("s_waitcnt vmcnt(0)" ::: "memory");
  if (hi == 0) LX[e * 32 + r32] = l_reg;
  asm volatile("s_waitcnt lgkmcnt(0)" ::: "memory"); PD_BAR();
  float rli[16];
#pragma unroll
  for (int r = 0; r < 16; ++r) rli[r] = __builtin_amdgcn_rcpf(LX[crow(r, hi)] + LX[32 + crow(r, hi)]);
  typename Cfg::OutT* Ow = Ob + (long)(rg * QBLK) * LDO + e * (VW / 2);
#pragma unroll
  for (int r = 0; r < 16; ++r) { int orow = crow(r, hi);
#pragma unroll
    for (int d0 = 0; d0 < ND0; ++d0) store_o(Ow + (long)orow * LDO + d0 * 32 + r32, o[d0][r] * rli[r]); }
  asm volatile("s_waitcnt lgkmcnt(0)" ::: "memory"); PD_BAR();
#undef PD_DMA_K
#undef PD_DMA_V
#undef PD_BAR
#undef PDSLOT
}

template <class Cfg> struct Pa2Map { static constexpr int NROPE = Cfg::NROPE, NVH = Cfg::VW / 128;
  static constexpr int OFF_K = 0, OFF_KR = 3 * SHM_K, OFF_V = OFF_KR + (NROPE > 0 ? 3 * SHM_KR : 0), OFF_PX = OFF_V + 2 * NVH * SHM_V, OFF_AX = OFF_PX + 2 * 16384, OFF_LX = OFF_AX + 2048, BYTES = OFF_LX + 1024; };
template <class Cfg>
__device__ __forceinline__ void attn_unit_pa2(const bf16_t* __restrict__ Qb, const bf16_t* __restrict__ Kh, const bf16_t* __restrict__ Vh, const bf16_t* __restrict__ Qr, const bf16_t* __restrict__ Kr,
                                              typename Cfg::OutT* __restrict__ Ob, int seq, char* lds, ATT_LAS unsigned char* ldsl, const QNorm qn) {
  constexpr int LDQ = Cfg::LDQ, LDK = Cfg::LDK, LDV = Cfg::LDV, LDO = Cfg::LDO, LDKR = Cfg::LDKR, VW = Cfg::VW, NROPE = Cfg::NROPE, NVH = VW / 128, ND0 = VW / 64, NVP = 2 * NVH;
  typedef Pa2Map<Cfg> M;
  int tid = my_tid(); asm volatile("" : "+v"(tid));
  const int wid = __builtin_amdgcn_readfirstlane(tid >> 6), lane = tid & 63, r32 = lane & 31, hi = lane >> 5, rg = wid & 3, e = wid >> 2;
  char* K_lds = lds + M::OFF_K; char* KR_lds = lds + M::OFF_KR; char* V_lds = lds + M::OFF_V;
  char* PX = lds + M::OFF_PX + rg * 4096 + lane * 16;
  float* AX = (float*)(lds + M::OFF_AX) + rg * 64;
  float* LX = (float*)(lds + M::OFF_LX) + rg * 64;
  float m_reg = SM_NOSHIFT ? __builtin_bit_cast(float, __builtin_amdgcn_readfirstlane(__builtin_bit_cast(int, qn.shift))) : -1e30f, l_reg = 0; f32x16 o[ND0]; bf16x8 qr[8]; bf16x8 qrr[4];
  constexpr float QS = SM_NOSHIFT ? Cfg::SCALE * 1.4426950408889634f : 1.f;
#pragma unroll
  for (int d = 0; d < ND0; ++d) o[d] = f32x16{};
  const bf16_t* Qw = Qb + (long)(rg * QBLK + r32) * LDQ + hi * 8;
#pragma unroll
  for (int d0 = 0; d0 < 8; ++d0) qr[d0] = *reinterpret_cast<const bf16x8*>(Qw + d0 * 16);
#pragma unroll
  for (int d0 = 0; d0 < 4; ++d0) qrr[d0] = bf16x8{};
  if constexpr (NROPE > 0) { const bf16_t* Qrw = Qr + (long)(rg * QBLK + r32) * LDQ + hi * 8;
#pragma unroll
    for (int d0 = 0; d0 < 4; ++d0) qrr[d0] = *reinterpret_cast<const bf16x8*>(Qrw + d0 * 16); }
  if constexpr (Cfg::QNORM) {
    if constexpr (NROPE > 0) { qnorm_nope<false>(qr, qn.g, nullptr, nullptr, hi, QS); qnorm_rope(qrr, qn.g + 128, qn.cs + (rg * QBLK + r32) * 32, qn.sn + (rg * QBLK + r32) * 32, hi, QS); }
    else qnorm_nope<true>(qr, qn.g, qn.cs + (rg * QBLK + r32) * 16, qn.sn + (rg * QBLK + r32) * 16, hi, QS); }
  unsigned koff[2], voff[NVP], kroff = 0;
#pragma unroll
  for (int i = 0; i < 2; ++i) { const int q = wid * 2 + i, R = 4 * q + (lane >> 4), g = (lane & 15) ^ KX(R); koff[i] = (unsigned)(R * LDK * 2 + g * 16); }
#pragma unroll
  for (int i = 0; i < NVP; ++i) { const int qq = wid * NVP + i, vh = qq >> 4, q = qq & 15;
    const int kk = (q >> 1) * 8 + ((lane & 31) >> 2), k = (kk & ~0xC) | ((kk & 4) << 1) | ((kk & 8) >> 1), c = vh * 128 + (2 * (q & 1) + (lane >> 5)) * 32 + (lane & 3) * 8;
    voff[i] = (unsigned)(k * LDV * 2 + c * 2); }
  if constexpr (NROPE > 0) { const int R = 8 * wid + (lane >> 3), g = (lane & 7) ^ KRX(R); kroff = (unsigned)(R * LDKR * 2 + g * 16); }
  const int vb0 = (int)(uintptr_t)V_lds + v_rd_base(lane) + ((e * ND0) >> 2) * SHM_V + ((e * ND0) & 3) * 512;
#define P2_DMA_K(t, s) do { const char* kb_ = (const char*)Kh + (size_t)(t) * (KVBLK * LDK * 2); _Pragma("unroll") for (int i_ = 0; i_ < 2; ++i_) \
    __builtin_amdgcn_global_load_lds((const unsigned*)(kb_ + koff[i_]), (ATT_LAS unsigned*)(ldsl + M::OFF_K + (s) * SHM_K + (wid * 2 + i_) * 1024), 16, 0, 0); \
    if constexpr (NROPE > 0) { const char* rb_ = (const char*)Kr + (size_t)(t) * (KVBLK * LDKR * 2); \
      __builtin_amdgcn_global_load_lds((const unsigned*)(rb_ + kroff), (ATT_LAS unsigned*)(ldsl + M::OFF_KR + (s) * SHM_KR + wid * 1024), 16, 0, 0); } } while (0)
#define P2_DMA_V(t, s) do { const char* vb_ = (const char*)Vh + (size_t)(t) * (KVBLK * LDV * 2); _Pragma("unroll") for (int i_ = 0; i_ < NVP; ++i_) \
    __builtin_amdgcn_global_load_lds((const unsigned*)(vb_ + voff[i_]), (ATT_LAS unsigned*)(ldsl + M::OFF_V + (s) * NVH * SHM_V + (wid * NVP + i_) * 1024), 16, 0, 0); } while (0)
#define P2_BAR() do { __builtin_amdgcn_s_barrier(); asm volatile("" ::: "memory"); } while (0)
#define P2_PV(vs) do { if constexpr (ND0 == 4) pv_d0p(o, vb0 + (vs) * NVH * SHM_V, pa0, pa1, pa2, pa3); else pv_nd<ND0>(o, vb0 + (vs) * NVH * SHM_V, pa0, pa1, pa2, pa3); } while (0)
  f32x16 p0, p1; float mn, alpha; bf16x8 pa0, pa1, pa2, pa3; const int NT = seq / KVBLK;
  if (ATT_STATIC_PRIO && wid >= 4) __builtin_amdgcn_s_setprio(1);
  P2_DMA_K(0, 0); P2_DMA_K(1, 1); P2_DMA_K(2, 2);
  asm volatile("s_waitcnt vmcnt(0)" ::: "memory"); P2_BAR();
  if (e == 0) qkt_r<NROPE>(p0, p1, K_lds, KR_lds, qr, qrr, r32, hi);
  asm volatile("s_waitcnt lgkmcnt(0)" ::: "memory"); P2_BAR();
  int ks0 = 0, ks1 = 1;
#if SM_NOSHIFT
#define P2SEG(t, PE, FIRST) do { \
    { const int tk_ = (t) + 3 < NT ? (t) + 3 : NT - 1; P2_DMA_K(tk_, ks0); P2_DMA_V((t), (PE)); } \
    if (!(FIRST)) { \
      if (e == (PE)) { const char* px_ = PX + (1 - (PE)) * 16384; pa0 = *(const bf16x8*)(px_); pa1 = *(const bf16x8*)(px_ + 1024); pa2 = *(const bf16x8*)(px_ + 2048); pa3 = *(const bf16x8*)(px_ + 3072); } \
      P2_PV(1 - (PE)); } \
    if (e == (PE)) { partialSM_ns<Cfg>(p0, p1, m_reg, mn, alpha); finishSM<true>(p0, p1, alpha, l_reg, pa0, pa1, pa2, pa3); \
      { char* px_ = PX + (PE) * 16384; *(bf16x8*)(px_) = pa0; *(bf16x8*)(px_ + 1024) = pa1; *(bf16x8*)(px_ + 2048) = pa2; *(bf16x8*)(px_ + 3072) = pa3; } } \
    else { if ((t) + 1 < NT) qkt_r<NROPE>(p0, p1, K_lds + ks1 * SHM_K, KR_lds + ks1 * SHM_KR, qr, qrr, r32, hi); } \
    asm volatile("s_waitcnt vmcnt(0) lgkmcnt(0)" ::: "memory"); P2_BAR(); \
    { const int n_ = 3 - ks0 - ks1; ks0 = ks1; ks1 = n_; } } while (0)
#else
#define P2SEG(t, PE, FIRST) do { \
    { const int tk_ = (t) + 3 < NT ? (t) + 3 : NT - 1; P2_DMA_K(tk_, ks0); P2_DMA_V((t), (PE)); } \
    if (!(FIRST)) { const float al = AX[(1 - (PE)) * 256 + 2 * r32], mm = AX[(1 - (PE)) * 256 + 2 * r32 + 1]; \
      if (e == (PE)) { const char* px_ = PX + (1 - (PE)) * 16384; pa0 = *(const bf16x8*)(px_); pa1 = *(const bf16x8*)(px_ + 1024); pa2 = *(const bf16x8*)(px_ + 2048); pa3 = *(const bf16x8*)(px_ + 3072); m_reg = mm; l_reg *= al; } \
      if (__any(al < 1.f)) { _Pragma("unroll") for (int r = 0; r < 16; ++r) { const float ar = AX[(1 - (PE)) * 256 + 2 * crow(r, hi)]; _Pragma("unroll") for (int d = 0; d < ND0; ++d) o[d][r] *= ar; } } \
      P2_PV(1 - (PE)); } \
    if (e == (PE)) { partialSM<Cfg>(p0, p1, m_reg, mn, alpha); finishSM(p0, p1, alpha, l_reg, pa0, pa1, pa2, pa3); \
      { char* px_ = PX + (PE) * 16384; *(bf16x8*)(px_) = pa0; *(bf16x8*)(px_ + 1024) = pa1; *(bf16x8*)(px_ + 2048) = pa2; *(bf16x8*)(px_ + 3072) = pa3; } \
      if (hi == 0) { AX[(PE) * 256 + 2 * r32] = alpha; AX[(PE) * 256 + 2 * r32 + 1] = mn; } } \
    else { if ((t) + 1 < NT) qkt_r<NROPE>(p0, p1, K_lds + ks1 * SHM_K, KR_lds + ks1 * SHM_KR, qr, qrr, r32, hi); } \
    asm volatile("s_waitcnt vmcnt(0) lgkmcnt(0)" ::: "memory"); P2_BAR(); \
    { const int n_ = 3 - ks0 - ks1; ks0 = ks1; ks1 = n_; } } while (0)
#endif
  P2SEG(0, 0, true); P2SEG(1, 1, false);
  for (int t = 2; t < NT; t += 2) { P2SEG(t, 0, false); P2SEG(t + 1, 1, false); }
#if SM_NOSHIFT
  { if (e == 0) { const char* px_ = PX + 16384; pa0 = *(const bf16x8*)(px_); pa1 = *(const bf16x8*)(px_ + 1024); pa2 = *(const bf16x8*)(px_ + 2048); pa3 = *(const bf16x8*)(px_ + 3072); }
    P2_PV(1); }
  l_reg = hsum32(l_reg);
#else
  { const float al = AX[256 + 2 * r32], mm = AX[256 + 2 * r32 + 1];
    if (e == 0) { const char* px_ = PX + 16384; pa0 = *(const bf16x8*)(px_); pa1 = *(const bf16x8*)(px_ + 1024); pa2 = *(const bf16x8*)(px_ + 2048); pa3 = *(const bf16x8*)(px_ + 3072); m_reg = mm; l_reg *= al; }
    if (__any(al < 1.f)) {
#pragma unroll
      for (int r = 0; r < 16; ++r) { const float ar = AX[256 + 2 * crow(r, hi)];
#pragma unroll
        for (int d = 0; d < ND0; ++d) o[d][r] *= ar; } }
    P2_PV(1); }
#endif
  if (hi == 0) LX[e * 32 + r32] = l_reg;
  asm volatile("s_waitcnt lgkmcnt(0)" ::: "memory"); P2_BAR();
  float rli[16];
#pragma unroll
  for (int r = 0; r < 16; ++r) rli[r] = __builtin_amdgcn_rcpf(LX[crow(r, hi)] + LX[32 + crow(r, hi)]);
  typename Cfg::OutT* Ow = Ob + (long)(rg * QBLK) * LDO + e * (VW / 2);
#pragma unroll
  for (int r = 0; r < 16; ++r) { int orow = crow(r, hi);
#pragma unroll
    for (int d0 = 0; d0 < ND0; ++d0) store_o(Ow + (long)orow * LDO + d0 * 32 + r32, o[d0][r] * rli[r]); }
  if (ATT_STATIC_PRIO) __builtin_amdgcn_s_setprio(0);
  asm volatile("s_waitcnt lgkmcnt(0)" ::: "memory"); P2_BAR();
#undef P2_DMA_K
#undef P2_DMA_V
#undef P2_BAR
#undef P2_PV
#undef P2SEG
}

using f32x4 = __attribute__((ext_vector_type(4))) float;
template <int OFF> __device__ __forceinline__ bf16x8 k3_read(int a) { bf16x8 r; asm volatile("ds_read_b128 %0, %1 offset:%2" : "=&v"(r) : "v"(a), "i"(OFF) : "memory"); return r; }
template <int N> __device__ __forceinline__ void lgkm3_wait() { asm volatile("s_waitcnt lgkmcnt(%0)" :: "n"(N) : "memory"); }
template <int I> __device__ __forceinline__ void qk3_step(f32x4 (&sT)[2][4], bf16x8 (&f)[16], const int (&ka)[4], const bf16x8 (&qf)[2][4]) {
  if constexpr (I < 16) f[I] = k3_read<(I >> 2) * 4096>(ka[I & 3]);
  if constexpr (I >= 2) { constexpr int D = I - 2, W = (D + 2 < 16 ? 2 : 15 - D);
    lgkm3_wait<W>(); SBAR();
    sT[0][D >> 2] = __builtin_amdgcn_mfma_f32_16x16x32_bf16(f[D], qf[0][D & 3], sT[0][D >> 2], 0, 0, 0);
    sT[1][D >> 2] = __builtin_amdgcn_mfma_f32_16x16x32_bf16(f[D], qf[1][D & 3], sT[1][D >> 2], 0, 0, 0); SBAR(); }
  if constexpr (I + 1 < 18) qk3_step<I + 1>(sT, f, ka, qf);
}
template <int I> __device__ __forceinline__ void pv3_step(f32x4 (&o)[2][8], s16x4 (&vl)[16], s16x4 (&vh)[16], int vbe, int vbo, const bf16x8 (&pf)[4]) {
  if constexpr (I < 16) { constexpr int db = I >> 1, t = I & 1, OFF = t * 8192 + (db >> 1) * 512;
    vl[I] = tr_read<OFF>((db & 1) ? vbo : vbe); vh[I] = tr_read<OFF + 4096>((db & 1) ? vbo : vbe); }
  if constexpr (I >= 2) { constexpr int D = I - 2, db = D >> 1, t = D & 1, W = 2 * (D + 2 < 16 ? 2 : 15 - D);
    lgkm3_wait<W>(); SBAR();
    const bf16x8 vf = (bf16x8){vl[D][0], vl[D][1], vl[D][2], vl[D][3], vh[D][0], vh[D][1], vh[D][2], vh[D][3]};
    o[0][db] = __builtin_amdgcn_mfma_f32_16x16x32_bf16(vf, pf[t], o[0][db], 0, 0, 0);
    o[1][db] = __builtin_amdgcn_mfma_f32_16x16x32_bf16(vf, pf[2 + t], o[1][db], 0, 0, 0); SBAR(); }
  if constexpr (I + 1 < 18) pv3_step<I + 1>(o, vl, vh, vbe, vbo, pf);
}
template <class Cfg>
__device__ __forceinline__ void attn_unit_pa3(const bf16_t* __restrict__ Qb, const bf16_t* __restrict__ Kh, const bf16_t* __restrict__ Vh, typename Cfg::OutT* __restrict__ Ob, int seq, char* lds, ATT_LAS unsigned char* ldsl, const QNorm qn) {
  constexpr int LDQ = Cfg::LDQ, LDK = Cfg::LDK, LDV = Cfg::LDV, LDO = Cfg::LDO, VW = Cfg::VW, NVH = 2, NVP = 4;
  static_assert(VW == 256 && Cfg::NROPE == 0 && Cfg::QNORM, "attn_unit_pa3: 256 value columns, no rope, q normalised here");
  typedef Pa2Map<Cfg> M;
  int tid = my_tid(); asm volatile("" : "+v"(tid));
  const int wid = __builtin_amdgcn_readfirstlane(tid >> 6), lane = tid & 63, fr = lane & 15, fq = lane >> 4, rg = wid & 3, e = wid >> 2;
  char* K_lds = lds + M::OFF_K; char* V_lds = lds + M::OFF_V;
  char* PX = lds + M::OFF_PX + rg * 4096 + lane * 16;
  float* LX = (float*)(lds + M::OFF_LX) + rg * 64;
  const float shift = __builtin_bit_cast(float, __builtin_amdgcn_readfirstlane(__builtin_bit_cast(int, qn.shift)));
  constexpr float QS = Cfg::SCALE * 1.4426950408889634f;
  f32x4 o[2][8]; float lsum[2] = {0.f, 0.f}; bf16x8 qf[2][4];
#pragma unroll
  for (int qb = 0; qb < 2; ++qb)
#pragma unroll
    for (int db = 0; db < 8; ++db) o[qb][db] = (f32x4){0.f, 0.f, 0.f, 0.f};
  { const bf16_t* Qw = Qb + (long)(rg * 32 + fr) * LDQ + fq * 8;
#pragma unroll
    for (int qb = 0; qb < 2; ++qb)
#pragma unroll
      for (int s = 0; s < 4; ++s) qf[qb][s] = *reinterpret_cast<const bf16x8*>(Qw + (long)qb * 16 * LDQ + s * 32);
#pragma unroll
    for (int qb = 0; qb < 2; ++qb) { float ss = 0.f;
#pragma unroll
      for (int s = 0; s < 4; ++s) { float x[8]; up8(qf[qb][s], x);
#pragma unroll
        for (int t = 0; t < 8; ++t) ss += x[t] * x[t]; }
      ss += pg8::xshfl<16>(ss); ss = pg8::xadd32(ss);
      const float rstd = __builtin_amdgcn_rsqf(ss * (1.f / 128.f) + 1e-6f) * QS;
      { float x[8]; up8(qf[qb][0], x); const float* cp = qn.cs + (rg * 32 + qb * 16 + fr) * 16 + 8 * (fq & 1); const float* sp = qn.sn + (rg * 32 + qb * 16 + fr) * 16 + 8 * (fq & 1);
#pragma unroll
        for (int t = 0; t < 8; ++t) { const float v = x[t] * rstd * qn.g[8 * fq + t], pr = pg8::xswap32(v, lane), c = cp[t], sn_ = sp[t]; x[t] = (fq < 2) ? v * c - pr * sn_ : v * c + pr * sn_; }
        qf[qb][0] = pk8(x); }
#pragma unroll
      for (int s = 1; s < 4; ++s) { float x[8]; up8(qf[qb][s], x);
#pragma unroll
        for (int t = 0; t < 8; ++t) x[t] = x[t] * rstd * qn.g[32 * s + 8 * fq + t];
        qf[qb][s] = pk8(x); } } }
  unsigned koff[2], voff[NVP];
#pragma unroll
  for (int i = 0; i < 2; ++i) { const int q = wid * 2 + i, R = 4 * q + (lane >> 4), g = (lane & 15) ^ (R & 15); koff[i] = (unsigned)(R * LDK * 2 + g * 16); }
#pragma unroll
  for (int i = 0; i < NVP; ++i) { const int qq = wid * NVP + i, vh = qq >> 4, q = qq & 15;
    const int kk = (q >> 1) * 8 + ((lane & 31) >> 2), k = (kk & ~0xC) | ((kk & 4) << 1) | ((kk & 8) >> 1), c = vh * 128 + (2 * (q & 1) + (lane >> 5)) * 32 + ((lane & 3) ^ (2 * ((q >> 1) & 1))) * 8;
    voff[i] = (unsigned)(k * LDV * 2 + c * 2); }
  int kal[4];
#pragma unroll
  for (int s = 0; s < 4; ++s) kal[s] = (int)(uintptr_t)K_lds + fr * 256 + ((((s ^ (fr >> 2)) << 2) | ((fq ^ fr) & 3)) << 4);
  const int vcom = (int)(uintptr_t)V_lds + e * SHM_V + (fq & 1) * 2048 + (fq >> 1) * 256 + (fr >> 2) * 64 + (fr & 3) * 8;
  const int vbe0 = vcom + (fq & 1) * 32, vbo0 = vcom + (1 - (fq & 1)) * 32;
#define P3_DMA_K(t, s) do { const char* kb_ = (const char*)Kh + (size_t)(t) * (KVBLK * LDK * 2); _Pragma("unroll") for (int i_ = 0; i_ < 2; ++i_) \
    __builtin_amdgcn_global_load_lds((const unsigned*)(kb_ + koff[i_]), (ATT_LAS unsigned*)(ldsl + M::OFF_K + (s) * SHM_K + (wid * 2 + i_) * 1024), 16, 0, 0); } while (0)
#define P3_DMA_V(t, s) do { const char* vb_ = (const char*)Vh + (size_t)(t) * (KVBLK * LDV * 2); _Pragma("unroll") for (int i_ = 0; i_ < NVP; ++i_) \
    __builtin_amdgcn_global_load_lds((const unsigned*)(vb_ + voff[i_]), (ATT_LAS unsigned*)(ldsl + M::OFF_V + (s) * NVH * SHM_V + (wid * NVP + i_) * 1024), 16, 0, 0); } while (0)
#define P3_BAR() do { __builtin_amdgcn_s_barrier(); asm volatile("" ::: "memory"); } while (0)
#define P3_QK(slot) do { int ka_[4]; _Pragma("unroll") for (int s_ = 0; s_ < 4; ++s_) ka_[s_] = kal[s_] + (slot) * SHM_K; bf16x8 f_[16]; \
    _Pragma("unroll") for (int a_ = 0; a_ < 2; ++a_) _Pragma("unroll") for (int b_ = 0; b_ < 4; ++b_) sT[a_][b_] = (f32x4){0.f, 0.f, 0.f, 0.f}; \
    SBAR(); qk3_step<0>(sT, f_, ka_, qf); } while (0)
#define P3_PV(vs) do { s16x4 vl_[16], vh_[16]; SBAR(); pv3_step<0>(o, vl_, vh_, vbe0 + (vs) * NVH * SHM_V, vbo0 + (vs) * NVH * SHM_V, pf); } while (0)
#define P3_LDP(par) do { const char* px_ = PX + (par) * 16384; _Pragma("unroll") for (int i_ = 0; i_ < 4; ++i_) pf[i_] = *(const bf16x8*)(px_ + i_ * 1024); } while (0)
  f32x4 sT[2][4]; bf16x8 pf[4]; const int NT = seq / KVBLK;
  P3_DMA_K(0, 0); P3_DMA_K(1, 1); P3_DMA_K(2, 2);
  asm volatile("s_waitcnt vmcnt(0)" ::: "memory"); P3_BAR();
  if (e == 0) P3_QK(0);
  asm volatile("s_waitcnt lgkmcnt(0)" ::: "memory"); P3_BAR();
  int ks0 = 0, ks1 = 1;
#define P3SEG(t, PE, FIRST) do { \
    { const int tk_ = (t) + 3 < NT ? (t) + 3 : NT - 1; P3_DMA_K(tk_, ks0); P3_DMA_V((t), (PE)); } \
    if (!(FIRST)) { if (e == (PE)) P3_LDP(1 - (PE)); P3_PV(1 - (PE)); } \
    if (e == (PE)) { \
      if (__builtin_expect(shift != 0.f, 0)) { _Pragma("unroll") for (int a_ = 0; a_ < 2; ++a_) _Pragma("unroll") for (int b_ = 0; b_ < 4; ++b_) sT[a_][b_] = sT[a_][b_] - shift; } \
      _Pragma("unroll") for (int a_ = 0; a_ < 2; ++a_) { float ps_ = 0.f; \
        _Pragma("unroll") for (int b_ = 0; b_ < 4; ++b_) _Pragma("unroll") for (int r_ = 0; r_ < 4; ++r_) { sT[a_][b_][r_] = __builtin_amdgcn_exp2f(sT[a_][b_][r_]); ps_ += sT[a_][b_][r_]; } \
        lsum[a_] += ps_; \
        _Pragma("unroll") for (int t_ = 0; t_ < 2; ++t_) { u32x4 w_ = {cvtpk(sT[a_][2 * t_][0], sT[a_][2 * t_][1]), cvtpk(sT[a_][2 * t_][2], sT[a_][2 * t_][3]), cvtpk(sT[a_][2 * t_ + 1][0], sT[a_][2 * t_ + 1][1]), cvtpk(sT[a_][2 * t_ + 1][2], sT[a_][2 * t_ + 1][3])}; \
          pf[2 * a_ + t_] = *reinterpret_cast<bf16x8*>(&w_); } } \
      { char* px_ = PX + (PE) * 16384; _Pragma("unroll") for (int i_ = 0; i_ < 4; ++i_) *(bf16x8*)(px_ + i_ * 1024) = pf[i_]; } } \
    else { if ((t) + 1 < NT) P3_QK(ks1); } \
    asm volatile("s_waitcnt vmcnt(0) lgkmcnt(0)" ::: "memory"); P3_BAR(); \
    { const int n_ = 3 - ks0 - ks1; ks0 = ks1; ks1 = n_; } } while (0)
  P3SEG(0, 0, true); P3SEG(1, 1, false);
  for (int t = 2; t < NT; t += 2) { P3SEG(t, 0, false); P3SEG(t + 1, 1, false); }
  { if (e == 0) P3_LDP(1); P3_PV(1); }
#pragma unroll
  for (int qb = 0; qb < 2; ++qb) { float lw = lsum[qb]; lw += pg8::xshfl<16>(lw); lw = pg8::xadd32(lw); if (fq == 0) LX[e * 32 + qb * 16 + fr] = lw; }
  asm volatile("s_waitcnt lgkmcnt(0)" ::: "memory"); P3_BAR();
  int fre = fr, fqe = fq; asm volatile("" : "+v"(fre), "+v"(fqe));
  typename Cfg::OutT* Ow = Ob + (long)(rg * 32 + fre) * LDO + e * 128 + 4 * fqe;
#pragma unroll
  for (int qb = 0; qb < 2; ++qb) { const float rl = __builtin_amdgcn_rcpf(LX[qb * 16 + fre] + LX[32 + qb * 16 + fre]);
#pragma unroll
    for (int db = 0; db < 8; ++db) { typedef unsigned u32x2_ __attribute__((ext_vector_type(2)));
      u32x2_ w; w.x = cvtpk(o[qb][db][0] * rl, o[qb][db][1] * rl); w.y = cvtpk(o[qb][db][2] * rl, o[qb][db][3] * rl);
      *(u32x2_*)(Ow + (long)qb * 16 * LDO + db * 16) = w; } }
  asm volatile("s_waitcnt lgkmcnt(0)" ::: "memory"); P3_BAR();
#undef P3_DMA_K
#undef P3_DMA_V
#undef P3_BAR
#undef P3_QK
#undef P3_PV
#undef P3_LDP
#undef P3SEG
}

template <int I> __device__ __forceinline__ void qk3r_step(f32x4 (&sT)[2][4], bf16x8 (&f)[24], const int (&ka)[4], const int (&kra)[2], const bf16x8 (&qf)[2][6]) {
  if constexpr (I < 16) f[I] = k3_read<(I >> 2) * 4096>(ka[I & 3]);
  else if constexpr (I < 24) f[I] = k3_read<((I - 16) >> 1) * 2048>(kra[(I - 16) & 1]);
  if constexpr (I >= 2) { constexpr int D = I - 2, W = (D + 2 < 24 ? 2 : 23 - D), kb = D < 16 ? (D >> 2) : ((D - 16) >> 1), sq = D < 16 ? (D & 3) : 4 + ((D - 16) & 1);
    lgkm3_wait<W>(); SBAR();
    sT[0][kb] = __builtin_amdgcn_mfma_f32_16x16x32_bf16(f[D], qf[0][sq], sT[0][kb], 0, 0, 0);
    sT[1][kb] = __builtin_amdgcn_mfma_f32_16x16x32_bf16(f[D], qf[1][sq], sT[1][kb], 0, 0, 0); SBAR(); }
  if constexpr (I + 1 < 26) qk3r_step<I + 1>(sT, f, ka, kra, qf);
}
template <class Cfg>
__device__ __forceinline__ void attn_unit_dma3(const bf16_t* __restrict__ Qb, const bf16_t* __restrict__ Kh, const bf16_t* __restrict__ Vh, const bf16_t* __restrict__ Qr, const bf16_t* __restrict__ Kr,
                                               typename Cfg::OutT* __restrict__ Ob, int seq, char* lds, ATT_LAS unsigned char* ldsl, const QNorm qn, unsigned char* __restrict__ Ob8 = nullptr) {
  constexpr int LDQ = Cfg::LDQ, LDK = Cfg::LDK, LDV = Cfg::LDV, LDO = Cfg::LDO, LDKR = Cfg::LDKR;
  static_assert(Cfg::NROPE == 64 && Cfg::VW == 128 && Cfg::QNORM, "attn_unit_dma3: 128 + 64 q.k dims, 128 value columns, q normalised here");
  int tid = my_tid(); asm volatile("" : "+v"(tid));
  const int wid = __builtin_amdgcn_readfirstlane(tid >> 6), lane = tid & 63, fr = lane & 15, fq = lane >> 4;
  char* K_lds = lds + D_OFF_K; char* V_lds = lds + D_OFF_V; char* KR_lds = lds + D_OFF_KR;
  const float shift = __builtin_bit_cast(float, __builtin_amdgcn_readfirstlane(__builtin_bit_cast(int, qn.shift)));
  constexpr float QS = Cfg::SCALE * 1.4426950408889634f;
  f32x4 o[2][8]; float lsum[2] = {0.f, 0.f}; bf16x8 qf[2][6];
#pragma unroll
  for (int qb = 0; qb < 2; ++qb)
#pragma unroll
    for (int db = 0; db < 8; ++db) o[qb][db] = (f32x4){0.f, 0.f, 0.f, 0.f};
  { const bf16_t* Qw = Qb + (long)(wid * 32 + fr) * LDQ + fq * 8; const bf16_t* Qrw = Qr + (long)(wid * 32 + fr) * LDQ + fq * 8;
#pragma unroll
    for (int qb = 0; qb < 2; ++qb) {
#pragma unroll
      for (int s = 0; s < 4; ++s) qf[qb][s] = *reinterpret_cast<const bf16x8*>(Qw + (long)qb * 16 * LDQ + s * 32);
#pragma unroll
      for (int s = 0; s < 2; ++s) qf[qb][4 + s] = *reinterpret_cast<const bf16x8*>(Qrw + (long)qb * 16 * LDQ + s * 32); }
#pragma unroll
    for (int qb = 0; qb < 2; ++qb) { float ss = 0.f, sr = 0.f;
#pragma unroll
      for (int s = 0; s < 4; ++s) { float x[8]; up8(qf[qb][s], x);
#pragma unroll
        for (int t = 0; t < 8; ++t) ss += x[t] * x[t]; }
#pragma unroll
      for (int s = 4; s < 6; ++s) { float x[8]; up8(qf[qb][s], x);
#pragma unroll
        for (int t = 0; t < 8; ++t) sr += x[t] * x[t]; }
      ss += pg8::xshfl<16>(ss); ss = pg8::xadd32(ss); sr += pg8::xshfl<16>(sr); sr = pg8::xadd32(sr);
      const float rn = __builtin_amdgcn_rsqf(ss * (1.f / 128.f) + 1e-6f) * QS, rr = __builtin_amdgcn_rsqf(sr * (1.f / 64.f) + 1e-6f) * QS;
#pragma unroll
      for (int s = 0; s < 4; ++s) { float x[8]; up8(qf[qb][s], x);
#pragma unroll
        for (int t = 0; t < 8; ++t) x[t] = x[t] * rn * qn.g[32 * s + 8 * fq + t];
        qf[qb][s] = pk8(x); }
      { float u[8], w[8]; up8(qf[qb][4], u); up8(qf[qb][5], w); const float* cp = qn.cs + (wid * 32 + qb * 16 + fr) * 32 + 8 * fq; const float* sp = qn.sn + (wid * 32 + qb * 16 + fr) * 32 + 8 * fq;
#pragma unroll
        for (int t = 0; t < 8; ++t) { const float a = u[t] * rr * qn.g[128 + 8 * fq + t], b = w[t] * rr * qn.g[160 + 8 * fq + t], c = cp[t], sn_ = sp[t]; u[t] = a * c - b * sn_; w[t] = b * c + a * sn_; }
        qf[qb][4] = pk8(u); qf[qb][5] = pk8(w); } } }
  unsigned koff[2], voff[2], kroff;
#pragma unroll
  for (int i = 0; i < 2; ++i) { const int q = wid * 2 + i;
    { const int R = 4 * q + (lane >> 4), g = (lane & 15) ^ (R & 15); koff[i] = (unsigned)(R * LDK * 2 + g * 16); }
    { const int kk = (q >> 1) * 8 + ((lane & 31) >> 2), k = (kk & ~0xC) | ((kk & 4) << 1) | ((kk & 8) >> 1), c = (2 * (q & 1) + (lane >> 5)) * 32 + ((lane & 3) ^ (2 * ((q >> 1) & 1))) * 8;
      voff[i] = (unsigned)(k * LDV * 2 + c * 2); } }
  { const int R = 8 * wid + (lane >> 3), g = (lane & 7) ^ KRX(R); kroff = (unsigned)(R * LDKR * 2 + g * 16); }
  int kal[4], kral[2];
#pragma unroll
  for (int s = 0; s < 4; ++s) kal[s] = (int)(uintptr_t)K_lds + fr * 256 + ((((s ^ (fr >> 2)) << 2) | ((fq ^ fr) & 3)) << 4);
#pragma unroll
  for (int s = 0; s < 2; ++s) kral[s] = (int)(uintptr_t)KR_lds + fr * 128 + ((((4 * s + fq) ^ (fr >> 1)) & 7) << 4);
  const int vcom = (int)(uintptr_t)V_lds + (fq & 1) * 2048 + (fq >> 1) * 256 + (fr >> 2) * 64 + (fr & 3) * 8;
  const int vbe0 = vcom + (fq & 1) * 32, vbo0 = vcom + (1 - (fq & 1)) * 32;
#define D3_TILE(t, s) do { const char* kb_ = (const char*)Kh + (size_t)(t) * (KVBLK * LDK * 2); const char* vb_ = (const char*)Vh + (size_t)(t) * (KVBLK * LDV * 2); \
    _Pragma("unroll") for (int i_ = 0; i_ < 2; ++i_) { \
      __builtin_amdgcn_global_load_lds((const unsigned*)(kb_ + koff[i_]), (ATT_LAS unsigned*)(ldsl + D_OFF_K + (s) * SHM_K + (wid * 2 + i_) * 1024), 16, 0, 0); \
      __builtin_amdgcn_global_load_lds((const unsigned*)(vb_ + voff[i_]), (ATT_LAS unsigned*)(ldsl + D_OFF_V + (s) * SHM_V + (wid * 2 + i_) * 1024), 16, 0, 0); } \
    { const char* rb_ = (const char*)Kr + (size_t)(t) * (KVBLK * LDKR * 2); \
      __builtin_amdgcn_global_load_lds((const unsigned*)(rb_ + kroff), (ATT_LAS unsigned*)(ldsl + D_OFF_KR + (s) * SHM_KR + wid * 1024), 16, 0, 0); } } while (0)
  f32x4 sT[2][4]; bf16x8 pf[4]; const int NT = seq / KVBLK;
#define D3_K(t, s) do { const char* kb_ = (const char*)Kh + (size_t)(t) * (KVBLK * LDK * 2); const char* rb_ = (const char*)Kr + (size_t)(t) * (KVBLK * LDKR * 2); \
    _Pragma("unroll") for (int i_ = 0; i_ < 2; ++i_) __builtin_amdgcn_global_load_lds((const unsigned*)(kb_ + koff[i_]), (ATT_LAS unsigned*)(ldsl + D_OFF_K + (s) * SHM_K + (wid * 2 + i_) * 1024), 16, 0, 0); \
    __builtin_amdgcn_global_load_lds((const unsigned*)(rb_ + kroff), (ATT_LAS unsigned*)(ldsl + D_OFF_KR + (s) * SHM_KR + wid * 1024), 16, 0, 0); } while (0)
#define D3_V(t, s) do { const char* vb_ = (const char*)Vh + (size_t)(t) * (KVBLK * LDV * 2); \
    _Pragma("unroll") for (int i_ = 0; i_ < 2; ++i_) __builtin_amdgcn_global_load_lds((const unsigned*)(vb_ + voff[i_]), (ATT_LAS unsigned*)(ldsl + D_OFF_V + (s) * SHM_V + (wid * 2 + i_) * 1024), 16, 0, 0); } while (0)
#define D3_QK(slot) do { int ka_[4], kra_[2]; bf16x8 f_[24]; \
      _Pragma("unroll") for (int s_ = 0; s_ < 4; ++s_) ka_[s_] = kal[s_] + (slot) * SHM_K; \
      _Pragma("unroll") for (int s_ = 0; s_ < 2; ++s_) kra_[s_] = kral[s_] + (slot) * SHM_KR; \
      _Pragma("unroll") for (int a_ = 0; a_ < 2; ++a_) _Pragma("unroll") for (int b_ = 0; b_ < 4; ++b_) sT[a_][b_] = (f32x4){0.f, 0.f, 0.f, 0.f}; \
      SBAR(); qk3r_step<0>(sT, f_, ka_, kra_, qf); } while (0)
#define D3_SM() do { \
    if (__builtin_expect(shift != 0.f, 0)) { _Pragma("unroll") for (int a_ = 0; a_ < 2; ++a_) _Pragma("unroll") for (int b_ = 0; b_ < 4; ++b_) sT[a_][b_] = sT[a_][b_] - shift; } \
    _Pragma("unroll") for (int a_ = 0; a_ < 2; ++a_) { float ps_ = 0.f; \
      _Pragma("unroll") for (int b_ = 0; b_ < 4; ++b_) _Pragma("unroll") for (int r_ = 0; r_ < 4; ++r_) { sT[a_][b_][r_] = __builtin_amdgcn_exp2f(sT[a_][b_][r_]); ps_ += sT[a_][b_][r_]; } \
      lsum[a_] += ps_; \
      _Pragma("unroll") for (int t_ = 0; t_ < 2; ++t_) { u32x4 w_ = {cvtpk(sT[a_][2 * t_][0], sT[a_][2 * t_][1]), cvtpk(sT[a_][2 * t_][2], sT[a_][2 * t_][3]), cvtpk(sT[a_][2 * t_ + 1][0], sT[a_][2 * t_ + 1][1]), cvtpk(sT[a_][2 * t_ + 1][2], sT[a_][2 * t_ + 1][3])}; \
        pf[2 * a_ + t_] = *reinterpret_cast<bf16x8*>(&w_); } } } while (0)
#define D3_PV(slot) do { s16x4 vl_[16], vh_[16]; SBAR(); pv3_step<0>(o, vl_, vh_, vbe0 + (slot) * SHM_V, vbo0 + (slot) * SHM_V, pf); } while (0)
#if MLA_STAGGER
  const bool lead = wid < 4;
  D3_V(0, 0); D3_K(0, 0); D3_V(1, 1); D3_K(1, 1); D3_K(2, 2);
  asm volatile("s_waitcnt vmcnt(8)" ::: "memory"); __builtin_amdgcn_s_barrier(); asm volatile("" ::: "memory");
  int s0 = 0, s1 = 1, s2 = 2;
#define D3_BARBLK(t) do { if ((t) + 1 < NT) { \
      if ((t) + 2 < NT) asm volatile("s_waitcnt vmcnt(3) lgkmcnt(0)" ::: "memory"); else asm volatile("s_waitcnt vmcnt(0) lgkmcnt(0)" ::: "memory"); \
      __builtin_amdgcn_s_barrier(); asm volatile("" ::: "memory"); \
      if ((t) + 2 < NT) D3_V((t) + 2, s2); \
      if ((t) + 3 < NT) D3_K((t) + 3, s0); \
      { const int a_ = s0; s0 = s1; s1 = s2; s2 = a_; } } } while (0)
  for (int t = 0; t < NT; ++t) { const int sv = s0;
    D3_QK(s0); D3_SM();
    if (!lead) D3_BARBLK(t);
    D3_PV(sv);
    if (lead) D3_BARBLK(t);
  }
#undef D3_BARBLK
#else
  D3_TILE(0, 0); D3_TILE(1, 1); D3_TILE(2, 2);
  asm volatile("s_waitcnt vmcnt(10)" ::: "memory"); __builtin_amdgcn_s_barrier(); asm volatile("" ::: "memory");
  int s0 = 0, s1 = 1, s2 = 2;
  for (int t = 0; t < NT; ++t) {
    D3_QK(s0); D3_SM(); D3_PV(s0);
    if (t + 1 < NT) {
      if (t + 2 < NT) asm volatile("s_waitcnt vmcnt(5) lgkmcnt(0)" ::: "memory"); else asm volatile("s_waitcnt vmcnt(0) lgkmcnt(0)" ::: "memory");
      __builtin_amdgcn_s_barrier(); asm volatile("" ::: "memory");
      if (t + 3 < NT) D3_TILE(t + 3, s0);
      { const int a_ = s0; s0 = s1; s1 = s2; s2 = a_; } }
  }
#endif
#undef D3_K
#undef D3_V
#undef D3_QK
#undef D3_SM
#undef D3_PV
  int fre = fr, fqe = fq; asm volatile("" : "+v"(fre), "+v"(fqe));
  typename Cfg::OutT* Ow = Ob + (long)(wid * 32 + fre) * LDO + 4 * fqe;
  unsigned char* Ow8 = Ob8 + (long)(wid * 32 + fre) * LDO + 4 * fqe;
#pragma unroll
  for (int qb = 0; qb < 2; ++qb) { float lw = lsum[qb]; lw += pg8::xshfl<16>(lw); lw = pg8::xadd32(lw); const float rl = __builtin_amdgcn_rcpf(lw);
    if (Ob8) { const float r8 = rl * 16.f;
#pragma unroll
      for (int db = 0; db < 8; ++db) { int e = 0; e = __builtin_amdgcn_cvt_pk_fp8_f32(o[qb][db][0] * r8, o[qb][db][1] * r8, e, false); e = __builtin_amdgcn_cvt_pk_fp8_f32(o[qb][db][2] * r8, o[qb][db][3] * r8, e, true);
        *(unsigned*)(Ow8 + (long)qb * 16 * LDO + db * 16) = (unsigned)e; } }
    else {
#pragma unroll
    for (int db = 0; db < 8; ++db) { typedef unsigned u32x2_ __attribute__((ext_vector_type(2)));
      u32x2_ w; w.x = cvtpk(o[qb][db][0] * rl, o[qb][db][1] * rl); w.y = cvtpk(o[qb][db][2] * rl, o[qb][db][3] * rl);
      *(u32x2_*)(Ow + (long)qb * 16 * LDO + db * 16) = w; } } }
  asm volatile("s_waitcnt lgkmcnt(0)" ::: "memory"); __builtin_amdgcn_s_barrier(); asm volatile("" ::: "memory");
#undef D3_TILE
}

template <int I, int NDB> __device__ __forceinline__ void pv3w_step(f32x4 (&o)[2][NDB], s16x4 (&vl)[2 * NDB], s16x4 (&vh)[2 * NDB], int vbe, int vbo, const bf16x8 (&pf)[4]) {
  constexpr int NST = 2 * NDB;
  if constexpr (I < NST) { constexpr int db = I >> 1, t = I & 1, OFF = (db >> 3) * 16384 + t * 8192 + ((db & 7) >> 1) * 512;
    vl[I] = tr_read<OFF>((db & 1) ? vbo : vbe); vh[I] = tr_read<OFF + 4096>((db & 1) ? vbo : vbe); }
  if constexpr (I >= PV_LA) { constexpr int D = I - PV_LA, db = D >> 1, t = D & 1, W = 2 * (D + PV_LA < NST ? PV_LA : NST - 1 - D);
    lgkm3_wait<W>(); SBAR();
    const bf16x8 vf = (bf16x8){vl[D][0], vl[D][1], vl[D][2], vl[D][3], vh[D][0], vh[D][1], vh[D][2], vh[D][3]};
    o[0][db] = __builtin_amdgcn_mfma_f32_16x16x32_bf16(vf, pf[t], o[0][db], 0, 0, 0);
    o[1][db] = __builtin_amdgcn_mfma_f32_16x16x32_bf16(vf, pf[2 + t], o[1][db], 0, 0, 0); SBAR(); }
  if constexpr (I + 1 < NST + PV_LA) pv3w_step<I + 1, NDB>(o, vl, vh, vbe, vbo, pf);
}
template <class Cfg>
__device__ __forceinline__ void attn_unit_dma3d(const bf16_t* __restrict__ Qb, const bf16_t* __restrict__ Kh, const bf16_t* __restrict__ Vh, typename Cfg::OutT* __restrict__ Ob, int seq, char* lds, ATT_LAS unsigned char* ldsl, const QNorm qn) {
  constexpr int LDQ = Cfg::LDQ, LDK = Cfg::LDK, LDV = Cfg::LDV, LDO = Cfg::LDO;
  constexpr int W_OFF_K = 0, W_OFF_V = 3 * SHM_K;
  static_assert(Cfg::NROPE == 0 && Cfg::VW == 256 && Cfg::QNORM, "attn_unit_dma3d: 128 q.k dims, 256 value columns, q normalised here");
  int tid = my_tid(); asm volatile("" : "+v"(tid));
  const int wid = __builtin_amdgcn_readfirstlane(tid >> 6), lane = tid & 63, fr = lane & 15, fq = lane >> 4;
  char* K_lds = lds + W_OFF_K; char* V_lds = lds + W_OFF_V;
  const float shift = __builtin_bit_cast(float, __builtin_amdgcn_readfirstlane(__builtin_bit_cast(int, qn.shift)));
  constexpr float QS = Cfg::SCALE * 1.4426950408889634f;
  f32x4 o[2][16]; float lsum[2] = {0.f, 0.f}; bf16x8 qf[2][4];
#pragma unroll
  for (int qb = 0; qb < 2; ++qb)
#pragma unroll
    for (int db = 0; db < 16; ++db) o[qb][db] = (f32x4){0.f, 0.f, 0.f, 0.f};
  { const bf16_t* Qw = Qb + (long)(wid * 32 + fr) * LDQ + fq * 8;
#pragma unroll
    for (int qb = 0; qb < 2; ++qb)
#pragma unroll
      for (int s = 0; s < 4; ++s) qf[qb][s] = *reinterpret_cast<const bf16x8*>(Qw + (long)qb * 16 * LDQ + s * 32);
#pragma unroll
    for (int qb = 0; qb < 2; ++qb) { float ss = 0.f;
#pragma unroll
      for (int s = 0; s < 4; ++s) { float x[8]; up8(qf[qb][s], x);
#pragma unroll
        for (int t = 0; t < 8; ++t) ss += x[t] * x[t]; }
      ss += pg8::xshfl<16>(ss); ss = pg8::xadd32(ss);
      const float rstd = __builtin_amdgcn_rsqf(ss * (1.f / 128.f) + 1e-6f) * QS;
      { float x[8]; up8(qf[qb][0], x); const float* cp = qn.cs + (wid * 32 + qb * 16 + fr) * 16 + 8 * (fq & 1); const float* sp = qn.sn + (wid * 32 + qb * 16 + fr) * 16 + 8 * (fq & 1);
#pragma unroll
        for (int t = 0; t < 8; ++t) { const float v = x[t] * rstd * qn.g[8 * fq + t], pr = pg8::xswap32(v, lane), c = cp[t], sn_ = sp[t]; x[t] = (fq < 2) ? v * c - pr * sn_ : v * c + pr * sn_; }
        qf[qb][0] = pk8(x); }
#pragma unroll
      for (int s = 1; s < 4; ++s) { float x[8]; up8(qf[qb][s], x);
#pragma unroll
        for (int t = 0; t < 8; ++t) x[t] = x[t] * rstd * qn.g[32 * s + 8 * fq + t];
        qf[qb][s] = pk8(x); } } }
  unsigned koff[2], voff[4];
#pragma unroll
  for (int i = 0; i < 2; ++i) { const int q = wid * 2 + i, R = 4 * q + (lane >> 4), g = (lane & 15) ^ (R & 15); koff[i] = (unsigned)(R * LDK * 2 + g * 16); }
#pragma unroll
  for (int i = 0; i < 4; ++i) { const int qq = wid * 4 + i, vh = qq >> 4, q = qq & 15;
    const int kk = (q >> 1) * 8 + ((lane & 31) >> 2), k = (kk & ~0xC) | ((kk & 4) << 1) | ((kk & 8) >> 1), c = vh * 128 + (2 * (q & 1) + (lane >> 5)) * 32 + ((lane & 3) ^ (2 * ((q >> 1) & 1))) * 8;
    voff[i] = (unsigned)(k * LDV * 2 + c * 2); }
  int kal[4];
#pragma unroll
  for (int s = 0; s < 4; ++s) kal[s] = (int)(uintptr_t)K_lds + fr * 256 + ((((s ^ (fr >> 2)) << 2) | ((fq ^ fr) & 3)) << 4);
  const int vcom = (int)(uintptr_t)V_lds + (fq & 1) * 2048 + (fq >> 1) * 256 + (fr >> 2) * 64 + (fr & 3) * 8;
  const int vbe0 = vcom + (fq & 1) * 32, vbo0 = vcom + (1 - (fq & 1)) * 32;
#define W3_TILE(t, s) do { const char* kb_ = (const char*)Kh + (size_t)(t) * (KVBLK * LDK * 2); const char* vb_ = (const char*)Vh + (size_t)(t) * (KVBLK * LDV * 2); \
    _Pragma("unroll") for (int i_ = 0; i_ < 2; ++i_) \
      __builtin_amdgcn_global_load_lds((const unsigned*)(kb_ + koff[i_]), (ATT_LAS unsigned*)(ldsl + W_OFF_K + (s) * SHM_K + (wid * 2 + i_) * 1024), 16, 0, 0); \
    _Pragma("unroll") for (int i_ = 0; i_ < 4; ++i_) \
      __builtin_amdgcn_global_load_lds((const unsigned*)(vb_ + voff[i_]), (ATT_LAS unsigned*)(ldsl + W_OFF_V + (s) * 2 * SHM_V + (wid * 4 + i_) * 1024), 16, 0, 0); } while (0)
  f32x4 sT[2][4]; bf16x8 pf[4]; const int NT = seq / KVBLK;
#define W3_K(t, s) do { const char* kb_ = (const char*)Kh + (size_t)(t) * (KVBLK * LDK * 2); _Pragma("unroll") for (int i_ = 0; i_ < 2; ++i_) \
      __builtin_amdgcn_global_load_lds((const unsigned*)(kb_ + koff[i_]), (ATT_LAS unsigned*)(ldsl + W_OFF_K + (s) * SHM_K + (wid * 2 + i_) * 1024), 16, 0, 0); } while (0)
#define W3_V(t, s) do { const char* vb_ = (const char*)Vh + (size_t)(t) * (KVBLK * LDV * 2); _Pragma("unroll") for (int i_ = 0; i_ < 4; ++i_) \
      __builtin_amdgcn_global_load_lds((const unsigned*)(vb_ + voff[i_]), (ATT_LAS unsigned*)(ldsl + W_OFF_V + (s) * 2 * SHM_V + (wid * 4 + i_) * 1024), 16, 0, 0); } while (0)
#define W3_QK(slot) do { int ka_[4]; bf16x8 f_[16]; _Pragma("unroll") for (int s_ = 0; s_ < 4; ++s_) ka_[s_] = kal[s_] + (slot) * SHM_K; \
      _Pragma("unroll") for (int a_ = 0; a_ < 2; ++a_) _Pragma("unroll") for (int b_ = 0; b_ < 4; ++b_) sT[a_][b_] = (f32x4){0.f, 0.f, 0.f, 0.f}; \
      SBAR(); qk3_step<0>(sT, f_, ka_, qf); } while (0)
#define W3_SM() do { \
    if (__builtin_expect(shift != 0.f, 0)) { _Pragma("unroll") for (int a_ = 0; a_ < 2; ++a_) _Pragma("unroll") for (int b_ = 0; b_ < 4; ++b_) sT[a_][b_] = sT[a_][b_] - shift; } \
    _Pragma("unroll") for (int a_ = 0; a_ < 2; ++a_) { float ps_ = 0.f; \
      _Pragma("unroll") for (int b_ = 0; b_ < 4; ++b_) _Pragma("unroll") for (int r_ = 0; r_ < 4; ++r_) { sT[a_][b_][r_] = __builtin_amdgcn_exp2f(sT[a_][b_][r_]); ps_ += sT[a_][b_][r_]; } \
      lsum[a_] += ps_; \
      _Pragma("unroll") for (int t_ = 0; t_ < 2; ++t_) { u32x4 w_ = {cvtpk(sT[a_][2 * t_][0], sT[a_][2 * t_][1]), cvtpk(sT[a_][2 * t_][2], sT[a_][2 * t_][3]), cvtpk(sT[a_][2 * t_ + 1][0], sT[a_][2 * t_ + 1][1]), cvtpk(sT[a_][2 * t_ + 1][2], sT[a_][2 * t_ + 1][3])}; \
        pf[2 * a_ + t_] = *reinterpret_cast<bf16x8*>(&w_); } } } while (0)
#define W3_PV(slot) do { s16x4 vl_[32], vh_[32]; SBAR(); pv3w_step<0, 16>(o, vl_, vh_, vbe0 + (slot) * 2 * SHM_V, vbo0 + (slot) * 2 * SHM_V, pf); } while (0)
#if ATT_STAGGER
  const bool lead = wid < 4;
  W3_V(0, 0); W3_K(0, 0); W3_V(1, 1); W3_K(1, 1); W3_K(2, 2);
  asm volatile("s_waitcnt vmcnt(8)" ::: "memory"); __builtin_amdgcn_s_barrier(); asm volatile("" ::: "memory");
  int s0 = 0, s1 = 1, s2 = 2;
#define W3_BARBLK(t) do { if ((t) + 1 < NT) { \
      if ((t) + 2 < NT) asm volatile("s_waitcnt vmcnt(2) lgkmcnt(0)" ::: "memory"); else asm volatile("s_waitcnt vmcnt(0) lgkmcnt(0)" ::: "memory"); \
      __builtin_amdgcn_s_barrier(); asm volatile("" ::: "memory"); \
      if ((t) + 2 < NT) W3_V((t) + 2, s2); \
      if ((t) + 3 < NT) W3_K((t) + 3, s0); \
      { const int a_ = s0; s0 = s1; s1 = s2; s2 = a_; } } } while (0)
  for (int t = 0; t < NT; ++t) { const int sv = s0;
    W3_QK(s0); W3_SM();
    if (!lead) W3_BARBLK(t);
    W3_PV(sv);
    if (lead) W3_BARBLK(t);
  }
#undef W3_BARBLK
#else
  W3_TILE(0, 0); W3_TILE(1, 1); W3_TILE(2, 2);
  asm volatile("s_waitcnt vmcnt(12)" ::: "memory"); __builtin_amdgcn_s_barrier(); asm volatile("" ::: "memory");
  int s0 = 0, s1 = 1, s2 = 2;
  for (int t = 0; t < NT; ++t) {
    W3_QK(s0); W3_SM(); W3_PV(s0);
    if (t + 1 < NT) {
      if (t + 2 < NT) asm volatile("s_waitcnt vmcnt(6) lgkmcnt(0)" ::: "memory"); else asm volatile("s_waitcnt vmcnt(0) lgkmcnt(0)" ::: "memory");
      __builtin_amdgcn_s_barrier(); asm volatile("" ::: "memory");
      if (t + 3 < NT) W3_TILE(t + 3, s0);
      { const int a_ = s0; s0 = s1; s1 = s2; s2 = a_; } }
  }
#endif
#undef W3_K
#undef W3_V
#undef W3_QK
#undef W3_SM
#undef W3_PV
  int fre = fr, fqe = fq; asm volatile("" : "+v"(fre), "+v"(fqe));
  typename Cfg::OutT* Ow = Ob + (long)(wid * 32 + fre) * LDO + 4 * fqe;
#pragma unroll
  for (int qb = 0; qb < 2; ++qb) { float lw = lsum[qb]; lw += pg8::xshfl<16>(lw); lw = pg8::xadd32(lw); const float rl = __builtin_amdgcn_rcpf(lw);
#pragma unroll
    for (int db = 0; db < 16; ++db) { typedef unsigned u32x2_ __attribute__((ext_vector_type(2)));
      u32x2_ w; w.x = cvtpk(o[qb][db][0] * rl, o[qb][db][1] * rl); w.y = cvtpk(o[qb][db][2] * rl, o[qb][db][3] * rl);
      *(u32x2_*)(Ow + (long)qb * 16 * LDO + db * 16) = w; } }
  asm volatile("s_waitcnt lgkmcnt(0)" ::: "memory"); __builtin_amdgcn_s_barrier(); asm volatile("" ::: "memory");
#undef W3_TILE
}

#undef KSWZ
#undef KRSWZ
#undef KX
#undef KRX
#undef SBAR
}

#define GAS __attribute__((address_space(1)))
#define LAS __attribute__((address_space(3)))
typedef unsigned short bf16;
typedef unsigned v4u __attribute__((ext_vector_type(4)));
typedef unsigned v2u __attribute__((ext_vector_type(2)));
typedef float f32x4 __attribute__((ext_vector_type(4)));
#define LDS_WAIT() asm volatile("s_waitcnt lgkmcnt(0)" ::: "memory")
#define VM_WAIT() asm volatile("s_waitcnt vmcnt(0)" ::: "memory")

#ifndef TR_AUX
#define TR_AUX 2
#endif
constexpr int NWAVES = 8;
constexpr int BATCH = 2, SEQ = 4096, DM = 4096, FF = 16384, MT = BATCH * SEQ;
constexpr int DEPTH = 4, PLED = 256;
constexpr int DIFF_IN = 12288;
constexpr int MLA_IN = 1600, MLA_INP = 1792, MLA_QR = 1024, MLA_KVR = 512, MLA_Q = 6144, MLA_KV = 8192;
constexpr float EPS = 1e-6f;

constexpr size_t MiB = (size_t)1 << 20;
constexpr size_t WS_CTL = 0, CTL_ZERO_BYTES = 1 * MiB;
constexpr size_t WS_LAM = 1 * MiB;
constexpr size_t WS_COSD = 2 * MiB, WS_SIND = WS_COSD + MiB / 2, WS_COSM = 3 * MiB, WS_SINM = 4 * MiB;
constexpr size_t WS_W1T = 8 * MiB;
constexpr size_t WS_W2T = WS_W1T + 512 * MiB;
constexpr size_t WS_WGT = WS_W2T + 512 * MiB;
constexpr size_t WS_WPT = WS_WGT + 128 * MiB;
constexpr size_t WS_DWIN = WS_WPT + 8 * MiB;
constexpr size_t WS_DWOUT = WS_DWIN + 192 * MiB;
constexpr size_t WS_MWIN = WS_DWOUT + 64 * MiB;
constexpr size_t WS_MWUQ = WS_MWIN + 28 * MiB;
constexpr size_t WS_MWUKV = WS_MWUQ + 24 * MiB;
constexpr size_t WS_MWOUT = WS_MWUKV + 16 * MiB;
constexpr size_t WS_HN = WS_MWOUT + 64 * MiB;
constexpr size_t WS_Z = WS_HN + 64 * MiB;
constexpr size_t WS_ZM = WS_Z + 192 * MiB;
constexpr size_t WS_CQN = WS_ZM + 56 * MiB;
constexpr size_t WS_CKVN = WS_CQN + 16 * MiB;
constexpr size_t WS_KR = WS_CKVN + 8 * MiB;
constexpr size_t WS_QM = WS_KR + 4 * MiB;
constexpr size_t WS_KVM = WS_QM + 96 * MiB;
constexpr size_t WS_OPART = WS_KVM + 128 * MiB;
constexpr size_t WS_OB = WS_OPART + 256 * MiB;
constexpr size_t WS_ACT = WS_OB + 64 * MiB;
constexpr size_t WS_PLE = WS_ACT + 256 * MiB;
constexpr size_t WS_PB = WS_PLE + 64 * MiB;
constexpr size_t WS_XB1 = WS_PB + 16 * MiB;
constexpr size_t WS_SS = WS_XB1 + 64 * MiB;
constexpr size_t WS_X8 = WS_SS + 26 * MiB;
constexpr size_t WS_OB8 = WS_X8 + 32 * MiB;
constexpr size_t WS_END = WS_OB8 + 32 * MiB;
constexpr int CW_BAR = 4096;

constexpr int SCR_BYTES = 151552;
constexpr int LDSCTL_OFF = SCR_BYTES, MISC_OFF = LDSCTL_OFF + 320;
constexpr int LDS_BYTES = 155648;
static_assert(MISC_OFF + 128 <= LDS_BYTES && 8 * 16640 <= SCR_BYTES && att::LDS_BYTES <= SCR_BYTES && att::PA_LDS_BYTES <= SCR_BYTES && att::DMA_LDS_BYTES <= SCR_BYTES && att::PAD_LDS_BYTES <= SCR_BYTES && pg8::STAGE_BYTES <= SCR_BYTES, "LDS map");

#define XB_TMO      128
#define XB_XCNT(j)  (256  + 64 * (j))
#define XB_XSUB(j)  (1280 + 64 * (j))
#define XB_XGEN(j)  (2304 + 64 * (j))
#define XB_TOP      3328
#define XB_TOPGEN   3392
#define XCD_BAR_WORDS 3456
#define XB_SPIN_CAP (1u << 18)

__device__ __forceinline__ unsigned xb_ld(unsigned* p)              { return __hip_atomic_load(p, __ATOMIC_RELAXED, __HIP_MEMORY_SCOPE_AGENT); }
__device__ __forceinline__ unsigned xb_add(unsigned* p, unsigned v) { return __hip_atomic_fetch_add(p, v, __ATOMIC_RELAXED, __HIP_MEMORY_SCOPE_AGENT); }
__device__ __forceinline__ unsigned xb_xcc_id() { return (unsigned)__builtin_amdgcn_s_getreg((3 << 11) | 20) & 0xFu; }
#define XB_SPIN(cond, bar) do { unsigned _sp = 0; while (cond) { __builtin_amdgcn_s_sleep(1); \
    if ((++_sp & 255u) == 0u) { if (xb_ld(&(bar)[XB_TMO])) break; if (_sp > XB_SPIN_CAP) { atomicAdd(&(bar)[XB_TMO], 1u); break; } } } } while (0)

struct XcdBarrier {
    unsigned* bar; unsigned x;
    volatile LAS unsigned* st;
};

__device__ __forceinline__ XcdBarrier xcd_barrier_post(unsigned* bar, volatile LAS unsigned* st) {
    XcdBarrier b; b.bar = bar; b.x = xb_xcc_id(); b.st = st;
    if (my_tid() == 0) (void)xb_add(&bar[XB_XCNT(b.x)], 1u);
    return b;
}
__device__ __forceinline__ void xcd_barrier_complete(unsigned* bar, unsigned x, unsigned& nloc, unsigned& nx) {
    const unsigned G = gridDim.x * gridDim.y * gridDim.z;
    unsigned sum, cnt, mine, sp = 0u;
    for (;;) {
        sum = 0u; cnt = 0u; mine = 0u;
#pragma unroll
        for (unsigned j = 0; j < 16; ++j) { const unsigned c = xb_ld(&bar[XB_XCNT(j)]); sum += c; cnt += (c > 0u) ? 1u : 0u; mine = (j == x) ? c : mine; }
        if (sum == G) break;
        __builtin_amdgcn_s_sleep(1);
        if ((++sp & 255u) == 0u) { if (xb_ld(&bar[XB_TMO])) break; if (sp > XB_SPIN_CAP) { atomicAdd(&bar[XB_TMO], 1u); break; } }
    }
    nloc = mine > 0u ? mine : 1u; nx = cnt > 0u ? cnt : 1u;
}

__device__ __forceinline__ void xcd_barrier(const XcdBarrier& b) {
    asm volatile("s_waitcnt vmcnt(0)" ::: "memory");
    __syncthreads();
    if (my_tid() == 0) {
        unsigned* bar = b.bar;
        __builtin_amdgcn_s_waitcnt(0);
        unsigned nloc = b.st[0], nx = b.st[1];
        if (nloc == 0u) { xcd_barrier_complete(bar, b.x, nloc, nx); b.st[0] = nloc; b.st[1] = nx; }
        const unsigned old = xb_add(&bar[XB_XSUB(b.x)], 1u);
        const unsigned gen = old / nloc;
        if (old + 1u == (gen + 1u) * nloc) {
            __builtin_amdgcn_fence(__ATOMIC_RELEASE, "agent");
            asm volatile("s_waitcnt vmcnt(0)" ::: "memory");
            const unsigned og = xb_add(&bar[XB_TOP], 1u);
            const unsigned tg = og / nx;
            if (og + 1u == (tg + 1u) * nx) xb_add(&bar[XB_TOPGEN], 1u);
            else XB_SPIN(xb_ld(&bar[XB_TOPGEN]) == tg, bar);
            __builtin_amdgcn_fence(__ATOMIC_ACQUIRE, "agent");
            xb_add(&bar[XB_XGEN(b.x)], 1u);
            asm volatile("s_waitcnt vmcnt(0)" ::: "memory");
        } else {
            XB_SPIN(xb_ld(&bar[XB_XGEN(b.x)]) == gen, bar);
            __builtin_amdgcn_fence(__ATOMIC_ACQUIRE, "agent");
            asm volatile("s_waitcnt vmcnt(0)" ::: "memory");
        }
    }
    __syncthreads();
}

__device__ __forceinline__ float wave_sum(float v) {
    v += pg8::xshfl<1>(v); v += pg8::xshfl<2>(v); v += pg8::xshfl<4>(v); v += pg8::xshfl<8>(v); v += pg8::xshfl<16>(v);
    return pg8::xadd32(v);
}
__device__ __forceinline__ float wave_max(float v) {
    v = fmaxf(v, pg8::xshfl<1>(v)); v = fmaxf(v, pg8::xshfl<2>(v)); v = fmaxf(v, pg8::xshfl<4>(v)); v = fmaxf(v, pg8::xshfl<8>(v)); v = fmaxf(v, pg8::xshfl<16>(v));
    const unsigned u = __builtin_bit_cast(unsigned, v); auto r = __builtin_amdgcn_permlane32_swap(u, u, false, false);
    return fmaxf(__builtin_bit_cast(float, (unsigned)r[0]), __builtin_bit_cast(float, (unsigned)r[1]));
}
__device__ __forceinline__ unsigned f2bf(float f) { unsigned u = __builtin_bit_cast(unsigned, f); return (u + 0x7fffu + ((u >> 16) & 1u)) >> 16; }
__device__ __forceinline__ unsigned pk2(float lo, float hi) { return pg8::cvt_pk_bf16(lo, hi); }
__device__ __forceinline__ float bflo(unsigned w) { return __uint_as_float(w << 16); }
__device__ __forceinline__ float bfhi(unsigned w) { return __uint_as_float(w & 0xffff0000u); }
__device__ __forceinline__ void unpack8(v4u r, float (&x)[8]) { x[0] = bflo(r.x); x[1] = bfhi(r.x); x[2] = bflo(r.y); x[3] = bfhi(r.y); x[4] = bflo(r.z); x[5] = bfhi(r.z); x[6] = bflo(r.w); x[7] = bfhi(r.w); }
__device__ __forceinline__ v4u pack8(const float (&y)[8]) { v4u o; o.x = pk2(y[0], y[1]); o.y = pk2(y[2], y[3]); o.z = pk2(y[4], y[5]); o.w = pk2(y[6], y[7]); return o; }
__device__ __forceinline__ double d_exp(double x) {
    const double n = __builtin_rint(x * 1.4426950408889634), r = x - n * 0.6931471805599453094;
    double t = 1.0, s = 1.0;
#pragma nounroll
    for (int k = 1; k <= 15; ++k) { t *= r / (double)k; s += t; }
    const long long e = (long long)n + 1023;
    return s * __builtin_bit_cast(double, (unsigned long long)e << 52);
}
__device__ __forceinline__ void d_sincos_small(double x, double& sn, double& cs) {
    const double x2 = x * x; double tc = 1.0, ts = x; cs = 1.0; sn = x;
#pragma nounroll
    for (int k = 1; k <= 11; ++k) { tc *= -x2 / (double)((2 * k - 1) * (2 * k)); ts *= -x2 / (double)((2 * k) * (2 * k + 1)); cs += tc; sn += ts; }
}
__device__ __forceinline__ void rope_cs(int pos, double inv, float& c_out, float& s_out) {
    double zs, zc; d_sincos_small(inv, zs, zc);
    double rc = 1.0, rs = 0.0; unsigned p = pos < 0 ? (unsigned)(-pos) : (unsigned)pos;
    while (p) { if (p & 1u) { const double t = rc * zc - rs * zs; rs = rc * zs + rs * zc; rc = t; }
        const double t2 = zc * zc - zs * zs; zs = 2.0 * zc * zs; zc = t2; p >>= 1; }
    c_out = (float)rc; s_out = (float)(pos < 0 ? -rs : rs);
}

__device__ __forceinline__ void transpose_items(const float* __restrict__ W, bf16* __restrict__ WT, int K, int N, int NP, int Lyr, const float* __restrict__ gain, int gmul, int gadd, LAS float* scr, int gw, int ngw, int lane_in, bool f8 = false) {
    int lane = lane_in; asm volatile("" : "+v"(lane));
    const int nkt = K >> 6, nnt = N >> 6, items = Lyr * nkt * nnt;
    const int c = lane & 7, nn = lane >> 3;
    const int rl = lane >> 4, gp = lane & 15;
    for (int it = gw; it < items; it += ngw) {
        const int nt = it % nnt, t2 = it / nnt, kt = t2 % nkt, l = t2 / nkt;
        const char* src = (const char*)(W + (size_t)l * K * N + (size_t)(kt * 64 + rl) * N + nt * 64);
#pragma unroll
        for (int p = 0; p < 16; ++p) { const int g = gp ^ ((p >> 1) & 7);
            __builtin_amdgcn_global_load_lds((const unsigned*)(src + (size_t)(4 * p) * N * 4 + g * 16), (LAS unsigned*)((LAS unsigned char*)scr + p * 1024), 16, 0, TR_AUX); }
        float gv[8];
        if (gain) { const float* gpn = gain + (size_t)(l * gmul + gadd) * DM + kt * 64 + 8 * c;
#pragma unroll
            for (int t = 0; t < 8; ++t) gv[t] = gpn[t]; }
        else {
#pragma unroll
            for (int t = 0; t < 8; ++t) gv[t] = 1.f; }
        asm volatile("s_waitcnt vmcnt(0)" ::: "memory");
        if (f8) { unsigned char* dst8 = (unsigned char*)WT + (size_t)l * NP * K + (size_t)(nt * 64) * K + kt * 64;
#pragma unroll
            for (int s = 0; s < 8; ++s) { const int n = s * 8 + nn; const LAS float* sp = scr + (8 * c) * 64 + (((n >> 2) ^ c) << 2) + (n & 3);
                int e0 = 0, e1 = 0;
                e0 = __builtin_amdgcn_cvt_pk_fp8_f32(sp[0 * 64] * gv[0] * 128.f, sp[1 * 64] * gv[1] * 128.f, e0, false); e0 = __builtin_amdgcn_cvt_pk_fp8_f32(sp[2 * 64] * gv[2] * 128.f, sp[3 * 64] * gv[3] * 128.f, e0, true);
                e1 = __builtin_amdgcn_cvt_pk_fp8_f32(sp[4 * 64] * gv[4] * 128.f, sp[5 * 64] * gv[5] * 128.f, e1, false); e1 = __builtin_amdgcn_cvt_pk_fp8_f32(sp[6 * 64] * gv[6] * 128.f, sp[7 * 64] * gv[7] * 128.f, e1, true);
                v2u o8; o8.x = (unsigned)e0; o8.y = (unsigned)e1; *(v2u*)(dst8 + (size_t)n * K + 8 * c) = o8; }
            LDS_WAIT(); continue; }
        bf16* dst = WT + (size_t)l * NP * K + (size_t)(nt * 64) * K + kt * 64;
#pragma unroll
        for (int s = 0; s < 8; ++s) { const int n = s * 8 + nn; const LAS float* sp = scr + (8 * c) * 64 + (((n >> 2) ^ c) << 2) + (n & 3);
            v4u o; o.x = pk2(sp[0 * 64] * gv[0], sp[1 * 64] * gv[1]); o.y = pk2(sp[2 * 64] * gv[2], sp[3 * 64] * gv[3]); o.z = pk2(sp[4 * 64] * gv[4], sp[5 * 64] * gv[5]); o.w = pk2(sp[6 * 64] * gv[6], sp[7 * 64] * gv[7]);
            *(v4u*)(dst + (size_t)n * K + 8 * c) = o; }
        LDS_WAIT();
    }
}
__device__ __forceinline__ void xb_rows(const float* __restrict__ X, bf16* __restrict__ out, float* __restrict__ ss, int gw, int ngw, int lane_in) {
    int lane = lane_in; asm volatile("" : "+v"(lane));
    for (int row = gw; row < MT; row += ngw) {
        const f32x4* xr = (const f32x4*)(X + (size_t)row * DM) + lane;
        f32x4 v[16]; float s = 0.f;
#pragma unroll
        for (int j = 0; j < 16; ++j) { v[j] = xr[64 * j]; s += (v[j].x * v[j].x + v[j].y * v[j].y) + (v[j].z * v[j].z + v[j].w * v[j].w); }
        s = wave_sum(s); ss[(size_t)row * 64 + lane] = (lane == 0) ? s : 0.f;
        v2u* o8 = (v2u*)(out + (size_t)row * DM) + lane;
#pragma unroll
        for (int j = 0; j < 16; ++j) { v2u w; w.x = pk2(v[j].x, v[j].y); w.y = pk2(v[j].z, v[j].w); o8[64 * j] = w; }
    }
}
__device__ __forceinline__ void diff_k_norm_rope(bf16* __restrict__ Z, const float* __restrict__ gk, const float* __restrict__ cosd, const float* __restrict__ sind, int gw, int ngw, int lane_in) {
    int lane = lane_in; asm volatile("" : "+v"(lane));
    const int li = lane & 15;
    float gkv[8];
#pragma unroll
    for (int t = 0; t < 8; ++t) gkv[t] = gk[li * 8 + t];
    for (int row = gw; row < MT; row += ngw) {
        v4u* zr = (v4u*)(Z + (size_t)row * DIFF_IN + 4096 + (lane >> 4) * 128 + li * 8);
        v4u raw[8];
#pragma unroll
        for (int it = 0; it < 8; ++it) raw[it] = zr[it * 64];
        float cs[8], sn[8];
#pragma unroll
        for (int t = 0; t < 8; ++t) { cs[t] = cosd[row * 16 + (li & 1) * 8 + t]; sn[t] = sind[row * 16 + (li & 1) * 8 + t]; }
#pragma unroll
        for (int it = 0; it < 8; ++it) {
            float x[8]; unpack8(raw[it], x);
            float ss = 0.f;
#pragma unroll
            for (int t = 0; t < 8; ++t) ss += x[t] * x[t];
            ss += pg8::xshfl<1>(ss); ss += pg8::xshfl<2>(ss); ss += pg8::xshfl<4>(ss); ss += pg8::xshfl<8>(ss);
            const float rstd = __builtin_amdgcn_rsqf(ss * (1.f / 128.f) + EPS);
            float y[8];
#pragma unroll
            for (int t = 0; t < 8; ++t) y[t] = x[t] * rstd * gkv[t];
#pragma unroll
            for (int t = 0; t < 8; ++t) { const float pr = pg8::xshfl<2>(y[t]);
                const float r1 = y[t] * cs[t] - pr * sn[t], r2 = y[t] * cs[t] + pr * sn[t];
                y[t] = (li < 2) ? r1 : ((li < 4) ? r2 : y[t]); }
            zr[it * 64] = pack8(y);
        }
    }
}
__device__ __forceinline__ void diff_combine(const bf16* __restrict__ OP, const float* __restrict__ lamp, const float* __restrict__ gsub, float om, bf16* __restrict__ OBo, int gw, int ngw, int lane_in) {
    int lane = lane_in; asm volatile("" : "+v"(lane));
    const float lam = *lamp; const int li = lane & 15, hg = lane >> 4;
    float gs[16];
#pragma unroll
    for (int k = 0; k < 16; ++k) gs[k] = gsub[li * 16 + k];
    for (int row = gw; row < MT; row += ngw) {
        const v4u* a0 = (const v4u*)(OP + (size_t)row * DM) + hg * 32 + li * 2; const v4u* a1 = (const v4u*)(OP + (size_t)MT * DM + (size_t)row * DM) + hg * 32 + li * 2;
        v4u va[4][2], vb[4][2];
#pragma unroll
        for (int it = 0; it < 4; ++it)
#pragma unroll
            for (int k = 0; k < 2; ++k) { va[it][k] = a0[it * 128 + k]; vb[it][k] = a1[it * 128 + k]; }
        v4u* o8 = (v4u*)(OBo + (size_t)row * DM) + hg * 32 + li * 2;
#pragma unroll
        for (int it = 0; it < 4; ++it) { float o[16]; float ss = 0.f;
#pragma unroll
            for (int k = 0; k < 2; ++k) { float x[8], y[8]; unpack8(va[it][k], x); unpack8(vb[it][k], y);
#pragma unroll
                for (int t = 0; t < 8; ++t) { const float v = x[t] - y[t] * lam; o[8 * k + t] = v; ss += v * v; } }
            ss += pg8::xshfl<1>(ss); ss += pg8::xshfl<2>(ss); ss += pg8::xshfl<4>(ss); ss += pg8::xshfl<8>(ss);
            const float rstd = om * __builtin_amdgcn_rsqf(ss * (1.f / 256.f) + EPS);
#pragma unroll
            for (int k = 0; k < 2; ++k) { float y[8];
#pragma unroll
                for (int t = 0; t < 8; ++t) y[t] = o[8 * k + t] * rstd * gs[8 * k + t];
                o8[it * 128 + k] = pack8(y); } }
    }
}
__device__ __forceinline__ void diff_combine_pair(const bf16* __restrict__ OP, size_t row0, int h, const float* __restrict__ lamp, const float* __restrict__ gsub, float om, bf16* __restrict__ OBo, int wave, int lane_in) {
    int lane = lane_in; asm volatile("" : "+v"(lane));
    const float lam = *lamp; const int li = lane & 15, rq = lane >> 4;
    float gs[16];
#pragma unroll
    for (int k = 0; k < 16; ++k) gs[k] = gsub[li * 16 + k];
    const size_t e0 = (row0 + (size_t)(wave * 4 + rq)) * DM + (size_t)h * 256 + li * 16;
    v4u va[4][2], vb[4][2];
#pragma unroll
    for (int st = 0; st < 4; ++st)
#pragma unroll
        for (int k = 0; k < 2; ++k) { va[st][k] = *(const v4u*)(OP + e0 + (size_t)st * 32 * DM + 8 * k); vb[st][k] = *(const v4u*)(OP + (size_t)MT * DM + e0 + (size_t)st * 32 * DM + 8 * k); }
#pragma unroll
    for (int st = 0; st < 4; ++st) { float o[16]; float ss = 0.f;
#pragma unroll
        for (int k = 0; k < 2; ++k) { float x[8], y[8]; unpack8(va[st][k], x); unpack8(vb[st][k], y);
#pragma unroll
            for (int t = 0; t < 8; ++t) { const float v = x[t] - y[t] * lam; o[8 * k + t] = v; ss += v * v; } }
        ss += pg8::xshfl<1>(ss); ss += pg8::xshfl<2>(ss); ss += pg8::xshfl<4>(ss); ss += pg8::xshfl<8>(ss);
        const float rstd = om * __builtin_amdgcn_rsqf(ss * (1.f / 256.f) + EPS);
#pragma unroll
        for (int k = 0; k < 2; ++k) { float y[8];
#pragma unroll
            for (int t = 0; t < 8; ++t) y[t] = o[8 * k + t] * rstd * gs[8 * k + t];
            *(v4u*)(OBo + e0 + (size_t)st * 32 * DM + 8 * k) = pack8(y); } }
}
__device__ __forceinline__ void mla_norm1(const float* __restrict__ ZMp, const float* __restrict__ gcq, const float* __restrict__ gckv, const float* __restrict__ gk, const float* __restrict__ cosm, const float* __restrict__ sinm,
                                          bf16* __restrict__ CQ, bf16* __restrict__ CKV, bf16* __restrict__ KRo, int gw, int ngw, int lane_in) {
    int lane = lane_in; asm volatile("" : "+v"(lane));
    const float gkr = gk[128 + lane];
    for (int row = gw; row < MT; row += ngw) {
        const float* zr = ZMp + (size_t)row * MLA_INP;
        f32x4 a[4], b[2]; float sa = 0.f, sb = 0.f;
#pragma unroll
        for (int j = 0; j < 4; ++j) { a[j] = ((const f32x4*)zr)[lane + 64 * j]; sa += (a[j].x * a[j].x + a[j].y * a[j].y) + (a[j].z * a[j].z + a[j].w * a[j].w); }
#pragma unroll
        for (int j = 0; j < 2; ++j) { b[j] = ((const f32x4*)(zr + MLA_QR))[lane + 64 * j]; sb += (b[j].x * b[j].x + b[j].y * b[j].y) + (b[j].z * b[j].z + b[j].w * b[j].w); }
        const float kx = zr[MLA_QR + MLA_KVR + lane];
        const float ra = 1.0f / sqrtf(wave_sum(sa) * (1.f / MLA_QR) + EPS), rb = 1.0f / sqrtf(wave_sum(sb) * (1.f / MLA_KVR) + EPS), rk = 1.0f / sqrtf(wave_sum(kx * kx) * (1.f / 64.f) + EPS);
        v2u* oa = (v2u*)(CQ + (size_t)row * MLA_QR) + lane; v2u* ob = (v2u*)(CKV + (size_t)row * MLA_KVR) + lane;
#pragma unroll
        for (int j = 0; j < 4; ++j) { const f32x4 g = ((const f32x4*)gcq)[lane + 64 * j]; v2u w; w.x = pk2(a[j].x * ra * g.x, a[j].y * ra * g.y); w.y = pk2(a[j].z * ra * g.z, a[j].w * ra * g.w); oa[64 * j] = w; }
#pragma unroll
        for (int j = 0; j < 2; ++j) { const f32x4 g = ((const f32x4*)gckv)[lane + 64 * j]; v2u w; w.x = pk2(b[j].x * rb * g.x, b[j].y * rb * g.y); w.y = pk2(b[j].z * rb * g.z, b[j].w * rb * g.w); ob[64 * j] = w; }
        const float y = kx * rk * gkr, pr = pg8::xswap32(y, lane), c = cosm[row * 32 + (lane & 31)], s = sinm[row * 32 + (lane & 31)];
        KRo[(size_t)row * 64 + lane] = (bf16)f2bf(lane < 32 ? y * c - pr * s : y * c + pr * s);
    }
}
__device__ __forceinline__ void mla_norm2(bf16* __restrict__ KVMp, const float* __restrict__ gk, int gw, int ngw, int lane_in) {
    int lane = lane_in; asm volatile("" : "+v"(lane));
    const int li = lane & 15;
    float gkn[8];
#pragma unroll
    for (int t = 0; t < 8; ++t) gkn[t] = gk[li * 8 + t];
    for (int row = gw; row < MT; row += ngw) {
        bf16* kr = KVMp + (size_t)row * MLA_KV;
        v4u rk[8];
#pragma unroll
        for (int it = 0; it < 8; ++it) { const int head = it * 4 + (lane >> 4); rk[it] = *(const v4u*)(kr + head * 256 + li * 8); }
#pragma unroll
        for (int it = 0; it < 8; ++it) {
            const int head = it * 4 + (lane >> 4);
            float z[8]; unpack8(rk[it], z);
            float sk = 0.f;
#pragma unroll
            for (int t = 0; t < 8; ++t) sk += z[t] * z[t];
            sk += pg8::xshfl<1>(sk); sk += pg8::xshfl<2>(sk); sk += pg8::xshfl<4>(sk); sk += pg8::xshfl<8>(sk);
            const float r2 = __builtin_amdgcn_rsqf(sk * (1.f / 128.f) + EPS);
#pragma unroll
            for (int t = 0; t < 8; ++t) z[t] = z[t] * r2 * gkn[t];
            *(v4u*)(kr + head * 256 + li * 8) = pack8(z);
        }
    }
}

#ifndef FUSE_KNORM_D
#define FUSE_KNORM_D 1
#endif
#ifndef FUSE_KNORM_M
#define FUSE_KNORM_M 1
#endif
#ifndef RES_BF16
#define RES_BF16 1
#endif
#ifndef STAGGER_CONV
#define STAGGER_CONV 1
#endif
#ifndef DIFF_PA
#define DIFF_PA 1
#endif
#ifndef DIFF_PAD
#define DIFF_PAD 2
#endif
#ifndef MLA_PA
#define MLA_PA 0
#endif
#ifndef DIFF_WIDE
#define DIFF_WIDE 1
#endif
#ifndef MLA_MFMA16
#define MLA_MFMA16 1
#endif
#if MLA_MFMA16
#define MLA_BODY attn_unit_dma3
#else
#define MLA_BODY attn_unit_dma
#endif
#ifndef DIFF_MFMA16
#define DIFF_MFMA16 1
#endif
#ifndef MLA_F8
#define MLA_F8 1
#endif
#ifndef GATE_F8
#define GATE_F8 1
#endif
#ifndef FUSE_COMBINE
#define FUSE_COMBINE 1
#endif
#ifndef DIFF_PVPIPE
#define DIFF_PVPIPE 1
#endif
#ifndef MLA_PVPIPE
#define MLA_PVPIPE 0
#endif
#ifndef ATT_DMA
#define ATT_DMA 1
#endif
#ifndef MLA_SDEPTH
#define MLA_SDEPTH 1
#endif
struct DiffCfg { static constexpr int LDQ = DIFF_IN, LDK = DIFF_IN, LDV = DIFF_IN, LDO = DM, LDKR = 64, NROPE = 0, SDEPTH = 2, VW = 256, PVPIPE = DIFF_PVPIPE; static constexpr bool QNORM = true; static constexpr float SCALE = 0.08838834764831845f; typedef bf16 OutT; };
struct MlaCfg  { static constexpr int LDQ = MLA_Q, LDK = MLA_KV, LDV = MLA_KV, LDO = DM, LDKR = 64, NROPE = 64, SDEPTH = MLA_SDEPTH, VW = 128, PVPIPE = MLA_PVPIPE; static constexpr bool QNORM = true; static constexpr float SCALE = 0.07216878364870323f; typedef bf16 OutT; };

__constant__ int TKIND[10][9] = {
    {6, 4096, 16384, 16384, 4, (int)(WS_W1T / MiB), 4, 1, 0}, {7, 16384, 4096, 4096, 4, (int)(WS_W2T / MiB), -1, 0, 0}, {8, 4096, 4096, 4096, 4, (int)(WS_WGT / MiB), 5, 1, 0}, {9, 256, 4096, 4096, 4, (int)(WS_WPT / MiB), -1, 0, 0},
    {10, 4096, 12288, 12288, 2, (int)(WS_DWIN / MiB), 3, 2, 0}, {11, 4096, 4096, 4096, 2, (int)(WS_DWOUT / MiB), -1, 0, 0}, {16, 4096, 1600, 1792, 2, (int)(WS_MWIN / MiB), 3, 2, 1}, {19, 1024, 6144, 6144, 2, (int)(WS_MWUQ / MiB), -1, 0, 0},
    {20, 512, 8192, 8192, 2, (int)(WS_MWUKV / MiB), -1, 0, 0}, {23, 4096, 4096, 4096, 2, (int)(WS_MWOUT / MiB), -1, 0, 0} };

__device__ __forceinline__ void xbar_fresh(const XcdBarrier& b) { XcdBarrier c = b; asm volatile("" : "+s"(c.bar)); asm volatile("" : "+s"(c.x)); xcd_barrier(c); }
#ifdef PROBE_BARX2
#define XBAR(b) do { xbar_fresh(b); xbar_fresh(b); } while (0)
#else
#define XBAR(b) xbar_fresh(b)
#endif
struct Args { const void* in[24]; float* out; unsigned char* ws; };

typedef const __attribute__((address_space(4))) unsigned char* kptr_t;
struct Ph { kptr_t kp; unsigned char* ws; float* X; int G, bx, vcu, gw, ngw, lane, tid; };
__device__ __forceinline__ Ph ph_begin() {
    Ph p; kptr_t kp = (kptr_t)__builtin_amdgcn_kernarg_segment_ptr(); asm volatile("" : "+s"(kp)); p.kp = kp;
    p.ws = *(unsigned char* const __attribute__((address_space(4)))*)(kp + 200); p.X = *(float* const __attribute__((address_space(4)))*)(kp + 192);
    int G = gridDim.x; asm volatile("" : "+s"(G)); int tid = my_tid(); asm volatile("" : "+v"(tid));
    int bxx = blockIdx.x; asm volatile("" : "+s"(bxx));
    p.G = G; p.bx = bxx; p.vcu = (G % 8 == 0) ? (p.bx % 8) * (G / 8) + p.bx / 8 : p.bx;
    p.tid = tid; p.lane = tid & 63; p.gw = p.vcu * NWAVES + __builtin_amdgcn_readfirstlane(tid >> 6); p.ngw = G * NWAVES;
    return p;
}
__device__ __forceinline__ const float* kin(const Ph& p, int k) { return *(const float* const __attribute__((address_space(4)))*)(p.kp + 8 * k); }
static_assert(sizeof(Args) == 208, "Args layout (kernarg offsets 8k, out at 192, ws at 200)");

#ifndef GEMM_ALIGN
#define GEMM_ALIGN true
#endif
#ifndef GEMM_SP2
#define GEMM_SP2 true
#endif
#ifdef SKIP_GEMM
#define GEMM_PHASE(EPI_T, EPI_OBJ, APTR, BPTR, MM, NN, KK) do {} while (0)
#else
#define GEMM_PHASE(EPI_T, EPI_OBJ, APTR, BPTR, MM, NN, KK) do { pg8::Gemm g_{(const pg8::bf16_t*)(APTR), (const pg8::bf16_t*)(BPTR), (MM), (NN), (KK)}; pg8::StaticOrder S_; S_.init((MM), (NN), P.G, P.bx); \
    const EPI_T E_ = EPI_OBJ; pg8::gemm_phase<EPI_T, pg8::StaticOrder, GEMM_ALIGN, GEMM_SP2>(L, g_, S_, E_); } while (0)
#define GEMM_PHASE_F8(EPI_T, EPI_OBJ, APTR, BPTR, MM, NN, KK) do { pg8::Gemm g_{(const pg8::bf16_t*)(APTR), (const pg8::bf16_t*)(BPTR), (MM), (NN), (KK)}; pg8::StaticOrder S_; S_.init((MM), (NN), P.G, P.bx); \
    const EPI_T E_ = EPI_OBJ; pg8::gemm_phase<EPI_T, pg8::StaticOrder, GEMM_ALIGN, GEMM_SP2, true>(L, g_, S_, E_); } while (0)
#endif
#define WSP(T, OFF) ((T*)(P.ws + (OFF)))
constexpr int RSTAB_OFF = LDSCTL_OFF + 1024;
static_assert(RSTAB_OFF + 1024 <= LDS_BYTES && RSTAB_OFF >= MISC_OFF + 128, "rstd table in spare LDS");
__device__ __forceinline__ pg8::RowScale rstd_table(const float* ssp, LAS unsigned char* L, const Ph& P, int M, int N) {
    LAS float* tab = (LAS float*)(L + RSTAB_OFF); pg8::RowScale r; r.tab = tab; r.ss = ssp; r.pm_tab = -1;
    pg8::StaticOrder S; S.init(M, N, P.G, P.bx); pg8::Unit u;
    if (S.next(0, u)) {
        const int t = P.tid, h = t & 1; const f32x4* p = (const f32x4*)(ssp + (size_t)(u.pm * 256 + (t >> 1)) * 64 + h * 32);
        f32x4 v[8];
#pragma unroll
        for (int k = 0; k < 8; ++k) v[k] = p[k];
        float s = 0.f;
#pragma unroll
        for (int k = 0; k < 8; ++k) s += (v[k][0] + v[k][1]) + (v[k][2] + v[k][3]);
        s += pg8::xshfl<1>(s);
        if (h == 0) tab[t >> 1] = 1.0f / sqrtf(s * (1.f / DM) + EPS);
        __syncthreads();
        r.pm_tab = u.pm;
    }
    return r;
}
#define SINGLE_ARG(...) __VA_ARGS__
constexpr int XT_OFF = 131072;
static_assert(XT_OFF >= pg8::STAGE_BYTES && XT_OFF + 8192 <= SCR_BYTES, "xt table");

__device__ __forceinline__ void convert_layer(const Ph& P, LAS unsigned char* L, int layer, int which = 0) {
    LAS float* scr = (LAS float*)(L + __builtin_amdgcn_readfirstlane(P.tid >> 6) * 16384);
    for (int kind = 0; kind < 10; ++kind) {
        const int ii = TKIND[kind][0], K = TKIND[kind][1], N = TKIND[kind][2], NP = TKIND[kind][3], Ly = TKIND[kind][4], gi = TKIND[kind][6], gmul = TKIND[kind][7], gadd = TKIND[kind][8]; const size_t off = (size_t)TKIND[kind][5] * MiB;
        const float* W = kin(P, ii); bf16* WT = (bf16*)(P.ws + off); const float* gain = gi >= 0 ? kin(P, gi) : (const float*)nullptr;
        const bool f8 = (GATE_F8 && kind == 2) || (MLA_F8 && kind == 9);
        if (layer < 0) { transpose_items(W, WT, K, N, NP, Ly, gain, gmul, gadd, scr, P.gw, P.ngw, P.lane, f8); continue; }
        int l;
        if (kind < 4) l = layer; else if (kind < 6) { if (layer & 1) continue; l = layer >> 1; } else { if (!(layer & 1)) continue; l = layer >> 1; }
        if (which) { const bool first = (kind == 4 || kind == 6); if ((which == 1) != first) continue; }
        transpose_items(W + (size_t)l * K * N, f8 ? (bf16*)((unsigned char*)WT + (size_t)l * NP * K) : WT + (size_t)l * NP * K, K, N, NP, 1, gain, 0, l * gmul + gadd, scr, P.gw, P.ngw, P.lane, f8);
    }
}
__device__ __forceinline__ void ph_prologue(LAS unsigned char* L) {
    const Ph P = ph_begin();
    const int wave = __builtin_amdgcn_readfirstlane(P.tid >> 6);
#ifndef SKIP_TR
    if (STAGGER_CONV) convert_layer(P, L, 0, 1); else convert_layer(P, L, -1);
#endif
    const int gt = P.vcu * (NWAVES * 64) + P.tid, ngt = P.G * NWAVES * 64;
    for (int idx = gt; idx < 2 * (MLA_INP - MLA_IN) * DM / 8; idx += ngt) { const int l = idx / ((MLA_INP - MLA_IN) * DM / 8), r = idx % ((MLA_INP - MLA_IN) * DM / 8);
        *(v4u*)(WSP(bf16, WS_MWIN) + (size_t)l * MLA_INP * DM + (size_t)MLA_IN * DM + (size_t)r * 8) = (v4u){0u, 0u, 0u, 0u}; }
    { const float* p = kin(P, 1); bf16* pb = WSP(bf16, WS_PB);
      for (int idx = gt; idx < DEPTH * MT * PLED / 8; idx += ngt) { const f32x4 u0 = ((const f32x4*)p)[2 * (size_t)idx], u1 = ((const f32x4*)p)[2 * (size_t)idx + 1];
          v4u o; o.x = pk2(u0.x, u0.y); o.y = pk2(u0.z, u0.w); o.z = pk2(u1.x, u1.y); o.w = pk2(u1.z, u1.w); ((v4u*)pb)[idx] = o; } }
    { const int* positions = (const int*)kin(P, 2); float* cosd = WSP(float, WS_COSD); float* sind = WSP(float, WS_SIND); float* cosm = WSP(float, WS_COSM); float* sinm = WSP(float, WS_SINM);
      for (int idx = gt; idx < MT * 48; idx += ngt) { const int row = idx / 48, f = idx % 48; const int pos = positions[row];
        float c, s;
        if (f < 16) { rope_cs(pos, d_exp(-(double)(2 * f) / 32.0 * 13.122363377404328), c, s); cosd[row * 16 + f] = c; sind[row * 16 + f] = s; }
        else { const int f2 = f - 16; rope_cs(pos, d_exp(-(double)(2 * f2) / 64.0 * 13.122363377404328), c, s); cosm[row * 32 + f2] = c; sinm[row * 32 + f2] = s; } } }
    if (P.bx == 0 && wave == 0) { float* lamf = WSP(float, WS_LAM); const int lane = P.lane;
        for (int j = 0; j < 2; ++j) { const float* lm = kin(P, 14) + j * 4 * 128;
            const float s1 = wave_sum(lm[lane] * lm[128 + lane] + lm[64 + lane] * lm[192 + lane]), s2 = wave_sum(lm[256 + lane] * lm[384 + lane] + lm[320 + lane] * lm[448 + lane]);
            const double linit = (j == 0) ? 0.2 : 0.47071301834358416;
            if (lane == 0) lamf[j] = (float)(d_exp((double)s1) - d_exp((double)s2) + linit); }
        for (int j = 0; j < 2; ++j) { const float* gq = kin(P, 12) + j * 128; const float* gk = kin(P, 13) + j * 128; const float* mq = kin(P, 21) + j * 192; const float* mk = kin(P, 22) + j * 192;
            const float a = wave_max(fmaxf(fabsf(gq[lane]), fabsf(gq[64 + lane]))), b = wave_max(fmaxf(fabsf(gk[lane]), fabsf(gk[64 + lane])));
            const float an = wave_max(fmaxf(fabsf(mq[lane]), fabsf(mq[64 + lane]))), ar = wave_max(fabsf(mq[128 + lane])), bn = wave_max(fmaxf(fabsf(mk[lane]), fabsf(mk[64 + lane]))), br = wave_max(fabsf(mk[128 + lane]));
            const float Bd = 1.01f * (0.08838834764831845f * 1.4426950408889634f * 128.f) * a * b, Bm = 1.01f * (0.07216878364870323f * 1.4426950408889634f) * (128.f * an * bn + 64.f * ar * br);
            if (lane == 0) { lamf[4 + j] = Bd > 64.f ? Bd : 0.f; lamf[6 + j] = Bm > 64.f ? Bm : 0.f; } }
    }
    xb_rows(kin(P, 0), WSP(bf16, WS_HN), WSP(float, WS_SS), P.gw, P.ngw, P.lane);
}
__device__ __forceinline__ void ph_diff_win(LAS unsigned char* L, int j) { const Ph P = ph_begin();
    const pg8::RowScale rsc = rstd_table(WSP(float, WS_SS) + (size_t)(6 * j) * MT * 64, L, P, MT, DIFF_IN);
#if FUSE_KNORM_D
    GEMM_PHASE(SINGLE_ARG(pg8::EpiKN<1>), (pg8::EpiKN<1>{WSP(bf16, WS_Z), DIFF_IN, rsc, kin(P, 13) + j * 128, WSP(float, WS_COSD), WSP(float, WS_SIND), (LAS float*)(L + XT_OFF)}), WSP(bf16, WS_HN), WSP(bf16, WS_DWIN) + (size_t)j * DIFF_IN * DM, MT, DIFF_IN, DM); }
#else
    GEMM_PHASE(SINGLE_ARG(pg8::EpiBf16<0, true>), (pg8::EpiBf16<0, true>{WSP(bf16, WS_Z), DIFF_IN, rsc}), WSP(bf16, WS_HN), WSP(bf16, WS_DWIN) + (size_t)j * DIFF_IN * DM, MT, DIFF_IN, DM); }
#endif
__device__ __forceinline__ void ph_diff_qknorm(int j) { const Ph P = ph_begin();
    diff_k_norm_rope(WSP(bf16, WS_Z), kin(P, 13) + j * 128, WSP(float, WS_COSD), WSP(float, WS_SIND), P.gw, P.ngw, P.lane); }
__device__ __forceinline__ void ph_diff_attn(char* lds, LAS unsigned char* L, int conv_layer, int j) {
#ifndef SKIP_ATTD
    const Ph P = ph_begin(); int ui = 0; const bf16* Z = WSP(bf16, WS_Z); bf16* OPART = WSP(bf16, WS_OPART);
#if DIFF_WIDE
    static_assert(3 * att::SHM_K + 3 * 2 * att::SHM_V <= SCR_BYTES, "dma3d LDS map");
    const int wave_ = __builtin_amdgcn_readfirstlane(P.tid >> 6);
    for (int pi = P.vcu; pi < 512; pi += P.G) {
        const int qb = pi & 15, h = (pi >> 4) & 15, b = pi >> 8;
        const bf16* Zb = Z + (size_t)(b * SEQ) * DIFF_IN;
#pragma nounroll
        for (int c = 0; c < 2; ++c) {
            att::attn_unit_dma3d<DiffCfg>(Zb + (size_t)(qb * 256) * DIFF_IN + (h * 2 + c) * 128, Zb + 4096 + (h * 2 + c) * 128, Zb + 8192 + h * 256,
                                          OPART + (size_t)c * MT * DM + (size_t)(b * SEQ + qb * 256) * DM + h * 256, SEQ, lds, (LAS unsigned char*)lds,
                                          att::QNorm{kin(P, 12) + j * 128, WSP(float, WS_COSD) + (size_t)(b * SEQ + qb * 256) * 16, WSP(float, WS_SIND) + (size_t)(b * SEQ + qb * 256) * 16, WSP(float, WS_LAM)[4 + j]});
            if (STAGGER_CONV && conv_layer >= 0 && ui == (P.vcu & 3)) { __syncthreads(); if (conv_layer == 1) convert_layer(P, L, 0, 2); convert_layer(P, L, conv_layer); __syncthreads(); }
            ++ui;
        }
        VM_WAIT(); __syncthreads();
#pragma nounroll
        for (int hf = 0; hf < 2; ++hf)
            diff_combine_pair(OPART, (size_t)(b * SEQ + qb * 256 + hf * 128), h, WSP(float, WS_LAM) + j, kin(P, 15) + j * 256, (j == 0) ? 0.8f : (float)(1.0 - 0.47071301834358416), WSP(bf16, WS_OB), wave_, P.lane);
    }
#elif DIFF_PA && DIFF_PAD == 2 && FUSE_COMBINE
    static_assert(att::Pa2Map<DiffCfg>::BYTES <= SCR_BYTES, "pa2 LDS map");
    const int wave_ = __builtin_amdgcn_readfirstlane(P.tid >> 6);
    for (int pi = P.vcu; pi < 1024; pi += P.G) {
        const int qb = pi & 31, h = (pi >> 5) & 15, b = pi >> 9;
        const bf16* Zb = Z + (size_t)(b * SEQ) * DIFF_IN;
#pragma nounroll
        for (int c = 0; c < 2; ++c) {
#if DIFF_MFMA16
            att::attn_unit_pa3<DiffCfg>(Zb + (size_t)(qb * 128) * DIFF_IN + (h * 2 + c) * 128, Zb + 4096 + (h * 2 + c) * 128, Zb + 8192 + h * 256,
                                        OPART + (size_t)c * MT * DM + (size_t)(b * SEQ + qb * 128) * DM + h * 256, SEQ, lds, (LAS unsigned char*)lds,
                                        att::QNorm{kin(P, 12) + j * 128, WSP(float, WS_COSD) + (size_t)(b * SEQ + qb * 128) * 16, WSP(float, WS_SIND) + (size_t)(b * SEQ + qb * 128) * 16, WSP(float, WS_LAM)[4 + j]});
#else
            att::attn_unit_pa2<DiffCfg>(Zb + (size_t)(qb * 128) * DIFF_IN + (h * 2 + c) * 128, Zb + 4096 + (h * 2 + c) * 128, Zb + 8192 + h * 256, nullptr, nullptr,
                                        OPART + (size_t)c * MT * DM + (size_t)(b * SEQ + qb * 128) * DM + h * 256, SEQ, lds, (LAS unsigned char*)lds,
                                        att::QNorm{kin(P, 12) + j * 128, WSP(float, WS_COSD) + (size_t)(b * SEQ + qb * 128) * 16, WSP(float, WS_SIND) + (size_t)(b * SEQ + qb * 128) * 16, WSP(float, WS_LAM)[4 + j]});
#endif
            if (STAGGER_CONV && conv_layer >= 0 && ui == (P.vcu & 7)) { __syncthreads(); if (conv_layer == 1) convert_layer(P, L, 0, 2); convert_layer(P, L, conv_layer); __syncthreads(); }
            ++ui;
        }
        VM_WAIT(); __syncthreads();
        diff_combine_pair(OPART, (size_t)(b * SEQ + qb * 128), h, WSP(float, WS_LAM) + j, kin(P, 15) + j * 256, (j == 0) ? 0.8f : (float)(1.0 - 0.47071301834358416), WSP(bf16, WS_OB), wave_, P.lane);
    }
#elif DIFF_PA
    for (int u = P.vcu; u < 2048; u += P.G) {
        const int qb = u & 31, c = (u >> 5) & 1, h = (u >> 6) & 15, b = u >> 10;
        const bf16* Zb = Z + (size_t)(b * SEQ) * DIFF_IN;
#if DIFF_PAD == 2
        static_assert(att::Pa2Map<DiffCfg>::BYTES <= SCR_BYTES, "pa2 LDS map");
        att::attn_unit_pa2<DiffCfg>(Zb + (size_t)(qb * 128) * DIFF_IN + (h * 2 + c) * 128, Zb + 4096 + (h * 2 + c) * 128, Zb + 8192 + h * 256, nullptr, nullptr,
                                    OPART + (size_t)c * MT * DM + (size_t)(b * SEQ + qb * 128) * DM + h * 256, SEQ, lds, (LAS unsigned char*)lds,
                                    att::QNorm{kin(P, 12) + j * 128, WSP(float, WS_COSD) + (size_t)(b * SEQ + qb * 128) * 16, WSP(float, WS_SIND) + (size_t)(b * SEQ + qb * 128) * 16, WSP(float, WS_LAM)[4 + j]});
        if (STAGGER_CONV && conv_layer >= 0 && ui == (P.vcu & 7)) { __syncthreads(); if (conv_layer == 1) convert_layer(P, L, 0, 2); convert_layer(P, L, conv_layer); __syncthreads(); }
#ifdef PROBE_CONVX2
        if (STAGGER_CONV && conv_layer >= 0 && ui == ((P.vcu + 4) & 7)) { __syncthreads(); convert_layer(P, L, conv_layer); __syncthreads(); }
#endif
        ++ui;
#elif DIFF_PAD
        att::attn_unit_pad<DiffCfg>(Zb + (size_t)(qb * 128) * DIFF_IN + (h * 2 + c) * 128, Zb + 4096 + (h * 2 + c) * 128, Zb + 8192 + h * 256,
                                    OPART + (size_t)c * MT * DM + (size_t)(b * SEQ + qb * 128) * DM + h * 256, SEQ, lds, (LAS unsigned char*)lds);
#else
        att::attn_unit_pa<DiffCfg>(Zb + (size_t)(qb * 128) * DIFF_IN + (h * 2 + c) * 128, Zb + 4096 + (h * 2 + c) * 128, Zb + 8192 + h * 256, nullptr, nullptr,
                                   OPART + (size_t)c * MT * DM + (size_t)(b * SEQ + qb * 128) * DM + h * 256, SEQ, lds);
#endif
    }
#else
    for (int u = P.vcu; u < 2048; u += P.G) {
        const int qb = u & 15, e = (u >> 4) & 1, c = (u >> 5) & 1, h = (u >> 6) & 15, b = u >> 10;
        const bf16* Zb = Z + (size_t)(b * SEQ) * DIFF_IN;
#if ATT_DMA
        att::attn_unit_dma<DiffCfg>(Zb + (size_t)(qb * 256) * DIFF_IN + (h * 2 + c) * 128, Zb + 4096 + (h * 2 + c) * 128, Zb + 8192 + h * 256 + e * 128, nullptr, nullptr,
                                OPART + (size_t)c * MT * DM + (size_t)(b * SEQ + qb * 256) * DM + h * 256 + e * 128, SEQ, lds, (LAS unsigned char*)lds,
                                att::QNorm{kin(P, 12) + j * 128, WSP(float, WS_COSD) + (size_t)(b * SEQ + qb * 256) * 16, WSP(float, WS_SIND) + (size_t)(b * SEQ + qb * 256) * 16});
#else
        att::attn_unit<DiffCfg>(Zb + (size_t)(qb * 256) * DIFF_IN + (h * 2 + c) * 128, Zb + 4096 + (h * 2 + c) * 128, Zb + 8192 + h * 256 + e * 128, nullptr, nullptr,
                                OPART + (size_t)c * MT * DM + (size_t)(b * SEQ + qb * 256) * DM + h * 256 + e * 128, SEQ, lds);
#endif
    }
#endif
#endif
}
__device__ __forceinline__ void ph_diff_combine(int j) { const Ph P = ph_begin();
    diff_combine(WSP(bf16, WS_OPART), WSP(float, WS_LAM) + j, kin(P, 15) + j * 256, (j == 0) ? 0.8f : (float)(1.0 - 0.47071301834358416), WSP(bf16, WS_OB), P.gw, P.ngw, P.lane); }
__device__ __forceinline__ void ph_wout(LAS unsigned char* L, size_t wofs, int i, bool f8 = false) { const Ph P = ph_begin();
#if RES_BF16
    if (f8) { GEMM_PHASE_F8(pg8::EpiResB, (pg8::EpiResB{WSP(bf16, WS_HN), WSP(bf16, WS_HN), DM, WSP(float, WS_SS) + (size_t)(3 * i + 1) * MT * 64, nullptr, 1.f / 2048.f}), P.ws + WS_OB8, P.ws + wofs, MT, DM, DM / 2); }
    else { GEMM_PHASE(pg8::EpiResB, (pg8::EpiResB{WSP(bf16, WS_HN), WSP(bf16, WS_HN), DM, WSP(float, WS_SS) + (size_t)(3 * i + 1) * MT * 64, nullptr, 1.f}), WSP(bf16, WS_OB), (bf16*)(P.ws + wofs), MT, DM, DM); } }
#else
    GEMM_PHASE(pg8::EpiRes, (pg8::EpiRes{i == 0 ? kin(P, 0) : (const float*)P.X, P.X, DM, WSP(bf16, WS_HN), WSP(float, WS_SS) + (size_t)(3 * i + 1) * MT * 64}), WSP(bf16, WS_OB), (bf16*)(P.ws + wofs), MT, DM, DM); }
#endif
__device__ __forceinline__ void ph_mla_win(LAS unsigned char* L, int j) { const Ph P = ph_begin();
    const pg8::RowScale rsc = rstd_table(WSP(float, WS_SS) + (size_t)(6 * j + 3) * MT * 64, L, P, MT, MLA_INP);
    GEMM_PHASE(pg8::EpiF32, (pg8::EpiF32{WSP(float, WS_ZM), MLA_INP, rsc}), WSP(bf16, WS_HN), WSP(bf16, WS_MWIN) + (size_t)j * MLA_INP * DM, MT, MLA_INP, DM); }
__device__ __forceinline__ void ph_mla_norm1(int j) { const Ph P = ph_begin();
    mla_norm1(WSP(float, WS_ZM), kin(P, 17) + j * MLA_QR, kin(P, 18) + j * MLA_KVR, kin(P, 22) + j * 192, WSP(float, WS_COSM), WSP(float, WS_SINM), WSP(bf16, WS_CQN), WSP(bf16, WS_CKVN), WSP(bf16, WS_KR), P.gw, P.ngw, P.lane); }
__device__ __forceinline__ void ph_mla_uq(LAS unsigned char* L, int j) { const Ph P = ph_begin();
    GEMM_PHASE(SINGLE_ARG(pg8::EpiBf16<0, false>), (pg8::EpiBf16<0, false>{WSP(bf16, WS_QM), MLA_Q, pg8::RowScale{}}), WSP(bf16, WS_CQN), WSP(bf16, WS_MWUQ) + (size_t)j * MLA_Q * MLA_QR, MT, MLA_Q, MLA_QR); }
__device__ __forceinline__ void ph_mla_ukv(LAS unsigned char* L, int j) { const Ph P = ph_begin();
#if FUSE_KNORM_M
    GEMM_PHASE(SINGLE_ARG(pg8::EpiKN<0>), (pg8::EpiKN<0>{WSP(bf16, WS_KVM), MLA_KV, pg8::RowScale{}, kin(P, 22) + j * 192, nullptr, nullptr, (LAS float*)(L + XT_OFF)}), WSP(bf16, WS_CKVN), WSP(bf16, WS_MWUKV) + (size_t)j * MLA_KV * MLA_KVR, MT, MLA_KV, MLA_KVR); }
#else
    GEMM_PHASE(SINGLE_ARG(pg8::EpiBf16<0, false>), (pg8::EpiBf16<0, false>{WSP(bf16, WS_KVM), MLA_KV, pg8::RowScale{}}), WSP(bf16, WS_CKVN), WSP(bf16, WS_MWUKV) + (size_t)j * MLA_KV * MLA_KVR, MT, MLA_KV, MLA_KVR); }
#endif
__device__ __forceinline__ void ph_mla_norm2(int j) { const Ph P = ph_begin();
    mla_norm2(WSP(bf16, WS_KVM), kin(P, 22) + j * 192, P.gw, P.ngw, P.lane); }
__device__ __forceinline__ void ph_mla_attn(char* lds, LAS unsigned char* L, int conv_layer, int j) {
#ifndef SKIP_ATTM
    const Ph P = ph_begin(); int ui = 0; const bf16* QMB = WSP(bf16, WS_QM); const bf16* KVMB = WSP(bf16, WS_KVM); const bf16* KRB = WSP(bf16, WS_KR); bf16* OBB = WSP(bf16, WS_OB);
#if MLA_PA
    for (int u = P.vcu; u < 2048; u += P.G) {
        const int qb = u & 31, h = (u >> 5) & 31, b = u >> 10;
        const bf16* Qp = QMB + (size_t)(b * SEQ + qb * 128) * MLA_Q + h * 192; const bf16* Kp = KVMB + (size_t)(b * SEQ) * MLA_KV + h * 256;
#if MLA_PA == 2
        static_assert(att::Pa2Map<MlaCfg>::BYTES <= SCR_BYTES, "pa2 LDS map");
        att::attn_unit_pa2<MlaCfg>(Qp, Kp, Kp + 128, Qp + 128, KRB + (size_t)(b * SEQ) * 64, OBB + (size_t)(b * SEQ + qb * 128) * DM + h * 128, SEQ, lds, (LAS unsigned char*)lds, att::QNorm{kin(P, 21) + j * 192, WSP(float, WS_COSM) + (size_t)(b * SEQ + qb * 128) * 32, WSP(float, WS_SINM) + (size_t)(b * SEQ + qb * 128) * 32});
#else
        att::attn_unit_pa<MlaCfg>(Qp, Kp, Kp + 128, Qp + 128, KRB + (size_t)(b * SEQ) * 64, OBB + (size_t)(b * SEQ + qb * 128) * DM + h * 128, SEQ, lds);
#endif
    }
#else
    for (int u = P.vcu; u < 1024; u += P.G) {
        const int qb = u & 15, h = (u >> 4) & 31, b = u >> 9;
        const bf16* Qp = QMB + (size_t)(b * SEQ + qb * 256) * MLA_Q + h * 192; const bf16* Kp = KVMB + (size_t)(b * SEQ) * MLA_KV + h * 256;
#if ATT_DMA
        att::MLA_BODY<MlaCfg>(Qp, Kp, Kp + 128, Qp + 128, KRB + (size_t)(b * SEQ) * 64, OBB + (size_t)(b * SEQ + qb * 256) * DM + h * 128, SEQ, lds, (LAS unsigned char*)lds,
                                   att::QNorm{kin(P, 21) + j * 192, WSP(float, WS_COSM) + (size_t)(b * SEQ + qb * 256) * 32, WSP(float, WS_SINM) + (size_t)(b * SEQ + qb * 256) * 32, WSP(float, WS_LAM)[6 + j]},
                                   (MLA_F8 && MLA_MFMA16) ? P.ws + WS_OB8 + (size_t)(b * SEQ + qb * 256) * DM + h * 128 : (unsigned char*)nullptr);
        if (STAGGER_CONV && conv_layer >= 0 && ui == (P.vcu & 3)) { __syncthreads(); convert_layer(P, L, conv_layer); __syncthreads(); }
        ++ui;
#else
        att::attn_unit<MlaCfg>(Qp, Kp, Kp + 128, Qp + 128, KRB + (size_t)(b * SEQ) * 64, OBB + (size_t)(b * SEQ + qb * 256) * DM + h * 128, SEQ, lds);
#endif
    }
#endif
#endif
}
__device__ __forceinline__ void ph_ple(LAS unsigned char* L, int i) { const Ph P = ph_begin();
    GEMM_PHASE(SINGLE_ARG(pg8::EpiBf16<0, false>), (pg8::EpiBf16<0, false>{WSP(bf16, WS_PLE), DM, pg8::RowScale{}}), WSP(bf16, WS_PB) + (size_t)i * MT * PLED, WSP(bf16, WS_WPT) + (size_t)i * DM * PLED, MT, DM, PLED); }
__device__ __forceinline__ void ph_w1(LAS unsigned char* L, int i) { const Ph P = ph_begin();
    const pg8::RowScale rsc = rstd_table(WSP(float, WS_SS) + (size_t)(3 * i + 1) * MT * 64, L, P, MT, FF);
    GEMM_PHASE(SINGLE_ARG(pg8::EpiBf16<1, true>), (pg8::EpiBf16<1, true>{WSP(bf16, WS_ACT), FF, rsc}), WSP(bf16, WS_HN), WSP(bf16, WS_W1T) + (size_t)i * FF * DM, MT, FF, DM); }
__device__ __forceinline__ void ph_w2(LAS unsigned char* L, int i) { const Ph P = ph_begin();
#if RES_BF16
    GEMM_PHASE(pg8::EpiResB, (pg8::EpiResB{WSP(bf16, WS_HN), WSP(bf16, WS_XB1), DM, WSP(float, WS_SS) + (size_t)(3 * i + 2) * MT * 64, GATE_F8 ? (unsigned char*)(P.ws + WS_X8) : (unsigned char*)nullptr, 1.f}), WSP(bf16, WS_ACT), WSP(bf16, WS_W2T) + (size_t)i * DM * FF, MT, DM, FF); }
#else
    GEMM_PHASE(pg8::EpiRes, (pg8::EpiRes{P.X, P.X, DM, WSP(bf16, WS_XB1), WSP(float, WS_SS) + (size_t)(3 * i + 2) * MT * 64}), WSP(bf16, WS_ACT), WSP(bf16, WS_W2T) + (size_t)i * DM * FF, MT, DM, FF); }
#endif
__device__ __forceinline__ void ph_gate(LAS unsigned char* L, int i) { const Ph P = ph_begin();
    const pg8::RowScale rsc = rstd_table(WSP(float, WS_SS) + (size_t)(3 * i + 2) * MT * 64, L, P, MT, DM);
#if RES_BF16
#if GATE_F8
    if (i == DEPTH - 1) { GEMM_PHASE_F8(SINGLE_ARG(pg8::EpiGateB<true>), (pg8::EpiGateB<true>{WSP(bf16, WS_XB1), WSP(bf16, WS_PLE), DM, rsc, nullptr, nullptr, P.X, 0.0078125f}), P.ws + WS_X8, P.ws + WS_WGT + (size_t)i * DM * DM, MT, DM, DM / 2); }
    else { GEMM_PHASE_F8(SINGLE_ARG(pg8::EpiGateB<false>), (pg8::EpiGateB<false>{WSP(bf16, WS_XB1), WSP(bf16, WS_PLE), DM, rsc, WSP(bf16, WS_HN), WSP(float, WS_SS) + (size_t)(3 * i + 3) * MT * 64, nullptr, 0.0078125f}), P.ws + WS_X8, P.ws + WS_WGT + (size_t)i * DM * DM, MT, DM, DM / 2); } }
#else
    if (i == DEPTH - 1) { GEMM_PHASE(SINGLE_ARG(pg8::EpiGateB<true>), (pg8::EpiGateB<true>{WSP(bf16, WS_XB1), WSP(bf16, WS_PLE), DM, rsc, nullptr, nullptr, P.X, 1.f}), WSP(bf16, WS_XB1), WSP(bf16, WS_WGT) + (size_t)i * DM * DM, MT, DM, DM); }
    else { GEMM_PHASE(SINGLE_ARG(pg8::EpiGateB<false>), (pg8::EpiGateB<false>{WSP(bf16, WS_XB1), WSP(bf16, WS_PLE), DM, rsc, WSP(bf16, WS_HN), WSP(float, WS_SS) + (size_t)(3 * i + 3) * MT * 64, nullptr, 1.f}), WSP(bf16, WS_XB1), WSP(bf16, WS_WGT) + (size_t)i * DM * DM, MT, DM, DM); } }
#endif
#else
    GEMM_PHASE(pg8::EpiGate, (pg8::EpiGate{P.X, P.X, WSP(bf16, WS_PLE), DM, rsc, WSP(bf16, WS_HN), WSP(float, WS_SS) + (size_t)(3 * i + 3) * MT * 64}), WSP(bf16, WS_XB1), WSP(bf16, WS_WGT) + (size_t)i * DM * DM, MT, DM, DM); }
#endif

__device__ __forceinline__ void ph_dummy(LAS unsigned char* L, size_t aofs, size_t bofs, int N, int K) { const Ph P = ph_begin();
    GEMM_PHASE(SINGLE_ARG(pg8::EpiBf16<0, false>), (pg8::EpiBf16<0, false>{WSP(bf16, WS_OPART), N, pg8::RowScale{}}), (bf16*)(P.ws + aofs), (bf16*)(P.ws + bofs), MT, N, K); }
__device__ __forceinline__ void ph_dummy_res(LAS unsigned char* L, size_t aofs, size_t bofs, int K) { const Ph P = ph_begin();
    GEMM_PHASE(pg8::EpiRes, (pg8::EpiRes{P.X, WSP(float, WS_OPART), DM, WSP(bf16, WS_OPART + 128 * MiB), WSP(float, WS_Z)}), (bf16*)(P.ws + aofs), (bf16*)(P.ws + bofs), MT, DM, K); }
__device__ __forceinline__ void ph_dummy_gate(LAS unsigned char* L, int i) { const Ph P = ph_begin();
    const pg8::RowScale rsc = rstd_table(WSP(float, WS_SS) + (size_t)(3 * i + 2) * MT * 64, L, P, MT, DM);
    GEMM_PHASE(pg8::EpiGate, (pg8::EpiGate{P.X, WSP(float, WS_OPART), WSP(bf16, WS_PLE), DM, rsc, WSP(bf16, WS_OPART + 128 * MiB), WSP(float, WS_Z)}), WSP(bf16, WS_XB1), WSP(bf16, WS_WGT) + (size_t)i * DM * DM, MT, DM, DM); }
__device__ __forceinline__ void mlp_part(const int i, LAS unsigned char* L, const XcdBarrier& bar) {
#ifdef PROBE_W2COLD
    ph_dummy(L, WS_ACT, WS_W2T + (size_t)((i + 2) & 3) * DM * FF * 2, DM, FF); XBAR(bar);
#endif
    ph_ple(L, i); ph_w1(L, i); XBAR(bar);
#ifdef PROBE_W1X2
    ph_w1(L, i); XBAR(bar);
#endif
    ph_w2(L, i); XBAR(bar);
#ifdef PROBE_RESD
    ph_dummy_res(L, WS_ACT, WS_W2T + (size_t)i * DM * FF * 2, FF); XBAR(bar);
#endif
#ifdef PROBE_RES4D
    ph_dummy_res(L, WS_OB, WS_DWOUT, DM); XBAR(bar);
#endif
#ifdef PROBE_GATED
    ph_dummy_gate(L, i); XBAR(bar);
#endif
#ifdef PROBE_W2D
    ph_dummy(L, WS_ACT, WS_W2T + (size_t)i * DM * FF * 2, DM, FF); XBAR(bar);
#endif
#ifdef PROBE_SQD
    ph_dummy(L, WS_HN, WS_WGT + (size_t)i * DM * DM * 2, DM, DM); XBAR(bar);
#endif
#ifdef PROBE_PLED
    ph_dummy(L, WS_PB + (size_t)i * MT * PLED * 2, WS_WPT + (size_t)i * DM * PLED * 2, DM, PLED); XBAR(bar);
#endif
    ph_gate(L, i); XBAR(bar);
}

__global__ void __launch_bounds__(NWAVES * 64, 2) mega_fwd(Args a) {
    extern __shared__ __attribute__((aligned(16))) unsigned char lds[];
    LAS unsigned char* L = (LAS unsigned char*)lds;
    volatile LAS unsigned* MISC = (volatile LAS unsigned*)(L + MISC_OFF);
    for (int u = threadIdx.x; u < (LDS_BYTES - LDSCTL_OFF) / 4; u += NWAVES * 64) ((LAS unsigned*)(L + LDSCTL_OFF))[u] = 0u;
    __syncthreads();
    static_assert(TIDTAB_LDS_OFF == LDSCTL_OFF + 2048 && TIDTAB_LDS_OFF + 256 <= LDS_BYTES, "tid table");
    if ((threadIdx.x & 63) == 0) *(volatile LAS int*)(L + TIDTAB_LDS_OFF + 4 * hw_slot()) = (int)(threadIdx.x >> 6);
    __syncthreads();
    XcdBarrier bar = xcd_barrier_post((unsigned*)(a.ws + WS_CTL) + CW_BAR, MISC + 8);
    bar.x = (unsigned)__builtin_amdgcn_readfirstlane((int)bar.x);

    ph_prologue(L);
#ifdef PROBE_P0X2
    XBAR(bar); ph_prologue(L);
#endif
    XBAR(bar);
    for (int j = 0; j < 2; ++j) {
        ph_diff_win(L, j); XBAR(bar);
#ifdef PROBE_DWINX2
        ph_diff_win(L, j); XBAR(bar);
#endif
#if !FUSE_KNORM_D
        ph_diff_qknorm(j); XBAR(bar);
#endif
        ph_diff_attn((char*)lds, L, 2 * j + 1, j); XBAR(bar);
#ifdef PROBE_ATTDX2
        ph_diff_attn((char*)lds, L, -1, j); XBAR(bar);
#endif
#if !(DIFF_WIDE || (DIFF_PA && DIFF_PAD == 2 && FUSE_COMBINE))
        ph_diff_combine(j); XBAR(bar);
#endif
#ifdef PROBE_COMBX2
        ph_diff_combine(j); XBAR(bar);
#endif
        ph_wout(L, WS_DWOUT + (size_t)j * DM * DM * 2, 2 * j); XBAR(bar);
        mlp_part(2 * j, L, bar);
        ph_mla_win(L, j); XBAR(bar);
#ifdef PROBE_MWINX2
        ph_mla_win(L, j); XBAR(bar);
#endif
        ph_mla_norm1(j); XBAR(bar);
#ifdef PROBE_N1X2
        ph_mla_norm1(j); XBAR(bar);
#endif
        ph_mla_uq(L, j); ph_mla_ukv(L, j); XBAR(bar);
#ifdef PROBE_UQKVX2
        ph_mla_uq(L, j); ph_mla_ukv(L, j); XBAR(bar);
#endif
#if !FUSE_KNORM_M
        ph_mla_norm2(j); XBAR(bar);
#endif
        ph_mla_attn((char*)lds, L, j == 0 ? 2 : -1, j); XBAR(bar);
#ifdef PROBE_ATTMX2
        ph_mla_attn((char*)lds, L, -1, j); XBAR(bar);
#endif
        ph_wout(L, MLA_F8 ? WS_MWOUT + (size_t)j * DM * DM : WS_MWOUT + (size_t)j * DM * DM * 2, 2 * j + 1, MLA_F8); XBAR(bar);
        mlp_part(2 * j + 1, L, bar);
    }
}

extern "C" void kernel_launch(void* const* d_in, const int* in_sizes, int n_in, void* d_out, int out_size, void* d_ws, size_t ws_size, hipStream_t stream) {
    static int grid = 0;
    if (grid == 0) {
        if (n_in != 24 || in_sizes[0] != MT * DM || out_size != MT * DM || ws_size < WS_END) { fprintf(stderr, "kernel_launch: shape mismatch: n_in %d in0 %d out %d ws %zu (need %zu)\n", n_in, n_in > 0 ? in_sizes[0] : -1, out_size, ws_size, (size_t)WS_END); grid = -1; return; }
        int dev = 0, cus = 0, per_cu = 0;
        if (hipGetDevice(&dev) != hipSuccess || hipDeviceGetAttribute(&cus, hipDeviceAttributeMultiprocessorCount, dev) != hipSuccess) { fprintf(stderr, "kernel_launch: device query failed\n"); grid = -1; return; }
        if (hipFuncSetAttribute((const void*)mega_fwd, hipFuncAttributeMaxDynamicSharedMemorySize, LDS_BYTES) != hipSuccess) { fprintf(stderr, "kernel_launch: hipFuncSetAttribute failed\n"); grid = -1; return; }
        if (hipOccupancyMaxActiveBlocksPerMultiprocessor(&per_cu, (const void*)mega_fwd, NWAVES * 64, LDS_BYTES) != hipSuccess || per_cu < 1) fprintf(stderr, "kernel_launch: note: occupancy query reports %d workgroups per CU\n", per_cu);
        (void)hipGetLastError();
        grid = cus;
    }
    if (grid < 0) return;
    if (hipMemsetAsync((char*)d_ws + WS_CTL, 0, CTL_ZERO_BYTES, stream) != hipSuccess) { fprintf(stderr, "kernel_launch: memset failed\n"); return; }
    Args a{};
    for (int i = 0; i < 24; ++i) a.in[i] = d_in[i];
    a.out = (float*)d_out; a.ws = (unsigned char*)d_ws;
    hipLaunchKernelGGL(mega_fwd, dim3(grid), dim3(NWAVES * 64), LDS_BYTES, stream, a);
    const hipError_t le = hipPeekAtLastError();
    if (le != hipSuccess) fprintf(stderr, "kernel_launch: launch failed: %s\n", hipGetErrorName(le));
}
```

```cpp
#include <hip/hip_runtime.h>
#include <cstdio>
#include <cstdint>
#define TIDTAB_LDS_OFF (151552 + 2048)
extern __shared__ __attribute__((aligned(16))) unsigned char tid_lds_alias[];
__device__ __forceinline__ unsigned hw_slot() { return (unsigned)__builtin_amdgcn_s_getreg((5 << 11) | 4) & 63u; }
__device__ __forceinline__ int my_tid() {
    const int wv = __builtin_amdgcn_readfirstlane(*(volatile __attribute__((address_space(3))) int*)((__attribute__((address_space(3))) unsigned char*)tid_lds_alias + TIDTAB_LDS_OFF + 4 * hw_slot()));
    int ln; asm volatile("v_mbcnt_lo_u32_b32 %0, -1, 0\n\tv_mbcnt_hi_u32_b32 %0, -1, %0" : "=v"(ln));
    return (wv << 6) | ln;
}
namespace pg8 {
#define PG8_LAS __attribute__((address_space(3)))
typedef unsigned short bf16_t;
typedef short bf16x8 __attribute__((ext_vector_type(8)));
typedef float f32x4 __attribute__((ext_vector_type(4)));
typedef unsigned u32x4 __attribute__((ext_vector_type(4)));
constexpr int BM = 256, BK = 64, HALF = 128, HTB = HALF * BK * 2  , STAGE_BYTES = 8 * HTB, NXCD = 8, WGM = 8;

__host__ __device__ __forceinline__ int lds_byte(int r, int c) { const int st = (r >> 4) * 2 + (c >> 5), rr = r & 15, cc = c & 31, ob = rr * 64 + cc * 2; return st * 1024 + (ob ^ (((ob >> 9) & 1) << 5)); }
__host__ __device__ __forceinline__ void stage_rc(int b, int& R, int& C) { const int st = b / 1024, sb = b % 1024, swz = sb ^ (((sb >> 9) & 1) << 5); R = (st >> 1) * 16 + swz / 64; C = (st & 1) * 32 + (swz % 64) / 2; }
__host__ __device__ __forceinline__ int perm32(int rho) { const int n = rho >> 4, i = rho & 15; return 8 * (i >> 2) + 4 * n + (i & 3); }

struct Unit { int pm, pn; };
struct Gemm { const bf16_t* A; const bf16_t* Bt; int M, N, K; };

struct StaticOrder {
    int nM, nN, nwg, G, c;
    __host__ __device__ void init(int M, int N, int G_, int c_) { nM = M / BM; nN = N / BM; nwg = nM * nN; G = G_; c = c_; }
    __host__ __device__ bool next(int i, Unit& u) const {
        const long L = (long)i * G + c; if (L >= nwg) return false;
        int wgid = (int)L; { const int q = nwg / NXCD, r = nwg % NXCD, xcd = wgid % NXCD, off = wgid / NXCD; wgid = (xcd < r ? xcd * (q + 1) : r * (q + 1) + (xcd - r) * q) + off; }
        const int nig = WGM * nN, gid = wgid / nig, fm = gid * WGM, gsz = (nM - fm) < WGM ? (nM - fm) : WGM;
        u.pm = fm + ((wgid % nig) % gsz); u.pn = (wgid % nig) / gsz; return true;
    }
    __device__ __forceinline__ void a_ready(const Unit&) const {}
    __device__ __forceinline__ void done(const Unit&) const {}
};
__device__ __forceinline__ unsigned cvt_pk_bf16(float lo, float hi) { unsigned r; asm volatile("v_cvt_pk_bf16_f32 %0, %1, %2" : "=v"(r) : "v"(lo), "v"(hi)); return r; }
typedef float f32x2 __attribute__((ext_vector_type(2)));
template <int M> __device__ __forceinline__ float xshfl(float v) { static_assert(M == 1 || M == 2 || M == 4 || M == 8 || M == 16, "xor mask");
    return __builtin_bit_cast(float, __builtin_amdgcn_ds_swizzle(__builtin_bit_cast(int, v), (M << 10) | 0x1f)); }
__device__ __forceinline__ float xadd32(float v) { const unsigned u = __builtin_bit_cast(unsigned, v); auto r = __builtin_amdgcn_permlane32_swap(u, u, false, false);
    return __builtin_bit_cast(float, (unsigned)r[0]) + __builtin_bit_cast(float, (unsigned)r[1]); }
__device__ __forceinline__ float xswap32(float v, int lane) { const unsigned u = __builtin_bit_cast(unsigned, v); auto r = __builtin_amdgcn_permlane32_swap(u, u, false, false);
    return __builtin_bit_cast(float, (unsigned)(lane < 32 ? r[1] : r[0])); }
__device__ __forceinline__ float row_rstd(const float* ss, int row, int fq) {
    const f32x4* p = (const f32x4*)(ss + (size_t)row * 64 + fq * 16); const f32x4 a = p[0], b = p[1], c = p[2], d = p[3];
    float s = (((a[0] + a[1]) + (a[2] + a[3])) + ((b[0] + b[1]) + (b[2] + b[3]))) + (((c[0] + c[1]) + (c[2] + c[3])) + ((d[0] + d[1]) + (d[2] + d[3])));
    s += xshfl<16>(s); s = xadd32(s);
    return 1.0f / sqrtf(s * (1.f / 4096.f) + 1e-6f);
}
struct RowScale { const PG8_LAS float* tab; int pm_tab; const float* ss;
    __device__ __forceinline__ float get(const Unit& u, int rloc, int fq) const { return (u.pm == pm_tab) ? tab[rloc] : __builtin_nanf(""); } };
template <int ACT, bool RS> struct EpiBf16 {
    static constexpr bool PERM = true, AFTER_DRAIN = false;
    bf16_t* O; int ldc; RowScale rsc;
    __device__ __forceinline__ void operator()(const f32x4 (&acc)[2][2][4][2], const Unit& u, int wr, int wc, int fr, int fq) const {
        const int row0 = u.pm * BM + wr * 64 + fr, col0 = u.pn * BM + wc * 32 + 8 * fq;
#pragma unroll
        for (int ai = 0; ai < 2; ++ai)
#pragma unroll
            for (int m = 0; m < 4; ++m) { bf16_t* rowp = O + (size_t)(row0 + ai * HALF + m * 16) * ldc + col0;
                float rs = 1.f; if (RS) rs = rsc.get(u, wr * 64 + fr + ai * HALF + m * 16, fq);
#pragma unroll
                for (int bj = 0; bj < 2; ++bj) { f32x4 v0 = acc[ai][bj][m][0], v1 = acc[ai][bj][m][1];
                    if (RS) { v0 = v0 * rs; v1 = v1 * rs; }
                    if (ACT == 1) {
#pragma unroll
                        for (int j = 0; j < 4; ++j) { const float a = fmaxf(v0[j], 0.f), b = fmaxf(v1[j], 0.f); v0[j] = a * a; v1[j] = b * b; } }
                    u32x4 w; w.x = cvt_pk_bf16(v0[0], v0[1]); w.y = cvt_pk_bf16(v0[2], v0[3]); w.z = cvt_pk_bf16(v1[0], v1[1]); w.w = cvt_pk_bf16(v1[2], v1[3]);
                    *(u32x4*)(rowp + bj * HALF) = w; } }
    }
};
struct EpiF32 {
    static constexpr bool PERM = false, AFTER_DRAIN = false;
    float* C; int ldc; RowScale rsc;
    __device__ __forceinline__ void operator()(const f32x4 (&acc)[2][2][4][2], const Unit& u, int wr, int wc, int fr, int fq) const {
        const int row0 = u.pm * BM + wr * 64 + fr, col0 = u.pn * BM + wc * 32 + 4 * fq;
#pragma unroll
        for (int ai = 0; ai < 2; ++ai)
#pragma unroll
            for (int m = 0; m < 4; ++m) { float* rowp = C + (size_t)(row0 + ai * HALF + m * 16) * ldc + col0; const float rs = rsc.get(u, wr * 64 + fr + ai * HALF + m * 16, fq);
#pragma unroll
                for (int bj = 0; bj < 2; ++bj)
#pragma unroll
                    for (int n = 0; n < 2; ++n) *(f32x4*)(rowp + bj * HALF + n * 16) = acc[ai][bj][m][n] * rs; }
    }
};
typedef unsigned u32x2e __attribute__((ext_vector_type(2)));
struct EpiRes {
    static constexpr bool PERM = false, AFTER_DRAIN = false;
    const float* base; float* out; int ldc; bf16_t* xb; float* ssout;
    __device__ __forceinline__ void operator()(const f32x4 (&acc)[2][2][4][2], const Unit& u, int wr, int wc, int fr, int fq) const {
        const int row0 = u.pm * BM + wr * 64 + fr, col0 = u.pn * BM + wc * 32 + 4 * fq;
#pragma unroll
        for (int aim = 0; aim < 4; ++aim) { const int ai = aim >> 1, mh = aim & 1;
            f32x4 bs[2][2][2];
#pragma unroll
            for (int mm = 0; mm < 2; ++mm) { const int m = 2 * mh + mm; const size_t off = (size_t)(row0 + ai * HALF + m * 16) * ldc + col0;
#pragma unroll
                for (int bj = 0; bj < 2; ++bj)
#pragma unroll
                    for (int n = 0; n < 2; ++n) bs[mm][bj][n] = *(const f32x4*)(base + off + bj * HALF + n * 16); }
            asm volatile("" ::: "memory");
#pragma unroll
            for (int mm = 0; mm < 2; ++mm) { const int m = 2 * mh + mm; const size_t off = (size_t)(row0 + ai * HALF + m * 16) * ldc + col0;
                float q = 0.f;
#pragma unroll
                for (int bj = 0; bj < 2; ++bj)
#pragma unroll
                    for (int n = 0; n < 2; ++n) { const f32x4 o = bs[mm][bj][n] + acc[ai][bj][m][n]; *(f32x4*)(out + off + bj * HALF + n * 16) = o;
                        q += (o[0] * o[0] + o[1] * o[1]) + (o[2] * o[2] + o[3] * o[3]);
                        u32x2e w; w.x = cvt_pk_bf16(o[0], o[1]); w.y = cvt_pk_bf16(o[2], o[3]); *(u32x2e*)(xb + off + bj * HALF + n * 16) = w; }
                q += xshfl<16>(q); q = xadd32(q);
                if (fq == 0) ssout[(size_t)(row0 + ai * HALF + m * 16) * 64 + u.pn * 4 + wc] = q; }
            asm volatile("" ::: "memory"); }
    }
};
struct EpiGate {
    static constexpr bool PERM = false, AFTER_DRAIN = false;
    const float* base; float* out; const bf16_t* ple; int ldc; RowScale rsc; bf16_t* xb; float* ssout;
    __device__ __forceinline__ void operator()(const f32x4 (&acc)[2][2][4][2], const Unit& u, int wr, int wc, int fr, int fq) const {
        typedef unsigned u32x2v __attribute__((ext_vector_type(2)));
        const int row0 = u.pm * BM + wr * 64 + fr, col0 = u.pn * BM + wc * 32 + 4 * fq;
#pragma unroll
        for (int aim = 0; aim < 4; ++aim) { const int ai = aim >> 1, mh = aim & 1;
            f32x4 bs[2][2][2]; u32x2v pl[2][2][2];
#pragma unroll
            for (int mm = 0; mm < 2; ++mm) { const int m = 2 * mh + mm; const size_t off = (size_t)(row0 + ai * HALF + m * 16) * ldc + col0;
#pragma unroll
                for (int bj = 0; bj < 2; ++bj)
#pragma unroll
                    for (int n = 0; n < 2; ++n) { bs[mm][bj][n] = *(const f32x4*)(base + off + bj * HALF + n * 16); pl[mm][bj][n] = *(const u32x2v*)(ple + off + bj * HALF + n * 16); } }
            asm volatile("" ::: "memory");
#pragma unroll
            for (int mm = 0; mm < 2; ++mm) { const int m = 2 * mh + mm; const size_t off = (size_t)(row0 + ai * HALF + m * 16) * ldc + col0;
                const float rs = rsc.get(u, wr * 64 + fr + ai * HALF + m * 16, fq) * -1.4426950408889634f; float q = 0.f;
#pragma unroll
                for (int bj = 0; bj < 2; ++bj)
#pragma unroll
                    for (int n = 0; n < 2; ++n) { const f32x4 a = acc[ai][bj][m][n] * rs; f32x4 o; const u32x2v pw = pl[mm][bj][n]; const f32x4 b = bs[mm][bj][n];
                        const float p0 = __uint_as_float(pw.x << 16), p1 = __uint_as_float(pw.x & 0xffff0000u), p2 = __uint_as_float(pw.y << 16), p3 = __uint_as_float(pw.y & 0xffff0000u);
                        o[0] = b[0] + p0 * __builtin_amdgcn_rcpf(1.f + __builtin_amdgcn_exp2f(a[0]));
                        o[1] = b[1] + p1 * __builtin_amdgcn_rcpf(1.f + __builtin_amdgcn_exp2f(a[1]));
                        o[2] = b[2] + p2 * __builtin_amdgcn_rcpf(1.f + __builtin_amdgcn_exp2f(a[2]));
                        o[3] = b[3] + p3 * __builtin_amdgcn_rcpf(1.f + __builtin_amdgcn_exp2f(a[3]));
                        *(f32x4*)(out + off + bj * HALF + n * 16) = o;
                        q += (o[0] * o[0] + o[1] * o[1]) + (o[2] * o[2] + o[3] * o[3]);
                        u32x2e w; w.x = cvt_pk_bf16(o[0], o[1]); w.y = cvt_pk_bf16(o[2], o[3]); *(u32x2e*)(xb + off + bj * HALF + n * 16) = w; }
                q += xshfl<16>(q); q = xadd32(q);
                if (fq == 0) ssout[(size_t)(row0 + ai * HALF + m * 16) * 64 + u.pn * 4 + wc] = q; }
            asm volatile("" ::: "memory"); }
    }
};


__device__ __forceinline__ void unpack_bf8(const u32x4 r, float (&x)[8]) { x[0] = __uint_as_float(r.x << 16); x[1] = __uint_as_float(r.x & 0xffff0000u); x[2] = __uint_as_float(r.y << 16); x[3] = __uint_as_float(r.y & 0xffff0000u);
    x[4] = __uint_as_float(r.z << 16); x[5] = __uint_as_float(r.z & 0xffff0000u); x[6] = __uint_as_float(r.w << 16); x[7] = __uint_as_float(r.w & 0xffff0000u); }
struct EpiResB {
    static constexpr bool PERM = true, AFTER_DRAIN = false;
    const bf16_t* xin; bf16_t* xout; int ldc; float* ssout; unsigned char* x8; float asc;
    __device__ __forceinline__ void operator()(const f32x4 (&acc)[2][2][4][2], const Unit& u, int wr, int wc, int fr, int fq) const {
        const int row0 = u.pm * BM + wr * 64 + fr, col0 = u.pn * BM + wc * 32 + 8 * fq;
#pragma unroll
        for (int ai = 0; ai < 2; ++ai) {
            u32x4 bs[4][2];
#pragma unroll
            for (int m = 0; m < 4; ++m)
#pragma unroll
                for (int bj = 0; bj < 2; ++bj) bs[m][bj] = *(const u32x4*)(xin + (size_t)(row0 + ai * HALF + m * 16) * ldc + col0 + bj * HALF);
            asm volatile("" ::: "memory");
#pragma unroll
            for (int m = 0; m < 4; ++m) { const size_t off = (size_t)(row0 + ai * HALF + m * 16) * ldc + col0; float q = 0.f;
#pragma unroll
                for (int bj = 0; bj < 2; ++bj) { float b[8]; unpack_bf8(bs[m][bj], b); const f32x4 a0 = acc[ai][bj][m][0], a1 = acc[ai][bj][m][1];
                    const float o0 = b[0] + a0[0] * asc, o1 = b[1] + a0[1] * asc, o2 = b[2] + a0[2] * asc, o3 = b[3] + a0[3] * asc, o4 = b[4] + a1[0] * asc, o5 = b[5] + a1[1] * asc, o6 = b[6] + a1[2] * asc, o7 = b[7] + a1[3] * asc;
                    q += ((o0 * o0 + o1 * o1) + (o2 * o2 + o3 * o3)) + ((o4 * o4 + o5 * o5) + (o6 * o6 + o7 * o7));
                    u32x4 w; w.x = cvt_pk_bf16(o0, o1); w.y = cvt_pk_bf16(o2, o3); w.z = cvt_pk_bf16(o4, o5); w.w = cvt_pk_bf16(o6, o7); *(u32x4*)(xout + off + bj * HALF) = w;
                    if (x8) { int e0 = 0, e1 = 0; e0 = __builtin_amdgcn_cvt_pk_fp8_f32(o0, o1, e0, false); e0 = __builtin_amdgcn_cvt_pk_fp8_f32(o2, o3, e0, true); e1 = __builtin_amdgcn_cvt_pk_fp8_f32(o4, o5, e1, false); e1 = __builtin_amdgcn_cvt_pk_fp8_f32(o6, o7, e1, true);
                        u32x2e w8; w8.x = (unsigned)e0; w8.y = (unsigned)e1; *(u32x2e*)(x8 + off + bj * HALF) = w8; } }
                q += xshfl<16>(q); q = xadd32(q);
                if (fq == 0) ssout[(size_t)(row0 + ai * HALF + m * 16) * 64 + u.pn * 4 + wc] = q; }
            asm volatile("" ::: "memory"); }
    }
};
template <bool FINAL> struct EpiGateB {
    static constexpr bool PERM = true, AFTER_DRAIN = false;
    const bf16_t* xin; const bf16_t* ple; int ldc; RowScale rsc; bf16_t* xout; float* ssout; float* fout; float asc;
    __device__ __forceinline__ void operator()(const f32x4 (&acc)[2][2][4][2], const Unit& u, int wr, int wc, int fr, int fq) const {
        const int row0 = u.pm * BM + wr * 64 + fr, col0 = u.pn * BM + wc * 32 + 8 * fq;
#pragma unroll
        for (int aim = 0; aim < 4; ++aim) { const int ai = aim >> 1, mh = aim & 1;
            u32x4 bs[2][2], pl[2][2];
#pragma unroll
            for (int mm = 0; mm < 2; ++mm)
#pragma unroll
                for (int bj = 0; bj < 2; ++bj) { const size_t o_ = (size_t)(row0 + ai * HALF + (2 * mh + mm) * 16) * ldc + col0 + bj * HALF; bs[mm][bj] = *(const u32x4*)(xin + o_); pl[mm][bj] = *(const u32x4*)(ple + o_); }
            asm volatile("" ::: "memory");
#pragma unroll
            for (int mm = 0; mm < 2; ++mm) { const int m = 2 * mh + mm; const size_t off = (size_t)(row0 + ai * HALF + m * 16) * ldc + col0;
                const float rs = rsc.get(u, wr * 64 + fr + ai * HALF + m * 16, fq) * -1.4426950408889634f * asc; float q = 0.f;
#pragma unroll
                for (int bj = 0; bj < 2; ++bj) { float b[8], p[8], o[8]; unpack_bf8(bs[mm][bj], b); unpack_bf8(pl[mm][bj], p); const f32x4 a0 = acc[ai][bj][m][0] * rs, a1 = acc[ai][bj][m][1] * rs;
#pragma unroll
                    for (int j = 0; j < 4; ++j) { o[j] = b[j] + p[j] * __builtin_amdgcn_rcpf(1.f + __builtin_amdgcn_exp2f(a0[j])); o[4 + j] = b[4 + j] + p[4 + j] * __builtin_amdgcn_rcpf(1.f + __builtin_amdgcn_exp2f(a1[j])); }
                    if (FINAL) { *(f32x4*)(fout + off + bj * HALF) = (f32x4){o[0], o[1], o[2], o[3]}; *(f32x4*)(fout + off + bj * HALF + 4) = (f32x4){o[4], o[5], o[6], o[7]}; }
                    else { q += ((o[0] * o[0] + o[1] * o[1]) + (o[2] * o[2] + o[3] * o[3])) + ((o[4] * o[4] + o[5] * o[5]) + (o[6] * o[6] + o[7] * o[7]));
                        u32x4 w; w.x = cvt_pk_bf16(o[0], o[1]); w.y = cvt_pk_bf16(o[2], o[3]); w.z = cvt_pk_bf16(o[4], o[5]); w.w = cvt_pk_bf16(o[6], o[7]); *(u32x4*)(xout + off + bj * HALF) = w; } }
                if (!FINAL) { q += xshfl<16>(q); q = xadd32(q);
                    if (fq == 0) ssout[(size_t)(row0 + ai * HALF + m * 16) * 64 + u.pn * 4 + wc] = q; } }
            asm volatile("" ::: "memory"); }
    }
};


template <int MODE> struct EpiKN {
    static constexpr bool PERM = true, AFTER_DRAIN = false;
    bf16_t* O; int ldc; RowScale rsc; const float* gk; const float* cs; const float* sn; PG8_LAS float* xt;
    __device__ __forceinline__ void operator()(const f32x4 (&acc)[2][2][4][2], const Unit& u, int wr, int wc, int fr, int fq) const {
        int frl = fr; asm volatile("" : "+v"(frl));
        const int col0 = u.pn * BM + wc * 32 + 8 * fq;
        const bool kn = (MODE == 0) ? true : (u.pn >= 16 && u.pn < 32);
        constexpr int NBJ = (MODE == 0) ? 1 : 2;
        if (kn) {
#pragma unroll
            for (int ai = 0; ai < 2; ++ai)
#pragma unroll
                for (int m = 0; m < 4; ++m) { const int rl = wr * 64 + frl + ai * HALF + m * 16; float rs = 1.f; if (MODE == 1) rs = rsc.get(u, rl, fq);
#pragma unroll
                    for (int bj = 0; bj < NBJ; ++bj) { const f32x4 a0 = acc[ai][bj][m][0] * rs, a1 = acc[ai][bj][m][1] * rs;
                        float q = ((a0[0] * a0[0] + a0[1] * a0[1]) + (a0[2] * a0[2] + a0[3] * a0[3])) + ((a1[0] * a1[0] + a1[1] * a1[1]) + (a1[2] * a1[2] + a1[3] * a1[3]));
                        q += xshfl<16>(q); q = xadd32(q);
                        if (fq == 0) xt[(rl * 2 + bj) * 4 + wc] = q; } }
            asm volatile("s_waitcnt lgkmcnt(0)" ::: "memory"); __builtin_amdgcn_s_barrier(); asm volatile("" ::: "memory");
        }
#pragma unroll
        for (int ai = 0; ai < 2; ++ai)
#pragma unroll
            for (int m = 0; m < 4; ++m) { const int rl = wr * 64 + frl + ai * HALF + m * 16; bf16_t* rowp = O + (size_t)(u.pm * BM + rl) * ldc + col0;
                float rs = 1.f; if (MODE == 1) rs = rsc.get(u, rl, fq);
                float c8[8], s8[8];
                if (MODE == 1 && kn && wc == 0) { const f32x4 c0 = *(const f32x4*)(cs + (size_t)(u.pm * BM + rl) * 16 + 8 * (fq & 1)), c1 = *(const f32x4*)(cs + (size_t)(u.pm * BM + rl) * 16 + 8 * (fq & 1) + 4);
                    const f32x4 s0 = *(const f32x4*)(sn + (size_t)(u.pm * BM + rl) * 16 + 8 * (fq & 1)), s1 = *(const f32x4*)(sn + (size_t)(u.pm * BM + rl) * 16 + 8 * (fq & 1) + 4);
#pragma unroll
                    for (int t = 0; t < 4; ++t) { c8[t] = c0[t]; c8[4 + t] = c1[t]; s8[t] = s0[t]; s8[4 + t] = s1[t]; } }
#pragma unroll
                for (int bj = 0; bj < 2; ++bj) { float v[8]; { const f32x4 a0 = acc[ai][bj][m][0] * rs, a1 = acc[ai][bj][m][1] * rs;
#pragma unroll
                        for (int t = 0; t < 4; ++t) { v[t] = a0[t]; v[4 + t] = a1[t]; } }
                    if (kn && bj < NBJ) { const f32x4 p = *(const PG8_LAS f32x4*)(xt + (rl * 2 + bj) * 4); const float hr = __builtin_amdgcn_rsqf(((p[0] + p[1]) + (p[2] + p[3])) * (1.f / 128.f) + 1e-6f);
                        const f32x4 g0 = *(const f32x4*)(gk + wc * 32 + 8 * fq), g1 = *(const f32x4*)(gk + wc * 32 + 8 * fq + 4);
#pragma unroll
                        for (int t = 0; t < 4; ++t) { v[t] = v[t] * hr * g0[t]; v[4 + t] = v[4 + t] * hr * g1[t]; }
                        if (MODE == 1 && wc == 0) {
#pragma unroll
                            for (int t = 0; t < 8; ++t) { const float pr = xswap32(v[t], fq * 16 + frl); v[t] = (fq < 2) ? v[t] * c8[t] - pr * s8[t] : v[t] * c8[t] + pr * s8[t]; } } }
                    u32x4 w; w.x = cvt_pk_bf16(v[0], v[1]); w.y = cvt_pk_bf16(v[2], v[3]); w.z = cvt_pk_bf16(v[4], v[5]); w.w = cvt_pk_bf16(v[6], v[7]);
                    *(u32x4*)(rowp + bj * HALF) = w; }
                asm volatile("" ::: "memory"); }
    }
};
#ifndef STAGE_OFF32
#define STAGE_OFF32 1
#endif
typedef int i32x4g __attribute__((ext_vector_type(4)));
typedef int i32x8g __attribute__((ext_vector_type(8)));
template <class Epi, class Sched, bool ALIGN_EPI = false, bool SP2 = false, bool F8 = false>
__device__ __forceinline__ void gemm_phase(PG8_LAS unsigned char* lds, const Gemm g, const Sched& S, const Epi& E) {
    int tid = my_tid(); asm volatile("" : "+v"(tid));
    const int wid = __builtin_amdgcn_readfirstlane(tid >> 6), lane = tid & 63, wr = wid >> 2, wc = wid & 3, fr = lane & 15, fq = lane >> 4;
    const int K = g.K, nt = K / BK;
    unsigned voffA[2], voffB[2];
#pragma unroll
    for (int i = 0; i < 2; ++i) { int R, C; stage_rc(tid * 16 + i * 8192, R, C); const int Rb = Epi::PERM ? ((R & ~31) + perm32(R & 31)) : R;
        voffA[i] = (unsigned)(R * K + C) * 2u; voffB[i] = (unsigned)(Rb * K + C) * 2u; }
    const size_t kstep = (size_t)(BK * 2);
    const size_t hstep = (size_t)HALF * K * 2;
    const size_t tstep = 2 * hstep;
    const unsigned ldsw = (unsigned)wid * 1024u;
    const int aoff = lds_byte(wr * 64 + fr, fq * 8), boff = lds_byte(wc * 32 + fr, fq * 8);
#define PG8_SA(b, h) (((b) * 2 + (h)) * HTB)
#define PG8_SB(b, h) ((4 + (b) * 2 + (h)) * HTB)
#define PG8_STAGE(bufoff, gbase, voff) do { _Pragma("unroll") for (int _i = 0; _i < 2; ++_i) { unsigned vo_ = (voff)[_i]; if (F8 || STAGE_OFF32) asm volatile("" : "+v"(vo_));   \
        __builtin_amdgcn_global_load_lds((const unsigned*)((const char*)(gbase) + vo_), (PG8_LAS unsigned*)(lds + (bufoff) + ldsw + _i * 8192), 16, 0, 0); } } while (0)
#define PG8_LDA(dst, b, h) do { _Pragma("unroll") for (int m = 0; m < 4; ++m) _Pragma("unroll") for (int k = 0; k < 2; ++k) dst[m][k] = *(const PG8_LAS bf16x8*)(lds + PG8_SA(b, h) + aoff + m * 2048 + k * 1024); } while (0)
#define PG8_LDB(dst, b, h) do { _Pragma("unroll") for (int n = 0; n < 2; ++n) _Pragma("unroll") for (int k = 0; k < 2; ++k) dst[n][k] = *(const PG8_LAS bf16x8*)(lds + PG8_SB(b, h) + boff + n * 2048 + k * 1024); } while (0)
#define PG8_MMA(ai, bj, At, Bt) do { __builtin_amdgcn_s_setprio(1); \
      if constexpr (F8) { _Pragma("unroll") for (int m = 0; m < 4; ++m) _Pragma("unroll") for (int n = 0; n < 2; ++n) { \
          const i32x8g a8_ = __builtin_shufflevector(__builtin_bit_cast(i32x4g, At[m][0]), __builtin_bit_cast(i32x4g, At[m][1]), 0, 1, 2, 3, 4, 5, 6, 7), b8_ = __builtin_shufflevector(__builtin_bit_cast(i32x4g, Bt[n][0]), __builtin_bit_cast(i32x4g, Bt[n][1]), 0, 1, 2, 3, 4, 5, 6, 7); \
          acc[ai][bj][m][n] = __builtin_amdgcn_mfma_scale_f32_16x16x128_f8f6f4(b8_, a8_, acc[ai][bj][m][n], 0, 0, 0, 0, 0, 0); } } \
      else { _Pragma("unroll") for (int m = 0; m < 4; ++m) _Pragma("unroll") for (int n = 0; n < 2; ++n) _Pragma("unroll") for (int k = 0; k < 2; ++k) \
        acc[ai][bj][m][n] = __builtin_amdgcn_mfma_f32_16x16x32_bf16(Bt[n][k], At[m][k], acc[ai][bj][m][n], 0, 0, 0); } \
      __builtin_amdgcn_s_setprio(0); } while (0)
#define PG8_WAIT_V(n) asm volatile("s_waitcnt vmcnt(" #n ")" ::: "memory")
#define PG8_WAIT_L(n) asm volatile("s_waitcnt lgkmcnt(" #n ")" ::: "memory")
#define PG8_BAR __builtin_amdgcn_s_barrier()
#define PG8_SCHED __builtin_amdgcn_sched_barrier(0)
    Unit cur, nxt; int ui = 0;
    if (!S.next(0, cur)) return;
    f32x4 acc[2][2][4][2];
#pragma unroll
    for (int a = 0; a < 2; ++a)
#pragma unroll
        for (int b = 0; b < 2; ++b)
#pragma unroll
            for (int m = 0; m < 4; ++m)
#pragma unroll
                for (int n = 0; n < 2; ++n) acc[a][b][m][n] = (f32x4){0.f, 0.f, 0.f, 0.f};
    bf16x8 At[4][2], B0[2][2], B1[2][2];
    const char* cA = (const char*)g.A + (size_t)cur.pm * tstep; const char* cB = (const char*)g.Bt + (size_t)cur.pn * tstep;
    S.a_ready(cur);
    if constexpr (SP2) {
        PG8_STAGE(PG8_SB(0, 0), cB, voffB); PG8_STAGE(PG8_SB(0, 1), cB + hstep, voffB); PG8_STAGE(PG8_SA(0, 0), cA, voffA); PG8_STAGE(PG8_SA(0, 1), cA + hstep, voffA);
        if (wr == 1) PG8_BAR;
        PG8_WAIT_V(2); PG8_BAR;
        PG8_STAGE(PG8_SB(1, 0), cB + kstep, voffB); PG8_STAGE(PG8_SA(1, 0), cA + kstep, voffA); PG8_STAGE(PG8_SB(1, 1), cB + hstep + kstep, voffB);
        PG8_WAIT_V(6); PG8_BAR;
    } else {
        PG8_STAGE(PG8_SB(0, 0), cB, voffB); PG8_STAGE(PG8_SA(0, 0), cA, voffA); PG8_STAGE(PG8_SB(0, 1), cB + hstep, voffB); PG8_STAGE(PG8_SA(0, 1), cA + hstep, voffA);
        if (wr == 1) PG8_BAR;
        PG8_WAIT_V(4); PG8_BAR;
        PG8_STAGE(PG8_SB(1, 0), cB + kstep, voffB); PG8_STAGE(PG8_SA(1, 0), cA + kstep, voffA); PG8_STAGE(PG8_SB(1, 1), cB + hstep + kstep, voffB);
        PG8_WAIT_V(6); PG8_BAR;
    }
    for (;;) {
        const bool has_next = S.next(ui + 1, nxt);
        const char* nA = has_next ? (const char*)g.A + (size_t)nxt.pm * tstep : cA; const char* nB = has_next ? (const char*)g.Bt + (size_t)nxt.pn * tstep : cB;
        for (int t = 0; t < nt; t += 2) {
            const bool last = (t == nt - 2);
            const char* a1 = cA + (size_t)(t + 1) * kstep;
            const char* a2 = last ? nA : cA + (size_t)(t + 2) * kstep; const char* b2 = last ? nB : cB + (size_t)(t + 2) * kstep;
            const char* a3 = a2 + kstep; const char* b3 = b2 + kstep;
            if (last && has_next) S.a_ready(nxt);
            if constexpr (SP2) {
            PG8_LDB(B0, 0, 0); PG8_LDB(B1, 0, 1); PG8_SCHED; PG8_LDA(At, 0, 0); PG8_STAGE(PG8_SA(1, 1), a1 + hstep, voffA);
            PG8_WAIT_V(8); PG8_WAIT_L(0); PG8_BAR; PG8_MMA(0, 0, At, B0); PG8_MMA(0, 1, At, B1); PG8_BAR; PG8_SCHED;
            PG8_LDA(At, 0, 1); PG8_STAGE(PG8_SB(0, 0), b2, voffB); PG8_STAGE(PG8_SB(0, 1), b2 + hstep, voffB); PG8_STAGE(PG8_SA(0, 0), a2, voffA);
            PG8_WAIT_V(8); PG8_WAIT_L(0); PG8_BAR; PG8_MMA(1, 0, At, B0); PG8_MMA(1, 1, At, B1); PG8_BAR; PG8_SCHED;
            PG8_LDB(B0, 1, 0); PG8_LDB(B1, 1, 1); PG8_SCHED; PG8_LDA(At, 1, 0); PG8_STAGE(PG8_SA(0, 1), a2 + hstep, voffA);
            PG8_WAIT_V(8); PG8_WAIT_L(0); PG8_BAR; PG8_MMA(0, 0, At, B0); PG8_MMA(0, 1, At, B1); PG8_BAR; PG8_SCHED;
            PG8_LDA(At, 1, 1); PG8_STAGE(PG8_SB(1, 0), b3, voffB); PG8_STAGE(PG8_SB(1, 1), b3 + hstep, voffB); PG8_STAGE(PG8_SA(1, 0), a3, voffA);
            PG8_WAIT_V(8); PG8_WAIT_L(0); PG8_BAR; PG8_MMA(1, 0, At, B0); PG8_MMA(1, 1, At, B1); PG8_BAR; PG8_SCHED;
            } else {
            PG8_LDB(B0, 0, 0); PG8_SCHED; PG8_LDA(At, 0, 0); PG8_STAGE(PG8_SA(1, 1), a1 + hstep, voffA);
            PG8_WAIT_L(8); PG8_BAR; PG8_WAIT_L(0); PG8_MMA(0, 0, At, B0); PG8_BAR; PG8_SCHED;
            PG8_LDB(B1, 0, 1); PG8_STAGE(PG8_SB(0, 0), b2, voffB);
            PG8_BAR; PG8_WAIT_L(0); PG8_MMA(0, 1, At, B1); PG8_BAR;
            PG8_LDA(At, 0, 1); PG8_STAGE(PG8_SA(0, 0), a2, voffA);
            PG8_BAR; PG8_WAIT_L(0); PG8_MMA(1, 0, At, B0); PG8_BAR; PG8_SCHED;
            PG8_STAGE(PG8_SB(0, 1), b2 + hstep, voffB);
            PG8_WAIT_V(6); PG8_BAR; PG8_MMA(1, 1, At, B1); PG8_BAR;
            PG8_LDB(B0, 1, 0); PG8_SCHED; PG8_LDA(At, 1, 0); PG8_STAGE(PG8_SA(0, 1), a2 + hstep, voffA);
            PG8_WAIT_L(8); PG8_BAR; PG8_WAIT_L(0); PG8_MMA(0, 0, At, B0); PG8_BAR; PG8_SCHED;
            PG8_LDB(B1, 1, 1); PG8_STAGE(PG8_SB(1, 0), b3, voffB);
            PG8_BAR; PG8_WAIT_L(0); PG8_MMA(0, 1, At, B1); PG8_BAR;
            PG8_LDA(At, 1, 1); PG8_STAGE(PG8_SA(1, 0), a3, voffA);
            PG8_BAR; PG8_WAIT_L(0); PG8_MMA(1, 0, At, B0); PG8_BAR; PG8_SCHED;
            PG8_STAGE(PG8_SB(1, 1), b3 + hstep, voffB);
            PG8_WAIT_V(6); PG8_BAR; PG8_MMA(1, 1, At, B1); PG8_BAR;
            }
        }
        if constexpr (ALIGN_EPI) { if (wr == 0) PG8_BAR; }
        if constexpr (!Epi::AFTER_DRAIN) { int te_ = my_tid(); asm volatile("" : "+v"(te_));
            E(acc, cur, wr, wc, te_ & 15, (te_ >> 4) & 3); S.done(cur); }
        if (!has_next) break;
#pragma unroll
        for (int a = 0; a < 2; ++a)
#pragma unroll
            for (int b = 0; b < 2; ++b)
#pragma unroll
                for (int m = 0; m < 4; ++m)
#pragma unroll
                    for (int n = 0; n < 2; ++n) acc[a][b][m][n] = (f32x4){0.f, 0.f, 0.f, 0.f};
        cur = nxt; cA = nA; cB = nB; ++ui;
        if constexpr (ALIGN_EPI) { if (wr == 1) PG8_BAR; }
    }
    PG8_WAIT_V(0);
    if constexpr (!ALIGN_EPI) { if (wr == 0) PG8_BAR; }
    PG8_BAR;
    if constexpr (Epi::AFTER_DRAIN) { E.fused(acc, cur, wr, wc, fr, fq, lds, wid, lane); S.done(cur); }
#undef PG8_SA
#undef PG8_SB
#undef PG8_STAGE
#undef PG8_LDA
#undef PG8_LDB
#undef PG8_MMA
#undef PG8_WAIT_V
#undef PG8_WAIT_L
#undef PG8_BAR
#undef PG8_SCHED
}
}
#ifndef ATT_STAGGER
#define ATT_STAGGER 1
#endif
#ifndef MLA_STAGGER
#define MLA_STAGGER 0
#endif
#ifndef PV_LA
#define PV_LA 2
#endif
#ifndef ATT_STATIC_PRIO
#define ATT_STATIC_PRIO 0
#endif
#ifndef QK_FRESH_ADDR
#define QK_FRESH_ADDR 0
#endif
#ifndef SM_GUARD
#define SM_GUARD 1
#endif
#ifndef SM_NOSHIFT
#define SM_NOSHIFT 1
#endif
namespace att {
typedef unsigned short bf16_t;
using bf16x8 = __attribute__((ext_vector_type(8))) short;
using s16x4  = __attribute__((ext_vector_type(4))) short;
using f32x16 = __attribute__((ext_vector_type(16))) float;
using u32x4  = __attribute__((ext_vector_type(4))) unsigned;
constexpr int D = 128, NW = 8, QBLK = 32, KVBLK = 64;
constexpr int SHM_V = KVBLK * D * 2, SHM_K = KVBLK * D * 2, SHM_KR = KVBLK * 64 * 2;
constexpr int OFF_V = 0, OFF_K = 2 * SHM_V, OFF_KR = OFF_K + 2 * SHM_K, OFF_WS = OFF_KR + 2 * SHM_KR, OFF_QR = OFF_WS + NW * 64 * 4, LDS_BYTES = OFF_QR + NW * 4096;
constexpr float THR = 8.f;
#define KX(row) ((((row) & 3) << 2) | (((row) >> 2) & 3))
#define KSWZ(row, colB) ((row) * 256 + ((colB) ^ (KX(row) << 4)))
#define KRX(row) (((row) >> 1) & 7)
#define KRSWZ(row, colB) ((row) * 128 + ((colB) ^ (KRX(row) << 4)))
#define SBAR() __builtin_amdgcn_sched_barrier(0)
__device__ __forceinline__ int crow(int r, int hi) { return (r & 3) + 8 * (r >> 2) + 4 * hi; }
__device__ __forceinline__ unsigned cvtpk(float lo, float hi) {
  unsigned r; asm volatile("v_cvt_pk_bf16_f32 %0, %1, %2" : "=v"(r) : "v"(lo), "v"(hi)); return r;
}
template <class Cfg>
__device__ __forceinline__ void partialSM(f32x16& p0, f32x16& p1, float& m_reg, float& mn, float& alpha) {
  constexpr float C = Cfg::SCALE * 1.4426950408889634f;
  float pmax = p0[0];
#pragma unroll
  for (int r = 1; r < 16; ++r) pmax = fmaxf(pmax, p0[r]);
#pragma unroll
  for (int r = 0; r < 16; ++r) pmax = fmaxf(pmax, p1[r]);
  { auto rr = __builtin_amdgcn_permlane32_swap(__float_as_uint(pmax), __float_as_uint(pmax), false, false);
    pmax = fmaxf(__uint_as_float(rr[0]), __uint_as_float(rr[1])); }
  if (__builtin_expect(__all(pmax - m_reg <= THR / Cfg::SCALE), 1)) { mn = m_reg; alpha = 1.f; }
  else { mn = fmaxf(m_reg, pmax); alpha = __builtin_amdgcn_exp2f((m_reg - mn) * C); m_reg = mn; }
  float mnC = -mn * C;
#pragma unroll
  for (int r = 0; r < 16; ++r) p0[r] = fmaf(p0[r], C, mnC);
#pragma unroll
  for (int r = 0; r < 16; ++r) p1[r] = fmaf(p1[r], C, mnC);
#pragma unroll
  for (int r = 0; r < 16; ++r) p0[r] = __builtin_amdgcn_exp2f(p0[r]);
}
template <class Cfg>
__device__ __forceinline__ void partialSM_ns(f32x16& p0, f32x16& p1, float& m_reg, float& mn, float& alpha) {
  mn = m_reg; alpha = 1.f; SBAR();
#if SM_GUARD
  if (__builtin_expect(m_reg != 0.f, 0)) {
#pragma unroll
    for (int r = 0; r < 16; ++r) { p0[r] -= m_reg; p1[r] -= m_reg; } }
#endif
#pragma unroll
  for (int r = 0; r < 16; ++r) p0[r] = __builtin_amdgcn_exp2f(p0[r]);
}
template <bool NS = false> __device__ __forceinline__ void finishSM(f32x16& p0, f32x16& p1, float alpha, float& l_reg, bf16x8& pa0, bf16x8& pa1, bf16x8& pa2, bf16x8& pa3) {
#pragma unroll
  for (int r = 0; r < 16; ++r) p1[r] = __builtin_amdgcn_exp2f(p1[r]);
  float ps = 0;
#pragma unroll
  for (int r = 0; r < 16; ++r) ps += p0[r];
#pragma unroll
  for (int r = 0; r < 16; ++r) ps += p1[r];
  if constexpr (NS) l_reg += ps;
  else { auto rr = __builtin_amdgcn_permlane32_swap(__float_as_uint(ps), __float_as_uint(ps), false, false);
    ps = __uint_as_float(rr[0]) + __uint_as_float(rr[1]);
    l_reg = l_reg * alpha + ps; }
#define PK4(P, BASE, OUT) do { unsigned a0 = cvtpk(P[BASE + 0], P[BASE + 1]), a1 = cvtpk(P[BASE + 2], P[BASE + 3]);   \
    unsigned b0 = cvtpk(P[BASE + 4], P[BASE + 5]), b1 = cvtpk(P[BASE + 6], P[BASE + 7]);                              \
    auto r0 = __builtin_amdgcn_permlane32_swap(a0, b0, false, false); auto r1 = __builtin_amdgcn_permlane32_swap(a1, b1, false, false); \
    u32x4 w = {r0[0], r1[0], r0[1], r1[1]}; OUT = *reinterpret_cast<bf16x8*>(&w); } while (0)
  PK4(p0, 0, pa0); PK4(p0, 8, pa1); PK4(p1, 0, pa2); PK4(p1, 8, pa3);
#undef PK4
}
template <int NROPE>
__device__ __forceinline__ void qkt(f32x16& p0, f32x16& p1, const char* Ks, const char* Krs, const bf16x8* qr, const char* qrl, int r32, int hi) {
  p0 = f32x16{}; p1 = f32x16{};
#pragma unroll
  for (int d0 = 0; d0 < 8; ++d0) { int cb = (d0 * 16 + hi * 8) * 2;
    bf16x8 b0 = *reinterpret_cast<const bf16x8*>(Ks + KSWZ(r32, cb));
    bf16x8 b1 = *reinterpret_cast<const bf16x8*>(Ks + KSWZ(32 + r32, cb));
    p0 = __builtin_amdgcn_mfma_f32_32x32x16_bf16(b0, qr[d0], p0, 0, 0, 0);
    p1 = __builtin_amdgcn_mfma_f32_32x32x16_bf16(b1, qr[d0], p1, 0, 0, 0); }
  if constexpr (NROPE > 0) {
#pragma unroll
    for (int d0 = 0; d0 < NROPE / 16; ++d0) { int cb = (d0 * 16 + hi * 8) * 2;
      bf16x8 b0 = *reinterpret_cast<const bf16x8*>(Krs + KRSWZ(r32, cb));
      bf16x8 b1 = *reinterpret_cast<const bf16x8*>(Krs + KRSWZ(32 + r32, cb));
      bf16x8 qq = *reinterpret_cast<const bf16x8*>(qrl + KRSWZ(r32, cb));
      p0 = __builtin_amdgcn_mfma_f32_32x32x16_bf16(b0, qq, p0, 0, 0, 0);
      p1 = __builtin_amdgcn_mfma_f32_32x32x16_bf16(b1, qq, p1, 0, 0, 0); }
  }
}
__device__ __forceinline__ int v_st(int k, int c) { const int kk = (k & ~0xC) | ((k & 4) << 1) | ((k & 8) >> 1); return ((kk >> 3) * 4 + (c >> 5)) * 512 + ((kk & 7) * 32 + (c & 31)) * 2; }
__device__ __forceinline__ int v_rd_base(int lane) { return ((lane & 3) << 3) | (((lane >> 2) & 3) << 6) | (((lane >> 4) & 1) << 5) | (((lane >> 5) & 1) << 8); }
constexpr int v_rd_off(int d0, int ks, int half) { return d0 * 512 + ks * 4096 + half * 2048; }
template <int OFF> __device__ __forceinline__ s16x4 tr_read(int vb) {
  s16x4 r; asm volatile("ds_read_b64_tr_b16 %0, %1 offset:%2" : "=&v"(r) : "v"(vb), "i"(OFF) : "memory"); return r;
}
template <int D0> __device__ __forceinline__ void pv_one(f32x16& od, int vb, bf16x8 pa0, bf16x8 pa1, bf16x8 pa2, bf16x8 pa3) {
  const s16x4 l0 = tr_read<v_rd_off(D0, 0, 0)>(vb), h0 = tr_read<v_rd_off(D0, 0, 1)>(vb), l1 = tr_read<v_rd_off(D0, 1, 0)>(vb), h1 = tr_read<v_rd_off(D0, 1, 1)>(vb);
  const s16x4 l2 = tr_read<v_rd_off(D0, 2, 0)>(vb), h2 = tr_read<v_rd_off(D0, 2, 1)>(vb), l3 = tr_read<v_rd_off(D0, 3, 0)>(vb), h3 = tr_read<v_rd_off(D0, 3, 1)>(vb);
  asm volatile("s_waitcnt lgkmcnt(0)" ::: "memory"); SBAR();
#define PK(L, H) (bf16x8){L[0], L[1], L[2], L[3], H[0], H[1], H[2], H[3]}
  od = __builtin_amdgcn_mfma_f32_32x32x16_bf16(pa0, PK(l0, h0), od, 0, 0, 0);
  od = __builtin_amdgcn_mfma_f32_32x32x16_bf16(pa1, PK(l1, h1), od, 0, 0, 0);
  od = __builtin_amdgcn_mfma_f32_32x32x16_bf16(pa2, PK(l2, h2), od, 0, 0, 0);
  od = __builtin_amdgcn_mfma_f32_32x32x16_bf16(pa3, PK(l3, h3), od, 0, 0, 0);
#undef PK
}
__device__ __forceinline__ void pv_d0(f32x16* o, int vb, bf16x8 pa0, bf16x8 pa1, bf16x8 pa2, bf16x8 pa3) {
  pv_one<0>(o[0], vb, pa0, pa1, pa2, pa3); pv_one<1>(o[1], vb, pa0, pa1, pa2, pa3); pv_one<2>(o[2], vb, pa0, pa1, pa2, pa3); pv_one<3>(o[3], vb, pa0, pa1, pa2, pa3);
}

#define TR8(D0, L0, H0, L1, H1, L2, H2, L3, H3) const s16x4 L0 = tr_read<v_rd_off(D0, 0, 0)>(vb), H0 = tr_read<v_rd_off(D0, 0, 1)>(vb), L1 = tr_read<v_rd_off(D0, 1, 0)>(vb), H1 = tr_read<v_rd_off(D0, 1, 1)>(vb), \
    L2 = tr_read<v_rd_off(D0, 2, 0)>(vb), H2 = tr_read<v_rd_off(D0, 2, 1)>(vb), L3 = tr_read<v_rd_off(D0, 3, 0)>(vb), H3 = tr_read<v_rd_off(D0, 3, 1)>(vb)
#define PKV(L, H) (bf16x8){L[0], L[1], L[2], L[3], H[0], H[1], H[2], H[3]}
#define MM4(OD, L0, H0, L1, H1, L2, H2, L3, H3) do { OD = __builtin_amdgcn_mfma_f32_32x32x16_bf16(pa0, PKV(L0, H0), OD, 0, 0, 0); OD = __builtin_amdgcn_mfma_f32_32x32x16_bf16(pa1, PKV(L1, H1), OD, 0, 0, 0); \
    OD = __builtin_amdgcn_mfma_f32_32x32x16_bf16(pa2, PKV(L2, H2), OD, 0, 0, 0); OD = __builtin_amdgcn_mfma_f32_32x32x16_bf16(pa3, PKV(L3, H3), OD, 0, 0, 0); } while (0)
__device__ __forceinline__ void pv_d0p(f32x16* o, int vb, bf16x8 pa0, bf16x8 pa1, bf16x8 pa2, bf16x8 pa3) {
  TR8(0, a0, a1, a2, a3, a4, a5, a6, a7);
  TR8(1, b0, b1, b2, b3, b4, b5, b6, b7);
  asm volatile("s_waitcnt lgkmcnt(8)" ::: "memory"); __builtin_amdgcn_sched_barrier(0);
  MM4(o[0], a0, a1, a2, a3, a4, a5, a6, a7);
  TR8(2, c0, c1, c2, c3, c4, c5, c6, c7);
  asm volatile("s_waitcnt lgkmcnt(8)" ::: "memory"); __builtin_amdgcn_sched_barrier(0);
  MM4(o[1], b0, b1, b2, b3, b4, b5, b6, b7);
  TR8(3, d0, d1, d2, d3, d4, d5, d6, d7);
  asm volatile("s_waitcnt lgkmcnt(8)" ::: "memory"); __builtin_amdgcn_sched_barrier(0);
  MM4(o[2], c0, c1, c2, c3, c4, c5, c6, c7);
  asm volatile("s_waitcnt lgkmcnt(0)" ::: "memory"); __builtin_amdgcn_sched_barrier(0);
  MM4(o[3], d0, d1, d2, d3, d4, d5, d6, d7);
}
#undef TR8
#undef PKV
#undef MM4
template <int ND0> __device__ __forceinline__ void pv_nd(f32x16* o, int vb, bf16x8 pa0, bf16x8 pa1, bf16x8 pa2, bf16x8 pa3) {
  pv_one<0>(o[0], vb, pa0, pa1, pa2, pa3); pv_one<1>(o[1], vb, pa0, pa1, pa2, pa3);
  if constexpr (ND0 == 4) { pv_one<2>(o[2], vb, pa0, pa1, pa2, pa3); pv_one<3>(o[3], vb, pa0, pa1, pa2, pa3); }
}
constexpr int PA_LDS_BYTES = 2 * SHM_K + 4 * SHM_V + 16384 + 2048;
__device__ __forceinline__ void store_o(float* p, float v) { *p = v; }
__device__ __forceinline__ void store_o(bf16_t* p, float v) { unsigned u = __float_as_uint(v); u += 0x7fffu + ((u >> 16) & 1u); *p = (bf16_t)(u >> 16); }
struct QNorm { const float* g; const float* cs; const float* sn; float shift; };
__device__ __forceinline__ void up8(const bf16x8 v, float (&x)[8]) {
#pragma unroll
  for (int j = 0; j < 8; ++j) x[j] = __uint_as_float(((unsigned)(unsigned short)v[j]) << 16); }
__device__ __forceinline__ bf16x8 pk8(const float (&y)[8]) { u32x4 w = {cvtpk(y[0], y[1]), cvtpk(y[2], y[3]), cvtpk(y[4], y[5]), cvtpk(y[6], y[7])}; return *reinterpret_cast<bf16x8*>(&w); }
__device__ __forceinline__ float hsum32(float v) { const unsigned u = __float_as_uint(v); auto r = __builtin_amdgcn_permlane32_swap(u, u, false, false); return __uint_as_float(r[0]) + __uint_as_float(r[1]); }
template <bool ROT16> __device__ __forceinline__ void qnorm_nope(bf16x8 (&qr)[8], const float* g, const float* cs, const float* sn, int hi, float qs = 1.f) {
  float ss = 0.f;
#pragma unroll
  for (int d0 = 0; d0 < 8; ++d0) { float x[8]; up8(qr[d0], x);
#pragma unroll
    for (int t = 0; t < 8; ++t) ss += x[t] * x[t]; }
  const float rstd = __builtin_amdgcn_rsqf(hsum32(ss) * (1.f / 128.f) + 1e-6f) * qs;
  if (ROT16) { float u[8], w[8]; up8(qr[0], u); up8(qr[1], w);
#pragma unroll
    for (int t = 0; t < 8; ++t) { const float c = cs[hi * 8 + t], s = sn[hi * 8 + t], a = u[t] * rstd * g[hi * 8 + t], b = w[t] * rstd * g[16 + hi * 8 + t]; u[t] = a * c - b * s; w[t] = b * c + a * s; }
    qr[0] = pk8(u); qr[1] = pk8(w); }
#pragma unroll
  for (int d0 = (ROT16 ? 2 : 0); d0 < 8; ++d0) { float x[8]; up8(qr[d0], x);
#pragma unroll
    for (int t = 0; t < 8; ++t) x[t] = x[t] * rstd * g[d0 * 16 + hi * 8 + t];
    qr[d0] = pk8(x); }
}
__device__ __forceinline__ void qnorm_rope(bf16x8 (&qrr)[4], const float* g, const float* cs, const float* sn, int hi, float qs = 1.f) {
  float ss = 0.f;
#pragma unroll
  for (int d0 = 0; d0 < 4; ++d0) { float x[8]; up8(qrr[d0], x);
#pragma unroll
    for (int t = 0; t < 8; ++t) ss += x[t] * x[t]; }
  const float rstd = __builtin_amdgcn_rsqf(hsum32(ss) * (1.f / 64.f) + 1e-6f) * qs;
#pragma unroll
  for (int d0 = 0; d0 < 2; ++d0) { float u[8], w[8]; up8(qrr[d0], u); up8(qrr[d0 + 2], w);
#pragma unroll
    for (int t = 0; t < 8; ++t) { const float c = cs[d0 * 16 + hi * 8 + t], s = sn[d0 * 16 + hi * 8 + t], a = u[t] * rstd * g[d0 * 16 + hi * 8 + t], b = w[t] * rstd * g[(d0 + 2) * 16 + hi * 8 + t]; u[t] = a * c - b * s; w[t] = b * c + a * s; }
    qrr[d0] = pk8(u); qrr[d0 + 2] = pk8(w); }
}

template <class Cfg>
__device__ __forceinline__ void attn_unit(const bf16_t* __restrict__ Qb, const bf16_t* __restrict__ Kh, const bf16_t* __restrict__ Vh,
                                          const bf16_t* __restrict__ Qr, const bf16_t* __restrict__ Kr, typename Cfg::OutT* __restrict__ Ob, int seq, char* lds) {
  constexpr int LDQ = Cfg::LDQ, LDK = Cfg::LDK, LDV = Cfg::LDV, LDO = Cfg::LDO, LDKR = Cfg::LDKR, NROPE = Cfg::NROPE, SDEPTH = Cfg::SDEPTH;
  static_assert(SDEPTH == 1 || SDEPTH == 2, "SDEPTH is 1 or 2");
  int tid = my_tid(); asm volatile("" : "+v"(tid));
  const int wid = tid >> 6, lane = tid & 63, r32 = lane & 31, hi = lane >> 5;
  char* V_lds = lds + OFF_V; char* K_lds = lds + OFF_K; char* KR_lds = lds + OFF_KR;
  float* ws = (float*)(lds + OFF_WS) + wid * 64; float* li_l = ws; float* al_l = ws + 32;
  float m_reg = -1e30f, l_reg = 0; f32x16 o[4] = {}; bf16x8 qr[8]; const char* qrl = lds + OFF_QR + wid * 4096;
  const bf16_t* Qw = Qb + (long)(wid * QBLK + r32) * LDQ + hi * 8;
#pragma unroll
  for (int d0 = 0; d0 < 8; ++d0) qr[d0] = *reinterpret_cast<const bf16x8*>(Qw + d0 * 16);
  if constexpr (NROPE > 0) {
    const bf16_t* Qrw = Qr + (long)(wid * QBLK + r32) * LDQ + hi * 8;
#pragma unroll
    for (int d0 = 0; d0 < 4; ++d0) *(bf16x8*)(lds + OFF_QR + wid * 4096 + KRSWZ(r32, (d0 * 16 + hi * 8) * 2)) = *reinterpret_cast<const bf16x8*>(Qrw + d0 * 16);
  }
  const int sr = tid >> 4, sc = (tid & 15) * 8, vst0 = v_st(sr, sc), vst1 = v_st(32 + sr, sc);
  const int krr = tid >> 3, krc = (tid & 7) * 8;
  const int vb0 = (int)(uintptr_t)V_lds + v_rd_base(lane);
  struct { bf16x8 vs0, vs1, ks0, ks1, kr; } sr_[SDEPTH];
#define SLOAD(i, k0) do { sr_[i].vs0 = *reinterpret_cast<const bf16x8*>(&Vh[(long)((k0) + sr) * LDV + sc]); sr_[i].vs1 = *reinterpret_cast<const bf16x8*>(&Vh[(long)((k0) + 32 + sr) * LDV + sc]); \
    sr_[i].ks0 = *reinterpret_cast<const bf16x8*>(&Kh[(long)((k0) + sr) * LDK + sc]); sr_[i].ks1 = *reinterpret_cast<const bf16x8*>(&Kh[(long)((k0) + 32 + sr) * LDK + sc]); \
    if constexpr (NROPE > 0) sr_[i].kr = *reinterpret_cast<const bf16x8*>(&Kr[(long)((k0) + krr) * LDKR + krc]); } while (0)
#define SWRITE(b, i) do { *(bf16x8*)(V_lds + (b) * SHM_V + vst0) = sr_[i].vs0;          \
    *(bf16x8*)(V_lds + (b) * SHM_V + vst1) = sr_[i].vs1; int kc = sc * 2;               \
    *(bf16x8*)(K_lds + (b) * SHM_K + KSWZ(sr, kc)) = sr_[i].ks0;                       \
    *(bf16x8*)(K_lds + (b) * SHM_K + KSWZ(32 + sr, kc)) = sr_[i].ks1;                  \
    if constexpr (NROPE > 0) *(bf16x8*)(KR_lds + (b) * SHM_KR + KRSWZ(krr, krc * 2)) = sr_[i].kr; } while (0)
#define SWAIT() do { if constexpr (SDEPTH == 1) asm volatile("s_waitcnt vmcnt(0)" ::: "memory"); else if constexpr (NROPE > 0) asm volatile("s_waitcnt vmcnt(5)" ::: "memory"); else asm volatile("s_waitcnt vmcnt(4)" ::: "memory"); } while (0)
#define RESC(a) do { if (__any((a) < 1.f)) { if (hi == 0) al_l[r32] = (a); asm volatile("s_waitcnt lgkmcnt(0)" ::: "memory"); \
    _Pragma("unroll") for (int d = 0; d < 4; ++d) _Pragma("unroll") for (int r = 0; r < 16; ++r) o[d][r] *= al_l[crow(r, hi)]; } } while (0)
  f32x16 pA0, pA1, pB0, pB1; float mnA, mnB, alA, alB; bf16x8 pa0, pa1, pa2, pa3; const int NT = seq / KVBLK;
  constexpr int SE = 0, SO = SDEPTH - 1;
  SLOAD(SE, 0); asm volatile("s_waitcnt vmcnt(0)" ::: "memory"); SWRITE(0, SE); __syncthreads();
  qkt<NROPE>(pA0, pA1, K_lds, KR_lds, qr, qrl, r32, hi); partialSM<Cfg>(pA0, pA1, m_reg, mnA, alA);
  SLOAD(SO, KVBLK); if constexpr (SDEPTH == 2) { if (2 < NT) SLOAD(SE, 2 * KVBLK); }
  SWAIT(); SWRITE(1, SO); __syncthreads();
  for (int j = 1; j + 1 < NT; j += 2) {
    SBAR(); qkt<NROPE>(pB0, pB1, K_lds + SHM_K, KR_lds + SHM_KR, qr, qrl, r32, hi);
    finishSM(pA0, pA1, alA, l_reg, pa0, pa1, pa2, pa3); SBAR();
    SLOAD(SO, (j + SDEPTH) * KVBLK); SBAR();
    pv_d0(o, vb0, pa0, pa1, pa2, pa3); partialSM<Cfg>(pB0, pB1, m_reg, mnB, alB);
    __syncthreads(); SWAIT(); SWRITE(0, SE);
    RESC(alB); __syncthreads();
    SBAR(); qkt<NROPE>(pA0, pA1, K_lds, KR_lds, qr, qrl, r32, hi);
    finishSM(pB0, pB1, alB, l_reg, pa0, pa1, pa2, pa3); SBAR();
    if (SDEPTH == 1 || j + 3 < NT) SLOAD(SE, (j + 1 + SDEPTH) * KVBLK); SBAR();
    pv_d0(o, vb0 + SHM_V, pa0, pa1, pa2, pa3); partialSM<Cfg>(pA0, pA1, m_reg, mnA, alA);
    __syncthreads(); SWAIT(); SWRITE(1, SO);
    RESC(alA); __syncthreads();
  }
  SBAR(); qkt<NROPE>(pB0, pB1, K_lds + SHM_K, KR_lds + SHM_KR, qr, qrl, r32, hi);
  finishSM(pA0, pA1, alA, l_reg, pa0, pa1, pa2, pa3); SBAR();
  pv_d0(o, vb0, pa0, pa1, pa2, pa3); partialSM<Cfg>(pB0, pB1, m_reg, mnB, alB);
  __syncthreads(); RESC(alB);
  finishSM(pB0, pB1, alB, l_reg, pa0, pa1, pa2, pa3); SBAR();
  pv_d0(o, vb0 + SHM_V, pa0, pa1, pa2, pa3);
  if (hi == 0) li_l[r32] = l_reg; asm volatile("s_waitcnt lgkmcnt(0)" ::: "memory");
  float rli[16];
#pragma unroll
  for (int r = 0; r < 16; ++r) rli[r] = __builtin_amdgcn_rcpf(li_l[crow(r, hi)]);
  typename Cfg::OutT* Ow = Ob + (long)(wid * QBLK) * LDO;
#pragma unroll
  for (int r = 0; r < 16; ++r) { int orow = crow(r, hi);
#pragma unroll
    for (int d0 = 0; d0 < 4; ++d0) store_o(Ow + (long)orow * LDO + d0 * 32 + r32, o[d0][r] * rli[r]); }
#undef SLOAD
#undef SWRITE
#undef SWAIT
#undef RESC
}

#define KX(row) ((((row) & 3) << 2) | (((row) >> 2) & 3))
#define KSWZ(row, colB) ((row) * 256 + ((colB) ^ (KX(row) << 4)))
#define KRX(row) (((row) >> 1) & 7)
#define KRSWZ(row, colB) ((row) * 128 + ((colB) ^ (KRX(row) << 4)))
#define SBAR() __builtin_amdgcn_sched_barrier(0)
#define ATT_LAS __attribute__((address_space(3)))
constexpr int D_OFF_K = 0, D_OFF_V = 3 * SHM_K, D_OFF_KR = D_OFF_V + 3 * SHM_V, D_OFF_WS = D_OFF_KR + 3 * SHM_KR, DMA_LDS_BYTES = D_OFF_WS + NW * 64 * 4;
template <int NROPE>
__device__ __forceinline__ void qkt_r(f32x16& p0, f32x16& p1, const char* Ks, const char* Krs, const bf16x8* qr, const bf16x8* qrr, int r32_, int hi) {
  int r32 = r32_; if (QK_FRESH_ADDR) asm volatile("" : "+v"(r32));
  p0 = f32x16{}; p1 = f32x16{};
#pragma unroll
  for (int d0 = 0; d0 < 8; ++d0) { int cb = (d0 * 16 + hi * 8) * 2;
    bf16x8 b0 = *reinterpret_cast<const bf16x8*>(Ks + KSWZ(r32, cb));
    bf16x8 b1 = *reinterpret_cast<const bf16x8*>(Ks + KSWZ(32 + r32, cb));
    p0 = __builtin_amdgcn_mfma_f32_32x32x16_bf16(b0, qr[d0], p0, 0, 0, 0);
    p1 = __builtin_amdgcn_mfma_f32_32x32x16_bf16(b1, qr[d0], p1, 0, 0, 0); }
  if constexpr (NROPE > 0) {
#pragma unroll
    for (int d0 = 0; d0 < NROPE / 16; ++d0) { int cb = (d0 * 16 + hi * 8) * 2;
      bf16x8 b0 = *reinterpret_cast<const bf16x8*>(Krs + KRSWZ(r32, cb));
      bf16x8 b1 = *reinterpret_cast<const bf16x8*>(Krs + KRSWZ(32 + r32, cb));
      p0 = __builtin_amdgcn_mfma_f32_32x32x16_bf16(b0, qrr[d0], p0, 0, 0, 0);
      p1 = __builtin_amdgcn_mfma_f32_32x32x16_bf16(b1, qrr[d0], p1, 0, 0, 0); }
  }
}
#define PV_FN(...) do { if constexpr (Cfg::PVPIPE) pv_d0p(__VA_ARGS__); else pv_d0(__VA_ARGS__); } while (0)
template <class Cfg>
__device__ __forceinline__ void attn_unit_dma(const bf16_t* __restrict__ Qb, const bf16_t* __restrict__ Kh, const bf16_t* __restrict__ Vh,
                                              const bf16_t* __restrict__ Qr, const bf16_t* __restrict__ Kr, typename Cfg::OutT* __restrict__ Ob, int seq, char* lds, ATT_LAS unsigned char* ldsl, const QNorm qn) {
  constexpr int LDQ = Cfg::LDQ, LDK = Cfg::LDK, LDV = Cfg::LDV, LDO = Cfg::LDO, LDKR = Cfg::LDKR, NROPE = Cfg::NROPE;
  int tid = my_tid(); asm volatile("" : "+v"(tid));
  const int wid = __builtin_amdgcn_readfirstlane(tid >> 6), lane = tid & 63, r32 = lane & 31, hi = lane >> 5;
  char* V_lds = lds + D_OFF_V; char* K_lds = lds + D_OFF_K; char* KR_lds = lds + D_OFF_KR;
  float* ws = (float*)(lds + D_OFF_WS) + wid * 64; float* li_l = ws; float* al_l = ws + 32;
  float m_reg = -1e30f, l_reg = 0; f32x16 o[4] = {}; bf16x8 qr[8]; bf16x8 qrr[4];
  constexpr float QS = 1.f;
  const bf16_t* Qw = Qb + (long)(wid * QBLK + r32) * LDQ + hi * 8;
#pragma unroll
  for (int d0 = 0; d0 < 8; ++d0) qr[d0] = *reinterpret_cast<const bf16x8*>(Qw + d0 * 16);
#pragma unroll
  for (int d0 = 0; d0 < 4; ++d0) qrr[d0] = bf16x8{};
  if constexpr (NROPE > 0) { const bf16_t* Qrw = Qr + (long)(wid * QBLK + r32) * LDQ + hi * 8;
#pragma unroll
    for (int d0 = 0; d0 < 4; ++d0) qrr[d0] = *reinterpret_cast<const bf16x8*>(Qrw + d0 * 16); }
  if constexpr (Cfg::QNORM) {
    if constexpr (NROPE > 0) { qnorm_nope<false>(qr, qn.g, nullptr, nullptr, hi, QS); qnorm_rope(qrr, qn.g + 128, qn.cs + (wid * QBLK + r32) * 32, qn.sn + (wid * QBLK + r32) * 32, hi, QS); }
    else qnorm_nope<true>(qr, qn.g, qn.cs + (wid * QBLK + r32) * 16, qn.sn + (wid * QBLK + r32) * 16, hi, QS); }
  unsigned koff[2], voff[2], kroff = 0;
#pragma unroll
  for (int i = 0; i < 2; ++i) { const int q = wid * 2 + i;
    { const int R = 4 * q + (lane >> 4), g = (lane & 15) ^ KX(R); koff[i] = (unsigned)(R * LDK * 2 + g * 16); }
    { const int kk = (q >> 1) * 8 + ((lane & 31) >> 2), k = (kk & ~0xC) | ((kk & 4) << 1) | ((kk & 8) >> 1), c = (2 * (q & 1) + (lane >> 5)) * 32 + (lane & 3) * 8;
      voff[i] = (unsigned)(k * LDV * 2 + c * 2); } }
  if constexpr (NROPE > 0) { const int R = 8 * wid + (lane >> 3), g = (lane & 7) ^ KRX(R); kroff = (unsigned)(R * LDKR * 2 + g * 16); }
  const int vb0 = (int)(uintptr_t)V_lds + v_rd_base(lane);
#define DMA_TILE(t, s) do { const char* kb_ = (const char*)Kh + (size_t)(t) * (KVBLK * LDK * 2); const char* vb_ = (const char*)Vh + (size_t)(t) * (KVBLK * LDV * 2); \
    _Pragma("unroll") for (int i_ = 0; i_ < 2; ++i_) { \
      __builtin_amdgcn_global_load_lds((const unsigned*)(kb_ + koff[i_]), (ATT_LAS unsigned*)(ldsl + D_OFF_K + (s) * SHM_K + (wid * 2 + i_) * 1024), 16, 0, 0); \
      __builtin_amdgcn_global_load_lds((const unsigned*)(vb_ + voff[i_]), (ATT_LAS unsigned*)(ldsl + D_OFF_V + (s) * SHM_V + (wid * 2 + i_) * 1024), 16, 0, 0); } \
    if constexpr (NROPE > 0) { const char* rb_ = (const char*)Kr + (size_t)(t) * (KVBLK * LDKR * 2); \
      __builtin_amdgcn_global_load_lds((const unsigned*)(rb_ + kroff), (ATT_LAS unsigned*)(ldsl + D_OFF_KR + (s) * SHM_KR + wid * 1024), 16, 0, 0); } } while (0)
#define DWAITBAR() do { asm volatile("s_waitcnt vmcnt(0)" ::: "memory"); __builtin_amdgcn_s_barrier(); asm volatile("" ::: "memory"); } while (0)
#define RESC(a) do { if (__any((a) < 1.f)) { if (hi == 0) al_l[r32] = (a); asm volatile("s_waitcnt lgkmcnt(0)" ::: "memory"); \
    _Pragma("unroll") for (int d = 0; d < 4; ++d) _Pragma("unroll") for (int r = 0; r < 16; ++r) o[d][r] *= al_l[crow(r, hi)]; } } while (0)
  f32x16 pA0, pA1, pB0, pB1; float mnA, mnB, alA, alB; bf16x8 pa0, pa1, pa2, pa3; const int NT = seq / KVBLK;
  if (ATT_STATIC_PRIO && wid >= 4) __builtin_amdgcn_s_setprio(1);
  DMA_TILE(0, 0); DMA_TILE(1, 1); DWAITBAR();
  qkt_r<NROPE>(pA0, pA1, K_lds, KR_lds, qr, qrr, r32, hi); partialSM<Cfg>(pA0, pA1, m_reg, mnA, alA);
  if (2 < NT) DMA_TILE(2, 2);
  int s_m1 = 0, s_0 = 1, s_p1 = 2;
  for (int t = 1; t + 1 < NT; t += 2) {
    SBAR(); qkt_r<NROPE>(pB0, pB1, K_lds + s_0 * SHM_K, KR_lds + s_0 * SHM_KR, qr, qrr, r32, hi);
    finishSM(pA0, pA1, alA, l_reg, pa0, pa1, pa2, pa3); SBAR();
    PV_FN(o, vb0 + s_m1 * SHM_V, pa0, pa1, pa2, pa3); partialSM<Cfg>(pB0, pB1, m_reg, mnB, alB);
    DWAITBAR();
    if (t + 2 < NT) DMA_TILE(t + 2, s_m1);
    RESC(alB);
    SBAR(); qkt_r<NROPE>(pA0, pA1, K_lds + s_p1 * SHM_K, KR_lds + s_p1 * SHM_KR, qr, qrr, r32, hi);
    finishSM(pB0, pB1, alB, l_reg, pa0, pa1, pa2, pa3); SBAR();
    PV_FN(o, vb0 + s_0 * SHM_V, pa0, pa1, pa2, pa3); partialSM<Cfg>(pA0, pA1, m_reg, mnA, alA);
    DWAITBAR();
    if (t + 3 < NT) DMA_TILE(t + 3, s_0);
    RESC(alA);
    { const int a_ = s_m1; s_m1 = s_p1; s_p1 = s_0; s_0 = a_; }
  }
  SBAR(); qkt_r<NROPE>(pB0, pB1, K_lds + s_0 * SHM_K, KR_lds + s_0 * SHM_KR, qr, qrr, r32, hi);
  finishSM(pA0, pA1, alA, l_reg, pa0, pa1, pa2, pa3); SBAR();
  PV_FN(o, vb0 + s_m1 * SHM_V, pa0, pa1, pa2, pa3); partialSM<Cfg>(pB0, pB1, m_reg, mnB, alB);
  RESC(alB);
  finishSM(pB0, pB1, alB, l_reg, pa0, pa1, pa2, pa3); SBAR();
  PV_FN(o, vb0 + s_0 * SHM_V, pa0, pa1, pa2, pa3);
  if (hi == 0) li_l[r32] = l_reg; asm volatile("s_waitcnt lgkmcnt(0)" ::: "memory");
  float rli[16];
#pragma unroll
  for (int r = 0; r < 16; ++r) rli[r] = __builtin_amdgcn_rcpf(li_l[crow(r, hi)]);
  int r32e = r32, hie = hi; asm volatile("" : "+v"(r32e), "+v"(hie));
  typename Cfg::OutT* Ow = Ob + (long)(wid * QBLK) * LDO;
#pragma unroll
  for (int r = 0; r < 16; ++r) { int orow = crow(r, hie);
#pragma unroll
    for (int d0 = 0; d0 < 4; ++d0) store_o(Ow + (long)orow * LDO + d0 * 32 + r32e, o[d0][r] * rli[r]); }
  if (ATT_STATIC_PRIO) __builtin_amdgcn_s_setprio(0);
  __builtin_amdgcn_s_barrier();
#undef DMA_TILE
#undef DWAITBAR
#undef RESC
}
#undef KSWZ
#undef KRSWZ
#undef KX
#undef KRX
#undef SBAR
#define KX(row) ((((row) & 3) << 2) | (((row) >> 2) & 3))
#define KSWZ(row, colB) ((row) * 256 + ((colB) ^ (KX(row) << 4)))
#define KRX(row) (((row) >> 1) & 7)
#define KRSWZ(row, colB) ((row) * 128 + ((colB) ^ (KRX(row) << 4)))
#define SBAR() __builtin_amdgcn_sched_barrier(0)

template <class Cfg>
__device__ __forceinline__ void attn_unit_pa(const bf16_t* __restrict__ Qb, const bf16_t* __restrict__ Kh, const bf16_t* __restrict__ Vh,
                                             const bf16_t* __restrict__ Qr, const bf16_t* __restrict__ Kr, typename Cfg::OutT* __restrict__ Ob, int seq, char* lds) {
  constexpr int LDQ = Cfg::LDQ, LDK = Cfg::LDK, LDV = Cfg::LDV, LDO = Cfg::LDO, LDKR = Cfg::LDKR, NROPE = Cfg::NROPE, VW = Cfg::VW;
  constexpr int NVH = VW / 128, ND0 = VW / 64;
  static_assert(VW == 128 || VW == 256, "VW is 128 or 256");
  constexpr int P_OFF_K = 0, P_OFF_KR = 2 * SHM_K, P_OFF_V = P_OFF_KR + (NROPE > 0 ? 2 * SHM_KR : 0), P_OFF_PX = P_OFF_V + 2 * NVH * SHM_V, P_OFF_AX = P_OFF_PX + 16384, P_OFF_LX = P_OFF_AX + 1024, P_OFF_QR = P_OFF_LX + 1024;
  static_assert(P_OFF_QR + (NROPE > 0 ? 16384 : 0) <= PA_LDS_BYTES, "pair-alternating body: LDS map");
  int tid = my_tid(); asm volatile("" : "+v"(tid));
  const int wid = __builtin_amdgcn_readfirstlane(tid >> 6), lane = tid & 63, r32 = lane & 31, hi = lane >> 5, rg = wid & 3, e = wid >> 2;
  char* K_lds = lds + P_OFF_K; char* KR_lds = lds + P_OFF_KR; char* V_lds = lds + P_OFF_V;
  char* PX = lds + P_OFF_PX + rg * 4096 + lane * 16;
  float* AX = (float*)(lds + P_OFF_AX) + rg * 64;
  float* LX = (float*)(lds + P_OFF_LX) + rg * 64;
  const char* qrl = lds + P_OFF_QR + rg * 4096;
  float m_reg = -1e30f, l_reg = 0; f32x16 o[ND0]; bf16x8 qr[8];
#pragma unroll
  for (int d = 0; d < ND0; ++d) o[d] = f32x16{};
  const bf16_t* Qw = Qb + (long)(rg * QBLK + r32) * LDQ + hi * 8;
#pragma unroll
  for (int d0 = 0; d0 < 8; ++d0) qr[d0] = *reinterpret_cast<const bf16x8*>(Qw + d0 * 16);
  if constexpr (NROPE > 0) { if (e == 0) { const bf16_t* Qrw = Qr + (long)(rg * QBLK + r32) * LDQ + hi * 8;
#pragma unroll
      for (int d0 = 0; d0 < 4; ++d0) *(bf16x8*)(lds + P_OFF_QR + rg * 4096 + KRSWZ(r32, (d0 * 16 + hi * 8) * 2)) = *reinterpret_cast<const bf16x8*>(Qrw + d0 * 16); } }
  const int sr = tid >> 4, sc = (tid & 15) * 8, vst0 = v_st(sr, sc), vst1 = v_st(32 + sr, sc);
  const int krr = tid >> 3, krc = (tid & 7) * 8;
  const int vb0 = (int)(uintptr_t)V_lds + v_rd_base(lane) + ((e * ND0) >> 2) * SHM_V + ((e * ND0) & 3) * 512;
  struct { bf16x8 k0, k1, kr, v[2 * NVH]; } st;
#define PLOAD(kt, vt) do { st.k0 = *reinterpret_cast<const bf16x8*>(&Kh[(long)((kt) * KVBLK + sr) * LDK + sc]); st.k1 = *reinterpret_cast<const bf16x8*>(&Kh[(long)((kt) * KVBLK + 32 + sr) * LDK + sc]); \
    if constexpr (NROPE > 0) st.kr = *reinterpret_cast<const bf16x8*>(&Kr[(long)((kt) * KVBLK + krr) * LDKR + krc]); \
    _Pragma("unroll") for (int vh = 0; vh < NVH; ++vh) { st.v[2 * vh] = *reinterpret_cast<const bf16x8*>(&Vh[(long)((vt) * KVBLK + sr) * LDV + vh * 128 + sc]); \
      st.v[2 * vh + 1] = *reinterpret_cast<const bf16x8*>(&Vh[(long)((vt) * KVBLK + 32 + sr) * LDV + vh * 128 + sc]); } } while (0)
#define PWRITE(kb, vbuf) do { *(bf16x8*)(K_lds + (kb) * SHM_K + KSWZ(sr, sc * 2)) = st.k0; *(bf16x8*)(K_lds + (kb) * SHM_K + KSWZ(32 + sr, sc * 2)) = st.k1; \
    if constexpr (NROPE > 0) *(bf16x8*)(KR_lds + (kb) * SHM_KR + KRSWZ(krr, krc * 2)) = st.kr; \
    _Pragma("unroll") for (int vh = 0; vh < NVH; ++vh) { *(bf16x8*)(V_lds + ((vbuf) * NVH + vh) * SHM_V + vst0) = st.v[2 * vh]; *(bf16x8*)(V_lds + ((vbuf) * NVH + vh) * SHM_V + vst1) = st.v[2 * vh + 1]; } } while (0)
  f32x16 p0, p1; float mn, alpha; bf16x8 pa0, pa1, pa2, pa3; const int NT = seq / KVBLK;
  PLOAD(0, 0); PWRITE(0, 0); PLOAD(1, 0); PWRITE(1, 0); __syncthreads();
  if (e == 0) qkt<NROPE>(p0, p1, K_lds, KR_lds, qr, qrl, r32, hi);
  PLOAD(2 < NT ? 2 : NT - 1, 1);
#define PSLOT(j, PE) do { \
    if (e == (PE)) { partialSM<Cfg>(p0, p1, m_reg, mn, alpha); finishSM(p0, p1, alpha, l_reg, pa0, pa1, pa2, pa3); \
      *(bf16x8*)(PX) = pa0; *(bf16x8*)(PX + 1024) = pa1; *(bf16x8*)(PX + 2048) = pa2; *(bf16x8*)(PX + 3072) = pa3; \
      if (hi == 0) { AX[2 * r32] = alpha; AX[2 * r32 + 1] = mn; } } \
    else { if ((j) + 1 < NT) qkt<NROPE>(p0, p1, K_lds + (((j) + 1) & 1) * SHM_K, KR_lds + (((j) + 1) & 1) * SHM_KR, qr, qrl, r32, hi); } \
    __syncthreads(); SBAR(); \
    { const float al = AX[2 * r32], mm = AX[2 * r32 + 1]; \
      if (e != (PE)) { pa0 = *(const bf16x8*)(PX); pa1 = *(const bf16x8*)(PX + 1024); pa2 = *(const bf16x8*)(PX + 2048); pa3 = *(const bf16x8*)(PX + 3072); m_reg = mm; l_reg *= al; } \
      if (__any(al < 1.f)) { _Pragma("unroll") for (int r = 0; r < 16; ++r) { const float ar = AX[2 * crow(r, hi)]; _Pragma("unroll") for (int d = 0; d < ND0; ++d) o[d][r] *= ar; } } } \
    SBAR(); pv_nd<ND0>(o, vb0 + ((j) & 1) * NVH * SHM_V, pa0, pa1, pa2, pa3); SBAR(); \
    if ((j) + 1 < NT) { PWRITE((j) & 1, ((j) + 1) & 1); const int kt_ = (j) + 3 < NT ? (j) + 3 : NT - 1, vt_ = (j) + 2 < NT ? (j) + 2 : NT - 1; PLOAD(kt_, vt_); } \
    __syncthreads(); SBAR(); } while (0)
  for (int j = 0; j < NT; j += 2) { PSLOT(j, 0); PSLOT(j + 1, 1); }
  if (hi == 0) LX[e * 32 + r32] = l_reg;
  __syncthreads();
  float rli[16];
#pragma unroll
  for (int r = 0; r < 16; ++r) rli[r] = __builtin_amdgcn_rcpf(LX[crow(r, hi)] + LX[32 + crow(r, hi)]);
  typename Cfg::OutT* Ow = Ob + (long)(rg * QBLK) * LDO + e * (VW / 2);
#pragma unroll
  for (int r = 0; r < 16; ++r) { int orow = crow(r, hi);
#pragma unroll
    for (int d0 = 0; d0 < ND0; ++d0) store_o(Ow + (long)orow * LDO + d0 * 32 + r32, o[d0][r] * rli[r]); }
#undef PLOAD
#undef PWRITE
#undef PSLOT
}

constexpr int PD_OFF_K = 0, PD_OFF_V = 3 * SHM_K, PD_OFF_PX = PD_OFF_V + 4 * SHM_V, PD_OFF_AX = PD_OFF_PX + 16384, PD_OFF_LX = PD_OFF_AX + 1024, PAD_LDS_BYTES = PD_OFF_LX + 1024;
template <class Cfg>
__device__ __forceinline__ void attn_unit_pad(const bf16_t* __restrict__ Qb, const bf16_t* __restrict__ Kh, const bf16_t* __restrict__ Vh, typename Cfg::OutT* __restrict__ Ob, int seq, char* lds, ATT_LAS unsigned char* ldsl) {
  constexpr int LDQ = Cfg::LDQ, LDK = Cfg::LDK, LDV = Cfg::LDV, LDO = Cfg::LDO, VW = Cfg::VW, ND0 = 4;
  static_assert(VW == 256 && Cfg::NROPE == 0, "attn_unit_pad: 256 value columns, no rope");
  int tid = my_tid(); asm volatile("" : "+v"(tid));
  const int wid = __builtin_amdgcn_readfirstlane(tid >> 6), lane = tid & 63, r32 = lane & 31, hi = lane >> 5, rg = wid & 3, e = wid >> 2;
  char* K_lds = lds + PD_OFF_K; char* V_lds = lds + PD_OFF_V;
  char* PX = lds + PD_OFF_PX + rg * 4096 + lane * 16;
  float* AX = (float*)(lds + PD_OFF_AX) + rg * 64;
  float* LX = (float*)(lds + PD_OFF_LX) + rg * 64;
  float m_reg = -1e30f, l_reg = 0; f32x16 o[ND0]; bf16x8 qr[8];
#pragma unroll
  for (int d = 0; d < ND0; ++d) o[d] = f32x16{};
  const bf16_t* Qw = Qb + (long)(rg * QBLK + r32) * LDQ + hi * 8;
#pragma unroll
  for (int d0 = 0; d0 < 8; ++d0) qr[d0] = *reinterpret_cast<const bf16x8*>(Qw + d0 * 16);
  unsigned koff[2], voff[4];
#pragma unroll
  for (int i = 0; i < 2; ++i) { const int q = wid * 2 + i, R = 4 * q + (lane >> 4), g = (lane & 15) ^ KX(R); koff[i] = (unsigned)(R * LDK * 2 + g * 16); }
#pragma unroll
  for (int i = 0; i < 4; ++i) { const int qq = wid * 4 + i, vh = qq >> 4, q = qq & 15;
    const int kk = (q >> 1) * 8 + ((lane & 31) >> 2), k = (kk & ~0xC) | ((kk & 4) << 1) | ((kk & 8) >> 1), c = vh * 128 + (2 * (q & 1) + (lane >> 5)) * 32 + (lane & 3) * 8;
    voff[i] = (unsigned)(k * LDV * 2 + c * 2); }
  const int vb0 = (int)(uintptr_t)V_lds + v_rd_base(lane) + e * SHM_V;
#define PD_DMA_K(t, s) do { const char* kb_ = (const char*)Kh + (size_t)(t) * (KVBLK * LDK * 2); _Pragma("unroll") for (int i_ = 0; i_ < 2; ++i_) \
    __builtin_amdgcn_global_load_lds((const unsigned*)(kb_ + koff[i_]), (ATT_LAS unsigned*)(ldsl + PD_OFF_K + (s) * SHM_K + (wid * 2 + i_) * 1024), 16, 0, 0); } while (0)
#define PD_DMA_V(t, s) do { const char* vb_ = (const char*)Vh + (size_t)(t) * (KVBLK * LDV * 2); _Pragma("unroll") for (int i_ = 0; i_ < 4; ++i_) \
    __builtin_amdgcn_global_load_lds((const unsigned*)(vb_ + voff[i_]), (ATT_LAS unsigned*)(ldsl + PD_OFF_V + (s) * 2 * SHM_V + (wid * 4 + i_) * 1024), 16, 0, 0); } while (0)
#define PD_BAR() do { __builtin_amdgcn_s_barrier(); asm volatile("" ::: "memory"); } while (0)
  f32x16 p0, p1; float mn, alpha; bf16x8 pa0, pa1, pa2, pa3; const int NT = seq / KVBLK;
  PD_DMA_K(0, 0); PD_DMA_K(1, 1); PD_DMA_K(2, 2); PD_DMA_V(0, 0);
  asm volatile("s_waitcnt vmcnt(0)" ::: "memory"); PD_BAR();
  if (e == 0) qkt_r<0>(p0, p1, K_lds, K_lds, qr, qr, r32, hi);
  asm volatile("s_waitcnt lgkmcnt(0)" ::: "memory"); PD_BAR();
  int ks0 = 0, ks1 = 1, ks2 = 2;
#define PDSLOT(j, PE) do { \
    { const int tv_ = (j) + 1 < NT ? (j) + 1 : NT - 1, tk_ = (j) + 3 < NT ? (j) + 3 : NT - 1; PD_DMA_V(tv_, 1 - (PE)); PD_DMA_K(tk_, ks0); }     \
    if (e == (PE)) { partialSM<Cfg>(p0, p1, m_reg, mn, alpha); finishSM(p0, p1, alpha, l_reg, pa0, pa1, pa2, pa3); \
      *(bf16x8*)(PX) = pa0; *(bf16x8*)(PX + 1024) = pa1; *(bf16x8*)(PX + 2048) = pa2; *(bf16x8*)(PX + 3072) = pa3; \
      if (hi == 0) { AX[2 * r32] = alpha; AX[2 * r32 + 1] = mn; } } \
    else { if ((j) + 1 < NT) qkt_r<0>(p0, p1, K_lds + ks1 * SHM_K, K_lds, qr, qr, r32, hi); } \
    asm volatile("s_waitcnt vmcnt(6) lgkmcnt(0)" ::: "memory"); PD_BAR();                       \
    { const float al = AX[2 * r32], mm = AX[2 * r32 + 1]; \
      if (e != (PE)) { pa0 = *(const bf16x8*)(PX); pa1 = *(const bf16x8*)(PX + 1024); pa2 = *(const bf16x8*)(PX + 2048); pa3 = *(const bf16x8*)(PX + 3072); m_reg = mm; l_reg *= al; } \
      if (__any(al < 1.f)) { _Pragma("unroll") for (int r = 0; r < 16; ++r) { const float ar = AX[2 * crow(r, hi)]; _Pragma("unroll") for (int d = 0; d < ND0; ++d) o[d][r] *= ar; } } } \
    pv_d0p(o, vb0 + (PE) * 2 * SHM_V, pa0, pa1, pa2, pa3); \
    asm volatile("s_waitcnt lgkmcnt(0)" ::: "memory"); PD_BAR(); \
    { const int a_ = ks0; ks0 = ks1; ks1 = ks2; ks2 = a_; } } while (0)
  for (int j = 0; j < NT; j += 2) { PDSLOT(j, 0); PDSLOT(j + 1, 1); }
  asm volatile("s_waitcnt vmcnt(0)" ::: "memory");
  if (hi == 0) LX[e * 32 + r32] = l_reg;
  asm volatile("s_waitcnt lgkmcnt(0)" ::: "memory"); PD_BAR();
  float rli[16];
#pragma unroll
  for (int r = 0; r < 16; ++r) rli[r] = __builtin_amdgcn_rcpf(LX[crow(r, hi)] + LX[32 + crow(r, hi)]);
  typename Cfg::OutT* Ow = Ob + (long)(rg * QBLK) * LDO + e * (VW / 2);
#pragma unroll
  for (int r = 0; r < 16; ++r) { int orow = crow(r, hi);
#pragma unroll
    for (int d0 = 0; d0 < ND0; ++d0) store_o(Ow + (long)orow * LDO + d0 * 32 + r32, o[d0][r] * rli[r]); }
  asm volatile("s_waitcnt lgkmcnt(0)" ::: "memory"); PD_BAR();
#undef PD_DMA_K
#undef PD_DMA_V
#undef PD_BAR
#undef PDSLOT
}

template <class Cfg> struct Pa2Map { static constexpr int NROPE = Cfg::NROPE, NVH = Cfg::VW / 128;
  static constexpr int OFF_K = 0, OFF_KR = 3 * SHM_K, OFF_V = OFF_KR + (NROPE > 0 ? 3 * SHM_KR : 0), OFF_PX = OFF_V + 2 * NVH * SHM_V, OFF_AX = OFF_PX + 2 * 16384, OFF_LX = OFF_AX + 2048, BYTES = OFF_LX + 1024; };
template <class Cfg>
__device__ __forceinline__ void attn_unit_pa2(const bf16_t* __restrict__ Qb, const bf16_t* __restrict__ Kh, const bf16_t* __restrict__ Vh, const bf16_t* __restrict__ Qr, const bf16_t* __restrict__ Kr,
                                              typename Cfg::OutT* __restrict__ Ob, int seq, char* lds, ATT_LAS unsigned char* ldsl, const QNorm qn) {
  constexpr int LDQ = Cfg::LDQ, LDK = Cfg::LDK, LDV = Cfg::LDV, LDO = Cfg::LDO, LDKR = Cfg::LDKR, VW = Cfg::VW, NROPE = Cfg::NROPE, NVH = VW / 128, ND0 = VW / 64, NVP = 2 * NVH;
  typedef Pa2Map<Cfg> M;
  int tid = my_tid(); asm volatile("" : "+v"(tid));
  const int wid = __builtin_amdgcn_readfirstlane(tid >> 6), lane = tid & 63, r32 = lane & 31, hi = lane >> 5, rg = wid & 3, e = wid >> 2;
  char* K_lds = lds + M::OFF_K; char* KR_lds = lds + M::OFF_KR; char* V_lds = lds + M::OFF_V;
  char* PX = lds + M::OFF_PX + rg * 4096 + lane * 16;
  float* AX = (float*)(lds + M::OFF_AX) + rg * 64;
  float* LX = (float*)(lds + M::OFF_LX) + rg * 64;
  float m_reg = SM_NOSHIFT ? __builtin_bit_cast(float, __builtin_amdgcn_readfirstlane(__builtin_bit_cast(int, qn.shift))) : -1e30f, l_reg = 0; f32x16 o[ND0]; bf16x8 qr[8]; bf16x8 qrr[4];
  constexpr float QS = SM_NOSHIFT ? Cfg::SCALE * 1.4426950408889634f : 1.f;
#pragma unroll
  for (int d = 0; d < ND0; ++d) o[d] = f32x16{};
  const bf16_t* Qw = Qb + (long)(rg * QBLK + r32) * LDQ + hi * 8;
#pragma unroll
  for (int d0 = 0; d0 < 8; ++d0) qr[d0] = *reinterpret_cast<const bf16x8*>(Qw + d0 * 16);
#pragma unroll
  for (int d0 = 0; d0 < 4; ++d0) qrr[d0] = bf16x8{};
  if constexpr (NROPE > 0) { const bf16_t* Qrw = Qr + (long)(rg * QBLK + r32) * LDQ + hi * 8;
#pragma unroll
    for (int d0 = 0; d0 < 4; ++d0) qrr[d0] = *reinterpret_cast<const bf16x8*>(Qrw + d0 * 16); }
  if constexpr (Cfg::QNORM) {
    if constexpr (NROPE > 0) { qnorm_nope<false>(qr, qn.g, nullptr, nullptr, hi, QS); qnorm_rope(qrr, qn.g + 128, qn.cs + (rg * QBLK + r32) * 32, qn.sn + (rg * QBLK + r32) * 32, hi, QS); }
    else qnorm_nope<true>(qr, qn.g, qn.cs + (rg * QBLK + r32) * 16, qn.sn + (rg * QBLK + r32) * 16, hi, QS); }
  unsigned koff[2], voff[NVP], kroff = 0;
#pragma unroll
  for (int i = 0; i < 2; ++i) { const int q = wid * 2 + i, R = 4 * q + (lane >> 4), g = (lane & 15) ^ KX(R); koff[i] = (unsigned)(R * LDK * 2 + g * 16); }
#pragma unroll
  for (int i = 0; i < NVP; ++i) { const int qq = wid * NVP + i, vh = qq >> 4, q = qq & 15;
    const int kk = (q >> 1) * 8 + ((lane & 31) >> 2), k = (kk & ~0xC) | ((kk & 4) << 1) | ((kk & 8) >> 1), c = vh * 128 + (2 * (q & 1) + (lane >> 5)) * 32 + (lane & 3) * 8;
    voff[i] = (unsigned)(k * LDV * 2 + c * 2); }
  if constexpr (NROPE > 0) { const int R = 8 * wid + (lane >> 3), g = (lane & 7) ^ KRX(R); kroff = (unsigned)(R * LDKR * 2 + g * 16); }
  const int vb0 = (int)(uintptr_t)V_lds + v_rd_base(lane) + ((e * ND0) >> 2) * SHM_V + ((e * ND0) & 3) * 512;
#define P2_DMA_K(t, s) do { const char* kb_ = (const char*)Kh + (size_t)(t) * (KVBLK * LDK * 2); _Pragma("unroll") for (int i_ = 0; i_ < 2; ++i_) \
    __builtin_amdgcn_global_load_lds((const unsigned*)(kb_ + koff[i_]), (ATT_LAS unsigned*)(ldsl + M::OFF_K + (s) * SHM_K + (wid * 2 + i_) * 1024), 16, 0, 0); \
    if constexpr (NROPE > 0) { const char* rb_ = (const char*)Kr + (size_t)(t) * (KVBLK * LDKR * 2); \
      __builtin_amdgcn_global_load_lds((const unsigned*)(rb_ + kroff), (ATT_LAS unsigned*)(ldsl + M::OFF_KR + (s) * SHM_KR + wid * 1024), 16, 0, 0); } } while (0)
#define P2_DMA_V(t, s) do { const char* vb_ = (const char*)Vh + (size_t)(t) * (KVBLK * LDV * 2); _Pragma("unroll") for (int i_ = 0; i_ < NVP; ++i_) \
    __builtin_amdgcn_global_load_lds((const unsigned*)(vb_ + voff[i_]), (ATT_LAS unsigned*)(ldsl + M::OFF_V + (s) * NVH * SHM_V + (wid * NVP + i_) * 1024), 16, 0, 0); } while (0)
#define P2_BAR() do { __builtin_amdgcn_s_barrier(); asm volatile("" ::: "memory"); } while (0)
#define P2_PV(vs) do { if constexpr (ND0 == 4) pv_d0p(o, vb0 + (vs) * NVH * SHM_V, pa0, pa1, pa2, pa3); else pv_nd<ND0>(o, vb0 + (vs) * NVH * SHM_V, pa0, pa1, pa2, pa3); } while (0)
  f32x16 p0, p1; float mn, alpha; bf16x8 pa0, pa1, pa2, pa3; const int NT = seq / KVBLK;
  if (ATT_STATIC_PRIO && wid >= 4) __builtin_amdgcn_s_setprio(1);
  P2_DMA_K(0, 0); P2_DMA_K(1, 1); P2_DMA_K(2, 2);
  asm volatile("s_waitcnt vmcnt(0)" ::: "memory"); P2_BAR();
  if (e == 0) qkt_r<NROPE>(p0, p1, K_lds, KR_lds, qr, qrr, r32, hi);
  asm volatile("s_waitcnt lgkmcnt(0)" ::: "memory"); P2_BAR();
  int ks0 = 0, ks1 = 1;
#if SM_NOSHIFT
#define P2SEG(t, PE, FIRST) do { \
    { const int tk_ = (t) + 3 < NT ? (t) + 3 : NT - 1; P2_DMA_K(tk_, ks0); P2_DMA_V((t), (PE)); } \
    if (!(FIRST)) { \
      if (e == (PE)) { const char* px_ = PX + (1 - (PE)) * 16384; pa0 = *(const bf16x8*)(px_); pa1 = *(const bf16x8*)(px_ + 1024); pa2 = *(const bf16x8*)(px_ + 2048); pa3 = *(const bf16x8*)(px_ + 3072); } \
      P2_PV(1 - (PE)); } \
    if (e == (PE)) { partialSM_ns<Cfg>(p0, p1, m_reg, mn, alpha); finishSM<true>(p0, p1, alpha, l_reg, pa0, pa1, pa2, pa3); \
      { char* px_ = PX + (PE) * 16384; *(bf16x8*)(px_) = pa0; *(bf16x8*)(px_ + 1024) = pa1; *(bf16x8*)(px_ + 2048) = pa2; *(bf16x8*)(px_ + 3072) = pa3; } } \
    else { if ((t) + 1 < NT) qkt_r<NROPE>(p0, p1, K_lds + ks1 * SHM_K, KR_lds + ks1 * SHM_KR, qr, qrr, r32, hi); } \
    asm volatile("s_waitcnt vmcnt(0) lgkmcnt(0)" ::: "memory"); P2_BAR(); \
    { const int n_ = 3 - ks0 - ks1; ks0 = ks1; ks1 = n_; } } while (0)
#else
#define P2SEG(t, PE, FIRST) do { \
    { const int tk_ = (t) + 3 < NT ? (t) + 3 : NT - 1; P2_DMA_K(tk_, ks0); P2_DMA_V((t), (PE)); } \
    if (!(FIRST)) { const float al = AX[(1 - (PE)) * 256 + 2 * r32], mm = AX[(1 - (PE)) * 256 + 2 * r32 + 1]; \
      if (e == (PE)) { const char* px_ = PX + (1 - (PE)) * 16384; pa0 = *(const bf16x8*)(px_); pa1 = *(const bf16x8*)(px_ + 1024); pa2 = *(const bf16x8*)(px_ + 2048); pa3 = *(const bf16x8*)(px_ + 3072); m_reg = mm; l_reg *= al; } \
      if (__any(al < 1.f)) { _Pragma("unroll") for (int r = 0; r < 16; ++r) { const float ar = AX[(1 - (PE)) * 256 + 2 * crow(r, hi)]; _Pragma("unroll") for (int d = 0; d < ND0; ++d) o[d][r] *= ar; } } \
      P2_PV(1 - (PE)); } \
    if (e == (PE)) { partialSM<Cfg>(p0, p1, m_reg, mn, alpha); finishSM(p0, p1, alpha, l_reg, pa0, pa1, pa2, pa3); \
      { char* px_ = PX + (PE) * 16384; *(bf16x8*)(px_) = pa0; *(bf16x8*)(px_ + 1024) = pa1; *(bf16x8*)(px_ + 2048) = pa2; *(bf16x8*)(px_ + 3072) = pa3; } \
      if (hi == 0) { AX[(PE) * 256 + 2 * r32] = alpha; AX[(PE) * 256 + 2 * r32 + 1] = mn; } } \
    else { if ((t) + 1 < NT) qkt_r<NROPE>(p0, p1, K_lds + ks1 * SHM_K, KR_lds + ks1 * SHM_KR, qr, qrr, r32, hi); } \
    asm volatile("s_waitcnt vmcnt(0) lgkmcnt(0)" ::: "memory"); P2_BAR(); \
    { const int n_ = 3 - ks0 - ks1; ks0 = ks1; ks1 = n_; } } while (0)
#endif
  P2SEG(0, 0, true); P2SEG(1, 1, false);
  for (int t = 2; t < NT; t += 2) { P2SEG(t, 0, false); P2SEG(t + 1, 1, false); }
#if SM_NOSHIFT
  { if (e == 0) { const char* px_ = PX + 16384; pa0 = *(const bf16x8*)(px_); pa1 = *(const bf16x8*)(px_ + 1024); pa2 = *(const bf16x8*)(px_ + 2048); pa3 = *(const bf16x8*)(px_ + 3072); }
    P2_PV(1); }
  l_reg = hsum32(l_reg);
#else
  { const float al = AX[256 + 2 * r32], mm = AX[256 + 2 * r32 + 1];
    if (e == 0) { const char* px_ = PX + 16384; pa0 = *(const bf16x8*)(px_); pa1 = *(const bf16x8*)(px_ + 1024); pa2 = *(const bf16x8*)(px_ + 2048); pa3 = *(const bf16x8*)(px_ + 3072); m_reg = mm; l_reg *= al; }
    if (__any(al < 1.f)) {
#pragma unroll
      for (int r = 0; r < 16; ++r) { const float ar = AX[256 + 2 * crow(r, hi)];
#pragma unroll
        for (int d = 0; d < ND0; ++d) o[d][r] *= ar; } }
    P2_PV(1); }
#endif
  if (hi == 0) LX[e * 32 + r32] = l_reg;
  asm volatile("s_waitcnt lgkmcnt(0)" ::: "memory"); P2_BAR();
  float rli[16];
#pragma unroll
  for (int r = 0; r < 16; ++r) rli[r] = __builtin_amdgcn_rcpf(LX[crow(r, hi)] + LX[32 + crow(r, hi)]);
  typename Cfg::OutT* Ow = Ob + (long)(rg * QBLK) * LDO + e * (VW / 2);
#pragma unroll
  for (int r = 0; r < 16; ++r) { int orow = crow(r, hi);
#pragma unroll
    for (int d0 = 0; d0 < ND0; ++d0) store_o(Ow + (long)orow * LDO + d0 * 32 + r32, o[d0][r] * rli[r]); }
  if (ATT_STATIC_PRIO) __builtin_amdgcn_s_setprio(0);
  asm volatile("s_waitcnt lgkmcnt(0)" ::: "memory"); P2_BAR();
#undef P2_DMA_K
#undef P2_DMA_V
#undef P2_BAR
#undef P2_PV
#undef P2SEG
}

using f32x4 = __attribute__((ext_vector_type(4))) float;
template <int OFF> __device__ __forceinline__ bf16x8 k3_read(int a) { bf16x8 r; asm volatile("ds_read_b128 %0, %1 offset:%2" : "=&v"(r) : "v"(a), "i"(OFF) : "memory"); return r; }
template <int N> __device__ __forceinline__ void lgkm3_wait() { asm volatile("s_waitcnt lgkmcnt(%0)" :: "n"(N) : "memory"); }
template <int I> __device__ __forceinline__ void qk3_step(f32x4 (&sT)[2][4], bf16x8 (&f)[16], const int (&ka)[4], const bf16x8 (&qf)[2][4]) {
  if constexpr (I < 16) f[I] = k3_read<(I >> 2) * 4096>(ka[I & 3]);
  if constexpr (I >= 2) { constexpr int D = I - 2, W = (D + 2 < 16 ? 2 : 15 - D);
    lgkm3_wait<W>(); SBAR();
    sT[0][D >> 2] = __builtin_amdgcn_mfma_f32_16x16x32_bf16(f[D], qf[0][D & 3], sT[0][D >> 2], 0, 0, 0);
    sT[1][D >> 2] = __builtin_amdgcn_mfma_f32_16x16x32_bf16(f[D], qf[1][D & 3], sT[1][D >> 2], 0, 0, 0); SBAR(); }
  if constexpr (I + 1 < 18) qk3_step<I + 1>(sT, f, ka, qf);
}
template <int I> __device__ __forceinline__ void pv3_step(f32x4 (&o)[2][8], s16x4 (&vl)[16], s16x4 (&vh)[16], int vbe, int vbo, const bf16x8 (&pf)[4]) {
  if constexpr (I < 16) { constexpr int db = I >> 1, t = I & 1, OFF = t * 8192 + (db >> 1) * 512;
    vl[I] = tr_read<OFF>((db & 1) ? vbo : vbe); vh[I] = tr_read<OFF + 4096>((db & 1) ? vbo : vbe); }
  if constexpr (I >= 2) { constexpr int D = I - 2, db = D >> 1, t = D & 1, W = 2 * (D + 2 < 16 ? 2 : 15 - D);
    lgkm3_wait<W>(); SBAR();
    const bf16x8 vf = (bf16x8){vl[D][0], vl[D][1], vl[D][2], vl[D][3], vh[D][0], vh[D][1], vh[D][2], vh[D][3]};
    o[0][db] = __builtin_amdgcn_mfma_f32_16x16x32_bf16(vf, pf[t], o[0][db], 0, 0, 0);
    o[1][db] = __builtin_amdgcn_mfma_f32_16x16x32_bf16(vf, pf[2 + t], o[1][db], 0, 0, 0); SBAR(); }
  if constexpr (I + 1 < 18) pv3_step<I + 1>(o, vl, vh, vbe, vbo, pf);
}
template <class Cfg>
__device__ __forceinline__ void attn_unit_pa3(const bf16_t* __restrict__ Qb, const bf16_t* __restrict__ Kh, const bf16_t* __restrict__ Vh, typename Cfg::OutT* __restrict__ Ob, int seq, char* lds, ATT_LAS unsigned char* ldsl, const QNorm qn) {
  constexpr int LDQ = Cfg::LDQ, LDK = Cfg::LDK, LDV = Cfg::LDV, LDO = Cfg::LDO, VW = Cfg::VW, NVH = 2, NVP = 4;
  static_assert(VW == 256 && Cfg::NROPE == 0 && Cfg::QNORM, "attn_unit_pa3: 256 value columns, no rope, q normalised here");
  typedef Pa2Map<Cfg> M;
  int tid = my_tid(); asm volatile("" : "+v"(tid));
  const int wid = __builtin_amdgcn_readfirstlane(tid >> 6), lane = tid & 63, fr = lane & 15, fq = lane >> 4, rg = wid & 3, e = wid >> 2;
  char* K_lds = lds + M::OFF_K; char* V_lds = lds + M::OFF_V;
  char* PX = lds + M::OFF_PX + rg * 4096 + lane * 16;
  float* LX = (float*)(lds + M::OFF_LX) + rg * 64;
  const float shift = __builtin_bit_cast(float, __builtin_amdgcn_readfirstlane(__builtin_bit_cast(int, qn.shift)));
  constexpr float QS = Cfg::SCALE * 1.4426950408889634f;
  f32x4 o[2][8]; float lsum[2] = {0.f, 0.f}; bf16x8 qf[2][4];
#pragma unroll
  for (int qb = 0; qb < 2; ++qb)
#pragma unroll
    for (int db = 0; db < 8; ++db) o[qb][db] = (f32x4){0.f, 0.f, 0.f, 0.f};
  { const bf16_t* Qw = Qb + (long)(rg * 32 + fr) * LDQ + fq * 8;
#pragma unroll
    for (int qb = 0; qb < 2; ++qb)
#pragma unroll
      for (int s = 0; s < 4; ++s) qf[qb][s] = *reinterpret_cast<const bf16x8*>(Qw + (long)qb * 16 * LDQ + s * 32);
#pragma unroll
    for (int qb = 0; qb < 2; ++qb) { float ss = 0.f;
#pragma unroll
      for (int s = 0; s < 4; ++s) { float x[8]; up8(qf[qb][s], x);
#pragma unroll
        for (int t = 0; t < 8; ++t) ss += x[t] * x[t]; }
      ss += pg8::xshfl<16>(ss); ss = pg8::xadd32(ss);
      const float rstd = __builtin_amdgcn_rsqf(ss * (1.f / 128.f) + 1e-6f) * QS;
      { float x[8]; up8(qf[qb][0], x); const float* cp = qn.cs + (rg * 32 + qb * 16 + fr) * 16 + 8 * (fq & 1); const float* sp = qn.sn + (rg * 32 + qb * 16 + fr) * 16 + 8 * (fq & 1);
#pragma unroll
        for (int t = 0; t < 8; ++t) { const float v = x[t] * rstd * qn.g[8 * fq + t], pr = pg8::xswap32(v, lane), c = cp[t], sn_ = sp[t]; x[t] = (fq < 2) ? v * c - pr * sn_ : v * c + pr * sn_; }
        qf[qb][0] = pk8(x); }
#pragma unroll
      for (int s = 1; s < 4; ++s) { float x[8]; up8(qf[qb][s], x);
#pragma unroll
        for (int t = 0; t < 8; ++t) x[t] = x[t] * rstd * qn.g[32 * s + 8 * fq + t];
        qf[qb][s] = pk8(x); } } }
  unsigned koff[2], voff[NVP];
#pragma unroll
  for (int i = 0; i < 2; ++i) { const int q = wid * 2 + i, R = 4 * q + (lane >> 4), g = (lane & 15) ^ (R & 15); koff[i] = (unsigned)(R * LDK * 2 + g * 16); }
#pragma unroll
  for (int i = 0; i < NVP; ++i) { const int qq = wid * NVP + i, vh = qq >> 4, q = qq & 15;
    const int kk = (q >> 1) * 8 + ((lane & 31) >> 2), k = (kk & ~0xC) | ((kk & 4) << 1) | ((kk & 8) >> 1), c = vh * 128 + (2 * (q & 1) + (lane >> 5)) * 32 + ((lane & 3) ^ (2 * ((q >> 1) & 1))) * 8;
    voff[i] = (unsigned)(k * LDV * 2 + c * 2); }
  int kal[4];
#pragma unroll
  for (int s = 0; s < 4; ++s) kal[s] = (int)(uintptr_t)K_lds + fr * 256 + ((((s ^ (fr >> 2)) << 2) | ((fq ^ fr) & 3)) << 4);
  const int vcom = (int)(uintptr_t)V_lds + e * SHM_V + (fq & 1) * 2048 + (fq >> 1) * 256 + (fr >> 2) * 64 + (fr & 3) * 8;
  const int vbe0 = vcom + (fq & 1) * 32, vbo0 = vcom + (1 - (fq & 1)) * 32;
#define P3_DMA_K(t, s) do { const char* kb_ = (const char*)Kh + (size_t)(t) * (KVBLK * LDK * 2); _Pragma("unroll") for (int i_ = 0; i_ < 2; ++i_) \
    __builtin_amdgcn_global_load_lds((const unsigned*)(kb_ + koff[i_]), (ATT_LAS unsigned*)(ldsl + M::OFF_K + (s) * SHM_K + (wid * 2 + i_) * 1024), 16, 0, 0); } while (0)
#define P3_DMA_V(t, s) do { const char* vb_ = (const char*)Vh + (size_t)(t) * (KVBLK * LDV * 2); _Pragma("unroll") for (int i_ = 0; i_ < NVP; ++i_) \
    __builtin_amdgcn_global_load_lds((const unsigned*)(vb_ + voff[i_]), (ATT_LAS unsigned*)(ldsl + M::OFF_V + (s) * NVH * SHM_V + (wid * NVP + i_) * 1024), 16, 0, 0); } while (0)
#define P3_BAR() do { __builtin_amdgcn_s_barrier(); asm volatile("" ::: "memory"); } while (0)
#define P3_QK(slot) do { int ka_[4]; _Pragma("unroll") for (int s_ = 0; s_ < 4; ++s_) ka_[s_] = kal[s_] + (slot) * SHM_K; bf16x8 f_[16]; \
    _Pragma("unroll") for (int a_ = 0; a_ < 2; ++a_) _Pragma("unroll") for (int b_ = 0; b_ < 4; ++b_) sT[a_][b_] = (f32x4){0.f, 0.f, 0.f, 0.f}; \
    SBAR(); qk3_step<0>(sT, f_, ka_, qf); } while (0)
#define P3_PV(vs) do { s16x4 vl_[16], vh_[16]; SBAR(); pv3_step<0>(o, vl_, vh_, vbe0 + (vs) * NVH * SHM_V, vbo0 + (vs) * NVH * SHM_V, pf); } while (0)
#define P3_LDP(par) do { const char* px_ = PX + (par) * 16384; _Pragma("unroll") for (int i_ = 0; i_ < 4; ++i_) pf[i_] = *(const bf16x8*)(px_ + i_ * 1024); } while (0)
  f32x4 sT[2][4]; bf16x8 pf[4]; const int NT = seq / KVBLK;
  P3_DMA_K(0, 0); P3_DMA_K(1, 1); P3_DMA_K(2, 2);
  asm volatile("s_waitcnt vmcnt(0)" ::: "memory"); P3_BAR();
  if (e == 0) P3_QK(0);
  asm volatile("s_waitcnt lgkmcnt(0)" ::: "memory"); P3_BAR();
  int ks0 = 0, ks1 = 1;
#define P3SEG(t, PE, FIRST) do { \
    { const int tk_ = (t) + 3 < NT ? (t) + 3 : NT - 1; P3_DMA_K(tk_, ks0); P3_DMA_V((t), (PE)); } \
    if (!(FIRST)) { if (e == (PE)) P3_LDP(1 - (PE)); P3_PV(1 - (PE)); } \
    if (e == (PE)) { \
      if (__builtin_expect(shift != 0.f, 0)) { _Pragma("unroll") for (int a_ = 0; a_ < 2; ++a_) _Pragma("unroll") for (int b_ = 0; b_ < 4; ++b_) sT[a_][b_] = sT[a_][b_] - shift; } \
      _Pragma("unroll") for (int a_ = 0; a_ < 2; ++a_) { float ps_ = 0.f; \
        _Pragma("unroll") for (int b_ = 0; b_ < 4; ++b_) _Pragma("unroll") for (int r_ = 0; r_ < 4; ++r_) { sT[a_][b_][r_] = __builtin_amdgcn_exp2f(sT[a_][b_][r_]); ps_ += sT[a_][b_][r_]; } \
        lsum[a_] += ps_; \
        _Pragma("unroll") for (int t_ = 0; t_ < 2; ++t_) { u32x4 w_ = {cvtpk(sT[a_][2 * t_][0], sT[a_][2 * t_][1]), cvtpk(sT[a_][2 * t_][2], sT[a_][2 * t_][3]), cvtpk(sT[a_][2 * t_ + 1][0], sT[a_][2 * t_ + 1][1]), cvtpk(sT[a_][2 * t_ + 1][2], sT[a_][2 * t_ + 1][3])}; \
          pf[2 * a_ + t_] = *reinterpret_cast<bf16x8*>(&w_); } } \
      { char* px_ = PX + (PE) * 16384; _Pragma("unroll") for (int i_ = 0; i_ < 4; ++i_) *(bf16x8*)(px_ + i_ * 1024) = pf[i_]; } } \
    else { if ((t) + 1 < NT) P3_QK(ks1); } \
    asm volatile("s_waitcnt vmcnt(0) lgkmcnt(0)" ::: "memory"); P3_BAR(); \
    { const int n_ = 3 - ks0 - ks1; ks0 = ks1; ks1 = n_; } } while (0)
  P3SEG(0, 0, true); P3SEG(1, 1, false);
  for (int t = 2; t < NT; t += 2) { P3SEG(t, 0, false); P3SEG(t + 1, 1, false); }
  { if (e == 0) P3_LDP(1); P3_PV(1); }
#pragma unroll
  for (int qb = 0; qb < 2; ++qb) { float lw = lsum[qb]; lw += pg8::xshfl<16>(lw); lw = pg8::xadd32(lw); if (fq == 0) LX[e * 32 + qb * 16 + fr] = lw; }
  asm volatile("s_waitcnt lgkmcnt(0)" ::: "memory"); P3_BAR();
  int fre = fr, fqe = fq; asm volatile("" : "+v"(fre), "+v"(fqe));
  typename Cfg::OutT* Ow = Ob + (long)(rg * 32 + fre) * LDO + e * 128 + 4 * fqe;
#pragma unroll
  for (int qb = 0; qb < 2; ++qb) { const float rl = __builtin_amdgcn_rcpf(LX[qb * 16 + fre] + LX[32 + qb * 16 + fre]);
#pragma unroll
    for (int db = 0; db < 8; ++db) { typedef unsigned u32x2_ __attribute__((ext_vector_type(2)));
      u32x2_ w; w.x = cvtpk(o[qb][db][0] * rl, o[qb][db][1] * rl); w.y = cvtpk(o[qb][db][2] * rl, o[qb][db][3] * rl);
      *(u32x2_*)(Ow + (long)qb * 16 * LDO + db * 16) = w; } }
  asm volatile("s_waitcnt lgkmcnt(0)" ::: "memory"); P3_BAR();
#undef P3_DMA_K
#undef P3_DMA_V
#undef P3_BAR
#undef P3_QK
#undef P3_PV
#undef P3_LDP
#undef P3SEG
}

template <int I> __device__ __forceinline__ void qk3r_step(f32x4 (&sT)[2][4], bf16x8 (&f)[24], const int (&ka)[4], const int (&kra)[2], const bf16x8 (&qf)[2][6]) {
  if constexpr (I < 16) f[I] = k3_read<(I >> 2) * 4096>(ka[I & 3]);
  else if constexpr (I < 24) f[I] = k3_read<((I - 16) >> 1) * 2048>(kra[(I - 16) & 1]);
  if constexpr (I >= 2) { constexpr int D = I - 2, W = (D + 2 < 24 ? 2 : 23 - D), kb = D < 16 ? (D >> 2) : ((D - 16) >> 1), sq = D < 16 ? (D & 3) : 4 + ((D - 16) & 1);
    lgkm3_wait<W>(); SBAR();
    sT[0][kb] = __builtin_amdgcn_mfma_f32_16x16x32_bf16(f[D], qf[0][sq], sT[0][kb], 0, 0, 0);
    sT[1][kb] = __builtin_amdgcn_mfma_f32_16x16x32_bf16(f[D], qf[1][sq], sT[1][kb], 0, 0, 0); SBAR(); }
  if constexpr (I + 1 < 26) qk3r_step<I + 1>(sT, f, ka, kra, qf);
}
template <class Cfg>
__device__ __forceinline__ void attn_unit_dma3(const bf16_t* __restrict__ Qb, const bf16_t* __restrict__ Kh, const bf16_t* __restrict__ Vh, const bf16_t* __restrict__ Qr, const bf16_t* __restrict__ Kr,
                                               typename Cfg::OutT* __restrict__ Ob, int seq, char* lds, ATT_LAS unsigned char* ldsl, const QNorm qn, unsigned char* __restrict__ Ob8 = nullptr) {
  constexpr int LDQ = Cfg::LDQ, LDK = Cfg::LDK, LDV = Cfg::LDV, LDO = Cfg::LDO, LDKR = Cfg::LDKR;
  static_assert(Cfg::NROPE == 64 && Cfg::VW == 128 && Cfg::QNORM, "attn_unit_dma3: 128 + 64 q.k dims, 128 value columns, q normalised here");
  int tid = my_tid(); asm volatile("" : "+v"(tid));
  const int wid = __builtin_amdgcn_readfirstlane(tid >> 6), lane = tid & 63, fr = lane & 15, fq = lane >> 4;
  char* K_lds = lds + D_OFF_K; char* V_lds = lds + D_OFF_V; char* KR_lds = lds + D_OFF_KR;
  const float shift = __builtin_bit_cast(float, __builtin_amdgcn_readfirstlane(__builtin_bit_cast(int, qn.shift)));
  constexpr float QS = Cfg::SCALE * 1.4426950408889634f;
  f32x4 o[2][8]; float lsum[2] = {0.f, 0.f}; bf16x8 qf[2][6];
#pragma unroll
  for (int qb = 0; qb < 2; ++qb)
#pragma unroll
    for (int db = 0; db < 8; ++db) o[qb][db] = (f32x4){0.f, 0.f, 0.f, 0.f};
  { const bf16_t* Qw = Qb + (long)(wid * 32 + fr) * LDQ + fq * 8; const bf16_t* Qrw = Qr + (long)(wid * 32 + fr) * LDQ + fq * 8;
#pragma unroll
    for (int qb = 0; qb < 2; ++qb) {
#pragma unroll
      for (int s = 0; s < 4; ++s) qf[qb][s] = *reinterpret_cast<const bf16x8*>(Qw + (long)qb * 16 * LDQ + s * 32);
#pragma unroll
      for (int s = 0; s < 2; ++s) qf[qb][4 + s] = *reinterpret_cast<const bf16x8*>(Qrw + (long)qb * 16 * LDQ + s * 32); }
#pragma unroll
    for (int qb = 0; qb < 2; ++qb) { float ss = 0.f, sr = 0.f;
#pragma unroll
      for (int s = 0; s < 4; ++s) { float x[8]; up8(qf[qb][s], x);
#pragma unroll
        for (int t = 0; t < 8; ++t) ss += x[t] * x[t]; }
#pragma unroll
      for (int s = 4; s < 6; ++s) { float x[8]; up8(qf[qb][s], x);
#pragma unroll
        for (int t = 0; t < 8; ++t) sr += x[t] * x[t]; }
      ss += pg8::xshfl<16>(ss); ss = pg8::xadd32(ss); sr += pg8::xshfl<16>(sr); sr = pg8::xadd32(sr);
      const float rn = __builtin_amdgcn_rsqf(ss * (1.f / 128.f) + 1e-6f) * QS, rr = __builtin_amdgcn_rsqf(sr * (1.f / 64.f) + 1e-6f) * QS;
#pragma unroll
      for (int s = 0; s < 4; ++s) { float x[8]; up8(qf[qb][s], x);
#pragma unroll
        for (int t = 0; t < 8; ++t) x[t] = x[t] * rn * qn.g[32 * s + 8 * fq + t];
        qf[qb][s] = pk8(x); }
      { float u[8], w[8]; up8(qf[qb][4], u); up8(qf[qb][5], w); const float* cp = qn.cs + (wid * 32 + qb * 16 + fr) * 32 + 8 * fq; const float* sp = qn.sn + (wid * 32 + qb * 16 + fr) * 32 + 8 * fq;
#pragma unroll
        for (int t = 0; t < 8; ++t) { const float a = u[t] * rr * qn.g[128 + 8 * fq + t], b = w[t] * rr * qn.g[160 + 8 * fq + t], c = cp[t], sn_ = sp[t]; u[t] = a * c - b * sn_; w[t] = b * c + a * sn_; }
        qf[qb][4] = pk8(u); qf[qb][5] = pk8(w); } } }
  unsigned koff[2], voff[2], kroff;
#pragma unroll
  for (int i = 0; i < 2; ++i) { const int q = wid * 2 + i;
    { const int R = 4 * q + (lane >> 4), g = (lane & 15) ^ (R & 15); koff[i] = (unsigned)(R * LDK * 2 + g * 16); }
    { const int kk = (q >> 1) * 8 + ((lane & 31) >> 2), k = (kk & ~0xC) | ((kk & 4) << 1) | ((kk & 8) >> 1), c = (2 * (q & 1) + (lane >> 5)) * 32 + ((lane & 3) ^ (2 * ((q >> 1) & 1))) * 8;
      voff[i] = (unsigned)(k * LDV * 2 + c * 2); } }
  { const int R = 8 * wid + (lane >> 3), g = (lane & 7) ^ KRX(R); kroff = (unsigned)(R * LDKR * 2 + g * 16); }
  int kal[4], kral[2];
#pragma unroll
  for (int s = 0; s < 4; ++s) kal[s] = (int)(uintptr_t)K_lds + fr * 256 + ((((s ^ (fr >> 2)) << 2) | ((fq ^ fr) & 3)) << 4);
#pragma unroll
  for (int s = 0; s < 2; ++s) kral[s] = (int)(uintptr_t)KR_lds + fr * 128 + ((((4 * s + fq) ^ (fr >> 1)) & 7) << 4);
  const int vcom = (int)(uintptr_t)V_lds + (fq & 1) * 2048 + (fq >> 1) * 256 + (fr >> 2) * 64 + (fr & 3) * 8;
  const int vbe0 = vcom + (fq & 1) * 32, vbo0 = vcom + (1 - (fq & 1)) * 32;
#define D3_TILE(t, s) do { const char* kb_ = (const char*)Kh + (size_t)(t) * (KVBLK * LDK * 2); const char* vb_ = (const char*)Vh + (size_t)(t) * (KVBLK * LDV * 2); \
    _Pragma("unroll") for (int i_ = 0; i_ < 2; ++i_) { \
      __builtin_amdgcn_global_load_lds((const unsigned*)(kb_ + koff[i_]), (ATT_LAS unsigned*)(ldsl + D_OFF_K + (s) * SHM_K + (wid * 2 + i_) * 1024), 16, 0, 0); \
      __builtin_amdgcn_global_load_lds((const unsigned*)(vb_ + voff[i_]), (ATT_LAS unsigned*)(ldsl + D_OFF_V + (s) * SHM_V + (wid * 2 + i_) * 1024), 16, 0, 0); } \
    { const char* rb_ = (const char*)Kr + (size_t)(t) * (KVBLK * LDKR * 2); \
      __builtin_amdgcn_global_load_lds((const unsigned*)(rb_ + kroff), (ATT_LAS unsigned*)(ldsl + D_OFF_KR + (s) * SHM_KR + wid * 1024), 16, 0, 0); } } while (0)
  f32x4 sT[2][4]; bf16x8 pf[4]; const int NT = seq / KVBLK;
#define D3_K(t, s) do { const char* kb_ = (const char*)Kh + (size_t)(t) * (KVBLK * LDK * 2); const char* rb_ = (const char*)Kr + (size_t)(t) * (KVBLK * LDKR * 2); \
    _Pragma("unroll") for (int i_ = 0; i_ < 2; ++i_) __builtin_amdgcn_global_load_lds((const unsigned*)(kb_ + koff[i_]), (ATT_LAS unsigned*)(ldsl + D_OFF_K + (s) * SHM_K + (wid * 2 + i_) * 1024), 16, 0, 0); \
    __builtin_amdgcn_global_load_lds((const unsigned*)(rb_ + kroff), (ATT_LAS unsigned*)(ldsl + D_OFF_KR + (s) * SHM_KR + wid * 1024), 16, 0, 0); } while (0)
#define D3_V(t, s) do { const char* vb_ = (const char*)Vh + (size_t)(t) * (KVBLK * LDV * 2); \
    _Pragma("unroll") for (int i_ = 0; i_ < 2; ++i_) __builtin_amdgcn_global_load_lds((const unsigned*)(vb_ + voff[i_]), (ATT_LAS unsigned*)(ldsl + D_OFF_V + (s) * SHM_V + (wid * 2 + i_) * 1024), 16, 0, 0); } while (0)
#define D3_QK(slot) do { int ka_[4], kra_[2]; bf16x8 f_[24]; \
      _Pragma("unroll") for (int s_ = 0; s_ < 4; ++s_) ka_[s_] = kal[s_] + (slot) * SHM_K; \
      _Pragma("unroll") for (int s_ = 0; s_ < 2; ++s_) kra_[s_] = kral[s_] + (slot) * SHM_KR; \
      _Pragma("unroll") for (int a_ = 0; a_ < 2; ++a_) _Pragma("unroll") for (int b_ = 0; b_ < 4; ++b_) sT[a_][b_] = (f32x4){0.f, 0.f, 0.f, 0.f}; \
      SBAR(); qk3r_step<0>(sT, f_, ka_, kra_, qf); } while (0)
#define D3_SM() do { \
    if (__builtin_expect(shift != 0.f, 0)) { _Pragma("unroll") for (int a_ = 0; a_ < 2; ++a_) _Pragma("unroll") for (int b_ = 0; b_ < 4; ++b_) sT[a_][b_] = sT[a_][b_] - shift; } \
    _Pragma("unroll") for (int a_ = 0; a_ < 2; ++a_) { float ps_ = 0.f; \
      _Pragma("unroll") for (int b_ = 0; b_ < 4; ++b_) _Pragma("unroll") for (int r_ = 0; r_ < 4; ++r_) { sT[a_][b_][r_] = __builtin_amdgcn_exp2f(sT[a_][b_][r_]); ps_ += sT[a_][b_][r_]; } \
      lsum[a_] += ps_; \
      _Pragma("unroll") for (int t_ = 0; t_ < 2; ++t_) { u32x4 w_ = {cvtpk(sT[a_][2 * t_][0], sT[a_][2 * t_][1]), cvtpk(sT[a_][2 * t_][2], sT[a_][2 * t_][3]), cvtpk(sT[a_][2 * t_ + 1][0], sT[a_][2 * t_ + 1][1]), cvtpk(sT[a_][2 * t_ + 1][2], sT[a_][2 * t_ + 1][3])}; \
        pf[2 * a_ + t_] = *reinterpret_cast<bf16x8*>(&w_); } } } while (0)
#define D3_PV(slot) do { s16x4 vl_[16], vh_[16]; SBAR(); pv3_step<0>(o, vl_, vh_, vbe0 + (slot) * SHM_V, vbo0 + (slot) * SHM_V, pf); } while (0)
#if MLA_STAGGER
  const bool lead = wid < 4;
  D3_V(0, 0); D3_K(0, 0); D3_V(1, 1); D3_K(1, 1); D3_K(2, 2);
  asm volatile("s_waitcnt vmcnt(8)" ::: "memory"); __builtin_amdgcn_s_barrier(); asm volatile("" ::: "memory");
  int s0 = 0, s1 = 1, s2 = 2;
#define D3_BARBLK(t) do { if ((t) + 1 < NT) { \
      if ((t) + 2 < NT) asm volatile("s_waitcnt vmcnt(3) lgkmcnt(0)" ::: "memory"); else asm volatile("s_waitcnt vmcnt(0) lgkmcnt(0)" ::: "memory"); \
      __builtin_amdgcn_s_barrier(); asm volatile("" ::: "memory"); \
      if ((t) + 2 < NT) D3_V((t) + 2, s2); \
      if ((t) + 3 < NT) D3_K((t) + 3, s0); \
      { const int a_ = s0; s0 = s1; s1 = s2; s2 = a_; } } } while (0)
  for (int t = 0; t < NT; ++t) { const int sv = s0;
    D3_QK(s0); D3_SM();
    if (!lead) D3_BARBLK(t);
    D3_PV(sv);
    if (lead) D3_BARBLK(t);
  }
#undef D3_BARBLK
#else
  D3_TILE(0, 0); D3_TILE(1, 1); D3_TILE(2, 2);
  asm volatile("s_waitcnt vmcnt(10)" ::: "memory"); __builtin_amdgcn_s_barrier(); asm volatile("" ::: "memory");
  int s0 = 0, s1 = 1, s2 = 2;
  for (int t = 0; t < NT; ++t) {
    D3_QK(s0); D3_SM(); D3_PV(s0);
    if (t + 1 < NT) {
      if (t + 2 < NT) asm volatile("s_waitcnt vmcnt(5) lgkmcnt(0)" ::: "memory"); else asm volatile("s_waitcnt vmcnt(0) lgkmcnt(0)" ::: "memory");
      __builtin_amdgcn_s_barrier(); asm volatile("" ::: "memory");
      if (t + 3 < NT) D3_TILE(t + 3, s0);
      { const int a_ = s0; s0 = s1; s1 = s2; s2 = a_; } }
  }
#endif
#undef D3_K
#undef D3_V
#undef D3_QK
#undef D3_SM
#undef D3_PV
  int fre = fr, fqe = fq; asm volatile("" : "+v"(fre), "+v"(fqe));
  typename Cfg::OutT* Ow = Ob + (long)(wid * 32 + fre) * LDO + 4 * fqe;
  unsigned char* Ow8 = Ob8 + (long)(wid * 32 + fre) * LDO + 4 * fqe;
#pragma unroll
  for (int qb = 0; qb < 2; ++qb) { float lw = lsum[qb]; lw += pg8::xshfl<16>(lw); lw = pg8::xadd32(lw); const float rl = __builtin_amdgcn_rcpf(lw);
    if (Ob8) { const float r8 = rl * 16.f;
#pragma unroll
      for (int db = 0; db < 8; ++db) { int e = 0; e = __builtin_amdgcn_cvt_pk_fp8_f32(o[qb][db][0] * r8, o[qb][db][1] * r8, e, false); e = __builtin_amdgcn_cvt_pk_fp8_f32(o[qb][db][2] * r8, o[qb][db][3] * r8, e, true);
        *(unsigned*)(Ow8 + (long)qb * 16 * LDO + db * 16) = (unsigned)e; } }
    else {
#pragma unroll
    for (int db = 0; db < 8; ++db) { typedef unsigned u32x2_ __attribute__((ext_vector_type(2)));
      u32x2_ w; w.x = cvtpk(o[qb][db][0] * rl, o[qb][db][1] * rl); w.y = cvtpk(o[qb][db][2] * rl, o[qb][db][3] * rl);
      *(u32x2_*)(Ow + (long)qb * 16 * LDO + db * 16) = w; } } }
  asm volatile("s_waitcnt lgkmcnt(0)" ::: "memory"); __builtin_amdgcn_s_barrier(); asm volatile("" ::: "memory");
#undef D3_TILE
}

template <int I, int NDB> __device__ __forceinline__ void pv3w_step(f32x4 (&o)[2][NDB], s16x4 (&vl)[2 * NDB], s16x4 (&vh)[2 * NDB], int vbe, int vbo, const bf16x8 (&pf)[4]) {
  constexpr int NST = 2 * NDB;
  if constexpr (I < NST) { constexpr int db = I >> 1, t = I & 1, OFF = (db >> 3) * 16384 + t * 8192 + ((db & 7) >> 1) * 512;
    vl[I] = tr_read<OFF>((db & 1) ? vbo : vbe); vh[I] = tr_read<OFF + 4096>((db & 1) ? vbo : vbe); }
  if constexpr (I >= PV_LA) { constexpr int D = I - PV_LA, db = D >> 1, t = D & 1, W = 2 * (D + PV_LA < NST ? PV_LA : NST - 1 - D);
    lgkm3_wait<W>(); SBAR();
    const bf16x8 vf = (bf16x8){vl[D][0], vl[D][1], vl[D][2], vl[D][3], vh[D][0], vh[D][1], vh[D][2], vh[D][3]};
    o[0][db] = __builtin_amdgcn_mfma_f32_16x16x32_bf16(vf, pf[t], o[0][db], 0, 0, 0);
    o[1][db] = __builtin_amdgcn_mfma_f32_16x16x32_bf16(vf, pf[2 + t], o[1][db], 0, 0, 0); SBAR(); }
  if constexpr (I + 1 < NST + PV_LA) pv3w_step<I + 1, NDB>(o, vl, vh, vbe, vbo, pf);
}
template <class Cfg>
__device__ __forceinline__ void attn_unit_dma3d(const bf16_t* __restrict__ Qb, const bf16_t* __restrict__ Kh, const bf16_t* __restrict__ Vh, typename Cfg::OutT* __restrict__ Ob, int seq, char* lds, ATT_LAS unsigned char* ldsl, const QNorm qn) {
  constexpr int LDQ = Cfg::LDQ, LDK = Cfg::LDK, LDV = Cfg::LDV, LDO = Cfg::LDO;
  constexpr int W_OFF_K = 0, W_OFF_V = 3 * SHM_K;
  static_assert(Cfg::NROPE == 0 && Cfg::VW == 256 && Cfg::QNORM, "attn_unit_dma3d: 128 q.k dims, 256 value columns, q normalised here");
  int tid = my_tid(); asm volatile("" : "+v"(tid));
  const int wid = __builtin_amdgcn_readfirstlane(tid >> 6), lane = tid & 63, fr = lane & 15, fq = lane >> 4;
  char* K_lds = lds + W_OFF_K; char* V_lds = lds + W_OFF_V;
  const float shift = __builtin_bit_cast(float, __builtin_amdgcn_readfirstlane(__builtin_bit_cast(int, qn.shift)));
  constexpr float QS = Cfg::SCALE * 1.4426950408889634f;
  f32x4 o[2][16]; float lsum[2] = {0.f, 0.f}; bf16x8 qf[2][4];
#pragma unroll
  for (int qb = 0; qb < 2; ++qb)
#pragma unroll
    for (int db = 0; db < 16; ++db) o[qb][db] = (f32x4){0.f, 0.f, 0.f, 0.f};
  { const bf16_t* Qw = Qb + (long)(wid * 32 + fr) * LDQ + fq * 8;
#pragma unroll
    for (int qb = 0; qb < 2; ++qb)
#pragma unroll
      for (int s = 0; s < 4; ++s) qf[qb][s] = *reinterpret_cast<const bf16x8*>(Qw + (long)qb * 16 * LDQ + s * 32);
#pragma unroll
    for (int qb = 0; qb < 2; ++qb) { float ss = 0.f;
#pragma unroll
      for (int s = 0; s < 4; ++s) { float x[8]; up8(qf[qb][s], x);
#pragma unroll
        for (int t = 0; t < 8; ++t) ss += x[t] * x[t]; }
      ss += pg8::xshfl<16>(ss); ss = pg8::xadd32(ss);
      const float rstd = __builtin_amdgcn_rsqf(ss * (1.f / 128.f) + 1e-6f) * QS;
      { float x[8]; up8(qf[qb][0], x); const float* cp = qn.cs + (wid * 32 + qb * 16 + fr) * 16 + 8 * (fq & 1); const float* sp = qn.sn + (wid * 32 + qb * 16 + fr) * 16 + 8 * (fq & 1);
#pragma unroll
        for (int t = 0; t < 8; ++t) { const float v = x[t] * rstd * qn.g[8 * fq + t], pr = pg8::xswap32(v, lane), c = cp[t], sn_ = sp[t]; x[t] = (fq < 2) ? v * c - pr * sn_ : v * c + pr * sn_; }
        qf[qb][0] = pk8(x); }
#pragma unroll
      for (int s = 1; s < 4; ++s) { float x[8]; up8(qf[qb][s], x);
#pragma unroll
        for (int t = 0; t < 8; ++t) x[t] = x[t] * rstd * qn.g[32 * s + 8 * fq + t];
        qf[qb][s] = pk8(x); } } }
  unsigned koff[2], voff[4];
#pragma unroll
  for (int i = 0; i < 2; ++i) { const int q = wid * 2 + i, R = 4 * q + (lane >> 4), g = (lane & 15) ^ (R & 15); koff[i] = (unsigned)(R * LDK * 2 + g * 16); }
#pragma unroll
  for (int i = 0; i < 4; ++i) { const int qq = wid * 4 + i, vh = qq >> 4, q = qq & 15;
    const int kk = (q >> 1) * 8 + ((lane & 31) >> 2), k = (kk & ~0xC) | ((kk & 4) << 1) | ((kk & 8) >> 1), c = vh * 128 + (2 * (q & 1) + (lane >> 5)) * 32 + ((lane & 3) ^ (2 * ((q >> 1) & 1))) * 8;
    voff[i] = (unsigned)(k * LDV * 2 + c * 2); }
  int kal[4];
#pragma unroll
  for (int s = 0; s < 4; ++s) kal[s] = (int)(uintptr_t)K_lds + fr * 256 + ((((s ^ (fr >> 2)) << 2) | ((fq ^ fr) & 3)) << 4);
  const int vcom = (int)(uintptr_t)V_lds + (fq & 1) * 2048 + (fq >> 1) * 256 + (fr >> 2) * 64 + (fr & 3) * 8;
  const int vbe0 = vcom + (fq & 1) * 32, vbo0 = vcom + (1 - (fq & 1)) * 32;
#define W3_TILE(t, s) do { const char* kb_ = (const char*)Kh + (size_t)(t) * (KVBLK * LDK * 2); const char* vb_ = (const char*)Vh + (size_t)(t) * (KVBLK * LDV * 2); \
    _Pragma("unroll") for (int i_ = 0; i_ < 2; ++i_) \
      __builtin_amdgcn_global_load_lds((const unsigned*)(kb_ + koff[i_]), (ATT_LAS unsigned*)(ldsl + W_OFF_K + (s) * SHM_K + (wid * 2 + i_) * 1024), 16, 0, 0); \
    _Pragma("unroll") for (int i_ = 0; i_ < 4; ++i_) \
      __builtin_amdgcn_global_load_lds((const unsigned*)(vb_ + voff[i_]), (ATT_LAS unsigned*)(ldsl + W_OFF_V + (s) * 2 * SHM_V + (wid * 4 + i_) * 1024), 16, 0, 0); } while (0)
  f32x4 sT[2][4]; bf16x8 pf[4]; const int NT = seq / KVBLK;
#define W3_K(t, s) do { const char* kb_ = (const char*)Kh + (size_t)(t) * (KVBLK * LDK * 2); _Pragma("unroll") for (int i_ = 0; i_ < 2; ++i_) \
      __builtin_amdgcn_global_load_lds((const unsigned*)(kb_ + koff[i_]), (ATT_LAS unsigned*)(ldsl + W_OFF_K + (s) * SHM_K + (wid * 2 + i_) * 1024), 16, 0, 0); } while (0)
#define W3_V(t, s) do { const char* vb_ = (const char*)Vh + (size_t)(t) * (KVBLK * LDV * 2); _Pragma("unroll") for (int i_ = 0; i_ < 4; ++i_) \
      __builtin_amdgcn_global_load_lds((const unsigned*)(vb_ + voff[i_]), (ATT_LAS unsigned*)(ldsl + W_OFF_V + (s) * 2 * SHM_V + (wid * 4 + i_) * 1024), 16, 0, 0); } while (0)
#define W3_QK(slot) do { int ka_[4]; bf16x8 f_[16]; _Pragma("unroll") for (int s_ = 0; s_ < 4; ++s_) ka_[s_] = kal[s_] + (slot) * SHM_K; \
      _Pragma("unroll") for (int a_ = 0; a_ < 2; ++a_) _Pragma("unroll") for (int b_ = 0; b_ < 4; ++b_) sT[a_][b_] = (f32x4){0.f, 0.f, 0.f, 0.f}; \
      SBAR(); qk3_step<0>(sT, f_, ka_, qf); } while (0)
#define W3_SM() do { \
    if (__builtin_expect(shift != 0.f, 0)) { _Pragma("unroll") for (int a_ = 0; a_ < 2; ++a_) _Pragma("unroll") for (int b_ = 0; b_ < 4; ++b_) sT[a_][b_] = sT[a_][b_] - shift; } \
    _Pragma("unroll") for (int a_ = 0; a_ < 2; ++a_) { float ps_ = 0.f; \
      _Pragma("unroll") for (int b_ = 0; b_ < 4; ++b_) _Pragma("unroll") for (int r_ = 0; r_ < 4; ++r_) { sT[a_][b_][r_] = __builtin_amdgcn_exp2f(sT[a_][b_][r_]); ps_ += sT[a_][b_][r_]; } \
      lsum[a_] += ps_; \
      _Pragma("unroll") for (int t_ = 0; t_ < 2; ++t_) { u32x4 w_ = {cvtpk(sT[a_][2 * t_][0], sT[a_][2 * t_][1]), cvtpk(sT[a_][2 * t_][2], sT[a_][2 * t_][3]), cvtpk(sT[a_][2 * t_ + 1][0], sT[a_][2 * t_ + 1][1]), cvtpk(sT[a_][2 * t_ + 1][2], sT[a_][2 * t_ + 1][3])}; \
        pf[2 * a_ + t_] = *reinterpret_cast<bf16x8*>(&w_); } } } while (0)
#define W3_PV(slot) do { s16x4 vl_[32], vh_[32]; SBAR(); pv3w_step<0, 16>(o, vl_, vh_, vbe0 + (slot) * 2 * SHM_V, vbo0 + (slot) * 2 * SHM_V, pf); } while (0)
#if ATT_STAGGER
  const bool lead = wid < 4;
  W3_V(0, 0); W3_K(0, 0); W3_V(1, 1); W3_K(1, 1); W3_K(2, 2);
  asm volatile("s_waitcnt vmcnt(8)" ::: "memory"); __builtin_amdgcn_s_barrier(); asm volatile("" ::: "memory");
  int s0 = 0, s1 = 1, s2 = 2;
#define W3_BARBLK(t) do { if ((t) + 1 < NT) { \
      if ((t) + 2 < NT) asm volatile("s_waitcnt vmcnt(2) lgkmcnt(0)" ::: "memory"); else asm volatile("s_waitcnt vmcnt(0) lgkmcnt(0)" ::: "memory"); \
      __builtin_amdgcn_s_barrier(); asm volatile("" ::: "memory"); \
      if ((t) + 2 < NT) W3_V((t) + 2, s2); \
      if ((t) + 3 < NT) W3_K((t) + 3, s0); \
      { const int a_ = s0; s0 = s1; s1 = s2; s2 = a_; } } } while (0)
  for (int t = 0; t < NT; ++t) { const int sv = s0;
    W3_QK(s0); W3_SM();
    if (!lead) W3_BARBLK(t);
    W3_PV(sv);
    if (lead) W3_BARBLK(t);
  }
#undef W3_BARBLK
#else
  W3_TILE(0, 0); W3_TILE(1, 1); W3_TILE(2, 2);
  asm volatile("s_waitcnt vmcnt(12)" ::: "memory"); __builtin_amdgcn_s_barrier(); asm volatile("" ::: "memory");
  int s0 = 0, s1 = 1, s2 = 2;
  for (int t = 0; t < NT; ++t) {
    W3_QK(s0); W3_SM(); W3_PV(s0);
    if (t + 1 < NT) {
      if (t + 2 < NT) asm volatile("s_waitcnt vmcnt(6) lgkmcnt(0)" ::: "memory"); else asm volatile("s_waitcnt vmcnt(0) lgkmcnt(0)" ::: "memory");
      __builtin_amdgcn_s_barrier(); asm volatile("" ::: "memory");
      if (t + 3 < NT) W3_TILE(t + 3, s0);
      { const int a_ = s0; s0 = s1; s1 = s2; s2 = a_; } }
  }
#endif
#undef W3_K
#undef W3_V
#undef W3_QK
#undef W3_SM
#undef W3_PV
  int fre = fr, fqe = fq; asm volatile("" : "+v"(fre), "+v"(fqe));
  typename Cfg::OutT* Ow = Ob + (long)(wid * 32 + fre) * LDO + 4 * fqe;
#pragma unroll
  for (int qb = 0; qb < 2; ++qb) { float lw = lsum[qb]; lw += pg8::xshfl<16>(lw); lw = pg8::xadd32(lw); const float rl = __builtin_amdgcn_rcpf(lw);
#pragma unroll
    for (int db = 0; db < 16; ++db) { typedef unsigned u32x2_ __attribute__((ext_vector_type(2)));
      u32x2_ w; w.x = cvtpk(o[qb][db][0] * rl, o[qb][db][1] * rl); w.y = cvtpk(o[qb][db][2] * rl, o[qb][db][3] * rl);
      *(u32x2_*)(Ow + (long)qb * 16 * LDO + db * 16) = w; } }
  asm volatile("s_waitcnt lgkmcnt(0)" ::: "memory"); __builtin_amdgcn_s_barrier(); asm volatile("" ::: "memory");
#undef W3_TILE
}

#undef KSWZ
#undef KRSWZ
#undef KX
#undef KRX
#undef SBAR
}

#define GAS __attribute__((address_space(1)))
#define LAS __attribute__((address_space(3)))
typedef unsigned short bf16;
typedef unsigned v4u __attribute__((ext_vector_type(4)));
typedef unsigned v2u __attribute__((ext_vector_type(2)));
typedef float f32x4 __attribute__((ext_vector_type(4)));
#define LDS_WAIT() asm volatile("s_waitcnt lgkmcnt(0)" ::: "memory")
#define VM_WAIT() asm volatile("s_waitcnt vmcnt(0)" ::: "memory")

#ifndef TR_AUX
#define TR_AUX 2
#endif
constexpr int NWAVES = 8;
constexpr int BATCH = 2, SEQ = 4096, DM = 4096, FF = 16384, MT = BATCH * SEQ;
constexpr int DEPTH = 4, PLED = 256;
constexpr int DIFF_IN = 12288;
constexpr int MLA_IN = 1600, MLA_INP = 1792, MLA_QR = 1024, MLA_KVR = 512, MLA_Q = 6144, MLA_KV = 8192;
constexpr float EPS = 1e-6f;

constexpr size_t MiB = (size_t)1 << 20;
constexpr size_t WS_CTL = 0, CTL_ZERO_BYTES = 1 * MiB;
constexpr size_t WS_LAM = 1 * MiB;
constexpr size_t WS_COSD = 2 * MiB, WS_SIND = WS_COSD + MiB / 2, WS_COSM = 3 * MiB, WS_SINM = 4 * MiB;
constexpr size_t WS_W1T = 8 * MiB;
constexpr size_t WS_W2T = WS_W1T + 512 * MiB;
constexpr size_t WS_WGT = WS_W2T + 512 * MiB;
constexpr size_t WS_WPT = WS_WGT + 128 * MiB;
constexpr size_t WS_DWIN = WS_WPT + 8 * MiB;
constexpr size_t WS_DWOUT = WS_DWIN + 192 * MiB;
constexpr size_t WS_MWIN = WS_DWOUT + 64 * MiB;
constexpr size_t WS_MWUQ = WS_MWIN + 28 * MiB;
constexpr size_t WS_MWUKV = WS_MWUQ + 24 * MiB;
constexpr size_t WS_MWOUT = WS_MWUKV + 16 * MiB;
constexpr size_t WS_HN = WS_MWOUT + 64 * MiB;
constexpr size_t WS_Z = WS_HN + 64 * MiB;
constexpr size_t WS_ZM = WS_Z + 192 * MiB;
constexpr size_t WS_CQN = WS_ZM + 56 * MiB;
constexpr size_t WS_CKVN = WS_CQN + 16 * MiB;
constexpr size_t WS_KR = WS_CKVN + 8 * MiB;
constexpr size_t WS_QM = WS_KR + 4 * MiB;
constexpr size_t WS_KVM = WS_QM + 96 * MiB;
constexpr size_t WS_OPART = WS_KVM + 128 * MiB;
constexpr size_t WS_OB = WS_OPART + 256 * MiB;
constexpr size_t WS_ACT = WS_OB + 64 * MiB;
constexpr size_t WS_PLE = WS_ACT + 256 * MiB;
constexpr size_t WS_PB = WS_PLE + 64 * MiB;
constexpr size_t WS_XB1 = WS_PB + 16 * MiB;
constexpr size_t WS_SS = WS_XB1 + 64 * MiB;
constexpr size_t WS_X8 = WS_SS + 26 * MiB;
constexpr size_t WS_OB8 = WS_X8 + 32 * MiB;
constexpr size_t WS_END = WS_OB8 + 32 * MiB;
constexpr int CW_BAR = 4096;

constexpr int SCR_BYTES = 151552;
constexpr int LDSCTL_OFF = SCR_BYTES, MISC_OFF = LDSCTL_OFF + 320;
constexpr int LDS_BYTES = 155648;
static_assert(MISC_OFF + 128 <= LDS_BYTES && 8 * 16640 <= SCR_BYTES && att::LDS_BYTES <= SCR_BYTES && att::PA_LDS_BYTES <= SCR_BYTES && att::DMA_LDS_BYTES <= SCR_BYTES && att::PAD_LDS_BYTES <= SCR_BYTES && pg8::STAGE_BYTES <= SCR_BYTES, "LDS map");

#define XB_TMO      128
#define XB_XCNT(j)  (256  + 64 * (j))
#define XB_XSUB(j)  (1280 + 64 * (j))
#define XB_XGEN(j)  (2304 + 64 * (j))
#define XB_TOP      3328
#define XB_TOPGEN   3392
#define XCD_BAR_WORDS 3456
#define XB_SPIN_CAP (1u << 18)

__device__ __forceinline__ unsigned xb_ld(unsigned* p)              { return __hip_atomic_load(p, __ATOMIC_RELAXED, __HIP_MEMORY_SCOPE_AGENT); }
__device__ __forceinline__ unsigned xb_add(unsigned* p, unsigned v) { return __hip_atomic_fetch_add(p, v, __ATOMIC_RELAXED, __HIP_MEMORY_SCOPE_AGENT); }
__device__ __forceinline__ unsigned xb_xcc_id() { return (unsigned)__builtin_amdgcn_s_getreg((3 << 11) | 20) & 0xFu; }
#define XB_SPIN(cond, bar) do { unsigned _sp = 0; while (cond) { __builtin_amdgcn_s_sleep(1); \
    if ((++_sp & 255u) == 0u) { if (xb_ld(&(bar)[XB_TMO])) break; if (_sp > XB_SPIN_CAP) { atomicAdd(&(bar)[XB_TMO], 1u); break; } } } } while (0)

struct XcdBarrier {
    unsigned* bar; unsigned x;
    volatile LAS unsigned* st;
};

__device__ __forceinline__ XcdBarrier xcd_barrier_post(unsigned* bar, volatile LAS unsigned* st) {
    XcdBarrier b; b.bar = bar; b.x = xb_xcc_id(); b.st = st;
    if (my_tid() == 0) (void)xb_add(&bar[XB_XCNT(b.x)], 1u);
    return b;
}
__device__ __forceinline__ void xcd_barrier_complete(unsigned* bar, unsigned x, unsigned& nloc, unsigned& nx) {
    const unsigned G = gridDim.x * gridDim.y * gridDim.z;
    unsigned sum, cnt, mine, sp = 0u;
    for (;;) {
        sum = 0u; cnt = 0u; mine = 0u;
#pragma unroll
        for (unsigned j = 0; j < 16; ++j) { const unsigned c = xb_ld(&bar[XB_XCNT(j)]); sum += c; cnt += (c > 0u) ? 1u : 0u; mine = (j == x) ? c : mine; }
        if (sum == G) break;
        __builtin_amdgcn_s_sleep(1);
        if ((++sp & 255u) == 0u) { if (xb_ld(&bar[XB_TMO])) break; if (sp > XB_SPIN_CAP) { atomicAdd(&bar[XB_TMO], 1u); break; } }
    }
    nloc = mine > 0u ? mine : 1u; nx = cnt > 0u ? cnt : 1u;
}

__device__ __forceinline__ void xcd_barrier(const XcdBarrier& b) {
    asm volatile("s_waitcnt vmcnt(0)" ::: "memory");
    __syncthreads();
    if (my_tid() == 0) {
        unsigned* bar = b.bar;
        __builtin_amdgcn_s_waitcnt(0);
        unsigned nloc = b.st[0], nx = b.st[1];
        if (nloc == 0u) { xcd_barrier_complete(bar, b.x, nloc, nx); b.st[0] = nloc; b.st[1] = nx; }
        const unsigned old = xb_add(&bar[XB_XSUB(b.x)], 1u);
        const unsigned gen = old / nloc;
        if (old + 1u == (gen + 1u) * nloc) {
            __builtin_amdgcn_fence(__ATOMIC_RELEASE, "agent");
            asm volatile("s_waitcnt vmcnt(0)" ::: "memory");
            const unsigned og = xb_add(&bar[XB_TOP], 1u);
            const unsigned tg = og / nx;
            if (og + 1u == (tg + 1u) * nx) xb_add(&bar[XB_TOPGEN], 1u);
            else XB_SPIN(xb_ld(&bar[XB_TOPGEN]) == tg, bar);
            __builtin_amdgcn_fence(__ATOMIC_ACQUIRE, "agent");
            xb_add(&bar[XB_XGEN(b.x)], 1u);
            asm volatile("s_waitcnt vmcnt(0)" ::: "memory");
        } else {
            XB_SPIN(xb_ld(&bar[XB_XGEN(b.x)]) == gen, bar);
            __builtin_amdgcn_fence(__ATOMIC_ACQUIRE, "agent");
            asm volatile("s_waitcnt vmcnt(0)" ::: "memory");
        }
    }
    __syncthreads();
}

__device__ __forceinline__ float wave_sum(float v) {
    v += pg8::xshfl<1>(v); v += pg8::xshfl<2>(v); v += pg8::xshfl<4>(v); v += pg8::xshfl<8>(v); v += pg8::xshfl<16>(v);
    return pg8::xadd32(v);
}
__device__ __forceinline__ float wave_max(float v) {
    v = fmaxf(v, pg8::xshfl<1>(v)); v = fmaxf(v, pg8::xshfl<2>(v)); v = fmaxf(v, pg8::xshfl<4>(v)); v = fmaxf(v, pg8::xshfl<8>(v)); v = fmaxf(v, pg8::xshfl<16>(v));
    const unsigned u = __builtin_bit_cast(unsigned, v); auto r = __builtin_amdgcn_permlane32_swap(u, u, false, false);
    return fmaxf(__builtin_bit_cast(float, (unsigned)r[0]), __builtin_bit_cast(float, (unsigned)r[1]));
}
__device__ __forceinline__ unsigned f2bf(float f) { unsigned u = __builtin_bit_cast(unsigned, f); return (u + 0x7fffu + ((u >> 16) & 1u)) >> 16; }
__device__ __forceinline__ unsigned pk2(float lo, float hi) { return pg8::cvt_pk_bf16(lo, hi); }
__device__ __forceinline__ float bflo(unsigned w) { return __uint_as_float(w << 16); }
__device__ __forceinline__ float bfhi(unsigned w) { return __uint_as_float(w & 0xffff0000u); }
__device__ __forceinline__ void unpack8(v4u r, float (&x)[8]) { x[0] = bflo(r.x); x[1] = bfhi(r.x); x[2] = bflo(r.y); x[3] = bfhi(r.y); x[4] = bflo(r.z); x[5] = bfhi(r.z); x[6] = bflo(r.w); x[7] = bfhi(r.w); }
__device__ __forceinline__ v4u pack8(const float (&y)[8]) { v4u o; o.x = pk2(y[0], y[1]); o.y = pk2(y[2], y[3]); o.z = pk2(y[4], y[5]); o.w = pk2(y[6], y[7]); return o; }
__device__ __forceinline__ double d_exp(double x) {
    const double n = __builtin_rint(x * 1.4426950408889634), r = x - n * 0.6931471805599453094;
    double t = 1.0, s = 1.0;
#pragma nounroll
    for (int k = 1; k <= 15; ++k) { t *= r / (double)k; s += t; }
    const long long e = (long long)n + 1023;
    return s * __builtin_bit_cast(double, (unsigned long long)e << 52);
}
__device__ __forceinline__ void d_sincos_small(double x, double& sn, double& cs) {
    const double x2 = x * x; double tc = 1.0, ts = x; cs = 1.0; sn = x;
#pragma nounroll
    for (int k = 1; k <= 11; ++k) { tc *= -x2 / (double)((2 * k - 1) * (2 * k)); ts *= -x2 / (double)((2 * k) * (2 * k + 1)); cs += tc; sn += ts; }
}
__device__ __forceinline__ void rope_cs(int pos, double inv, float& c_out, float& s_out) {
    double zs, zc; d_sincos_small(inv, zs, zc);
    double rc = 1.0, rs = 0.0; unsigned p = pos < 0 ? (unsigned)(-pos) : (unsigned)pos;
    while (p) { if (p & 1u) { const double t = rc * zc - rs * zs; rs = rc * zs + rs * zc; rc = t; }
        const double t2 = zc * zc - zs * zs; zs = 2.0 * zc * zs; zc = t2; p >>= 1; }
    c_out = (float)rc; s_out = (float)(pos < 0 ? -rs : rs);
}

__device__ __forceinline__ void transpose_items(const float* __restrict__ W, bf16* __restrict__ WT, int K, int N, int NP, int Lyr, const float* __restrict__ gain, int gmul, int gadd, LAS float* scr, int gw, int ngw, int lane_in, bool f8 = false) {
    int lane = lane_in; asm volatile("" : "+v"(lane));
    const int nkt = K >> 6, nnt = N >> 6, items = Lyr * nkt * nnt;
    const int c = lane & 7, nn = lane >> 3;
    const int rl = lane >> 4, gp = lane & 15;
    for (int it = gw; it < items; it += ngw) {
        const int nt = it % nnt, t2 = it / nnt, kt = t2 % nkt, l = t2 / nkt;
        const char* src = (const char*)(W + (size_t)l * K * N + (size_t)(kt * 64 + rl) * N + nt * 64);
#pragma unroll
        for (int p = 0; p < 16; ++p) { const int g = gp ^ ((p >> 1) & 7);
            __builtin_amdgcn_global_load_lds((const unsigned*)(src + (size_t)(4 * p) * N * 4 + g * 16), (LAS unsigned*)((LAS unsigned char*)scr + p * 1024), 16, 0, TR_AUX); }
        float gv[8];
        if (gain) { const float* gpn = gain + (size_t)(l * gmul + gadd) * DM + kt * 64 + 8 * c;
#pragma unroll
            for (int t = 0; t < 8; ++t) gv[t] = gpn[t]; }
        else {
#pragma unroll
            for (int t = 0; t < 8; ++t) gv[t] = 1.f; }
        asm volatile("s_waitcnt vmcnt(0)" ::: "memory");
        if (f8) { unsigned char* dst8 = (unsigned char*)WT + (size_t)l * NP * K + (size_t)(nt * 64) * K + kt * 64;
#pragma unroll
            for (int s = 0; s < 8; ++s) { const int n = s * 8 + nn; const LAS float* sp = scr + (8 * c) * 64 + (((n >> 2) ^ c) << 2) + (n & 3);
                int e0 = 0, e1 = 0;
                e0 = __builtin_amdgcn_cvt_pk_fp8_f32(sp[0 * 64] * gv[0] * 128.f, sp[1 * 64] * gv[1] * 128.f, e0, false); e0 = __builtin_amdgcn_cvt_pk_fp8_f32(sp[2 * 64] * gv[2] * 128.f, sp[3 * 64] * gv[3] * 128.f, e0, true);
                e1 = __builtin_amdgcn_cvt_pk_fp8_f32(sp[4 * 64] * gv[4] * 128.f, sp[5 * 64] * gv[5] * 128.f, e1, false); e1 = __builtin_amdgcn_cvt_pk_fp8_f32(sp[6 * 64] * gv[6] * 128.f, sp[7 * 64] * gv[7] * 128.f, e1, true);
                v2u o8; o8.x = (unsigned)e0; o8.y = (unsigned)e1; *(v2u*)(dst8 + (size_t)n * K + 8 * c) = o8; }
            LDS_WAIT(); continue; }
        bf16* dst = WT + (size_t)l * NP * K + (size_t)(nt * 64) * K + kt * 64;
#pragma unroll
        for (int s = 0; s < 8; ++s) { const int n = s * 8 + nn; const LAS float* sp = scr + (8 * c) * 64 + (((n >> 2) ^ c) << 2) + (n & 3);
            v4u o; o.x = pk2(sp[0 * 64] * gv[0], sp[1 * 64] * gv[1]); o.y = pk2(sp[2 * 64] * gv[2], sp[3 * 64] * gv[3]); o.z = pk2(sp[4 * 64] * gv[4], sp[5 * 64] * gv[5]); o.w = pk2(sp[6 * 64] * gv[6], sp[7 * 64] * gv[7]);
            *(v4u*)(dst + (size_t)n * K + 8 * c) = o; }
        LDS_WAIT();
    }
}
__device__ __forceinline__ void xb_rows(const float* __restrict__ X, bf16* __restrict__ out, float* __restrict__ ss, int gw, int ngw, int lane_in) {
    int lane = lane_in; asm volatile("" : "+v"(lane));
    for (int row = gw; row < MT; row += ngw) {
        const f32x4* xr = (const f32x4*)(X + (size_t)row * DM) + lane;
        f32x4 v[16]; float s = 0.f;
#pragma unroll
        for (int j = 0; j < 16; ++j) { v[j] = xr[64 * j]; s += (v[j].x * v[j].x + v[j].y * v[j].y) + (v[j].z * v[j].z + v[j].w * v[j].w); }
        s = wave_sum(s); ss[(size_t)row * 64 + lane] = (lane == 0) ? s : 0.f;
        v2u* o8 = (v2u*)(out + (size_t)row * DM) + lane;
#pragma unroll
        for (int j = 0; j < 16; ++j) { v2u w; w.x = pk2(v[j].x, v[j].y); w.y = pk2(v[j].z, v[j].w); o8[64 * j] = w; }
    }
}
__device__ __forceinline__ void diff_k_norm_rope(bf16* __restrict__ Z, const float* __restrict__ gk, const float* __restrict__ cosd, const float* __restrict__ sind, int gw, int ngw, int lane_in) {
    int lane = lane_in; asm volatile("" : "+v"(lane));
    const int li = lane & 15;
    float gkv[8];
#pragma unroll
    for (int t = 0; t < 8; ++t) gkv[t] = gk[li * 8 + t];
    for (int row = gw; row < MT; row += ngw) {
        v4u* zr = (v4u*)(Z + (size_t)row * DIFF_IN + 4096 + (lane >> 4) * 128 + li * 8);
        v4u raw[8];
#pragma unroll
        for (int it = 0; it < 8; ++it) raw[it] = zr[it * 64];
        float cs[8], sn[8];
#pragma unroll
        for (int t = 0; t < 8; ++t) { cs[t] = cosd[row * 16 + (li & 1) * 8 + t]; sn[t] = sind[row * 16 + (li & 1) * 8 + t]; }
#pragma unroll
        for (int it = 0; it < 8; ++it) {
            float x[8]; unpack8(raw[it], x);
            float ss = 0.f;
#pragma unroll
            for (int t = 0; t < 8; ++t) ss += x[t] * x[t];
            ss += pg8::xshfl<1>(ss); ss += pg8::xshfl<2>(ss); ss += pg8::xshfl<4>(ss); ss += pg8::xshfl<8>(ss);
            const float rstd = __builtin_amdgcn_rsqf(ss * (1.f / 128.f) + EPS);
            float y[8];
#pragma unroll
            for (int t = 0; t < 8; ++t) y[t] = x[t] * rstd * gkv[t];
#pragma unroll
            for (int t = 0; t < 8; ++t) { const float pr = pg8::xshfl<2>(y[t]);
                const float r1 = y[t] * cs[t] - pr * sn[t], r2 = y[t] * cs[t] + pr * sn[t];
                y[t] = (li < 2) ? r1 : ((li < 4) ? r2 : y[t]); }
            zr[it * 64] = pack8(y);
        }
    }
}
__device__ __forceinline__ void diff_combine(const bf16* __restrict__ OP, const float* __restrict__ lamp, const float* __restrict__ gsub, float om, bf16* __restrict__ OBo, int gw, int ngw, int lane_in) {
    int lane = lane_in; asm volatile("" : "+v"(lane));
    const float lam = *lamp; const int li = lane & 15, hg = lane >> 4;
    float gs[16];
#pragma unroll
    for (int k = 0; k < 16; ++k) gs[k] = gsub[li * 16 + k];
    for (int row = gw; row < MT; row += ngw) {
        const v4u* a0 = (const v4u*)(OP + (size_t)row * DM) + hg * 32 + li * 2; const v4u* a1 = (const v4u*)(OP + (size_t)MT * DM + (size_t)row * DM) + hg * 32 + li * 2;
        v4u va[4][2], vb[4][2];
#pragma unroll
        for (int it = 0; it < 4; ++it)
#pragma unroll
            for (int k = 0; k < 2; ++k) { va[it][k] = a0[it * 128 + k]; vb[it][k] = a1[it * 128 + k]; }
        v4u* o8 = (v4u*)(OBo + (size_t)row * DM) + hg * 32 + li * 2;
#pragma unroll
        for (int it = 0; it < 4; ++it) { float o[16]; float ss = 0.f;
#pragma unroll
            for (int k = 0; k < 2; ++k) { float x[8], y[8]; unpack8(va[it][k], x); unpack8(vb[it][k], y);
#pragma unroll
                for (int t = 0; t < 8; ++t) { const float v = x[t] - y[t] * lam; o[8 * k + t] = v; ss += v * v; } }
            ss += pg8::xshfl<1>(ss); ss += pg8::xshfl<2>(ss); ss += pg8::xshfl<4>(ss); ss += pg8::xshfl<8>(ss);
            const float rstd = om * __builtin_amdgcn_rsqf(ss * (1.f / 256.f) + EPS);
#pragma unroll
            for (int k = 0; k < 2; ++k) { float y[8];
#pragma unroll
                for (int t = 0; t < 8; ++t) y[t] = o[8 * k + t] * rstd * gs[8 * k + t];
                o8[it * 128 + k] = pack8(y); } }
    }
}
__device__ __forceinline__ void diff_combine_pair(const bf16* __restrict__ OP, size_t row0, int h, const float* __restrict__ lamp, const float* __restrict__ gsub, float om, bf16* __restrict__ OBo, int wave, int lane_in) {
    int lane = lane_in; asm volatile("" : "+v"(lane));
    const float lam = *lamp; const int li = lane & 15, rq = lane >> 4;
    float gs[16];
#pragma unroll
    for (int k = 0; k < 16; ++k) gs[k] = gsub[li * 16 + k];
    const size_t e0 = (row0 + (size_t)(wave * 4 + rq)) * DM + (size_t)h * 256 + li * 16;
    v4u va[4][2], vb[4][2];
#pragma unroll
    for (int st = 0; st < 4; ++st)
#pragma unroll
        for (int k = 0; k < 2; ++k) { va[st][k] = *(const v4u*)(OP + e0 + (size_t)st * 32 * DM + 8 * k); vb[st][k] = *(const v4u*)(OP + (size_t)MT * DM + e0 + (size_t)st * 32 * DM + 8 * k); }
#pragma unroll
    for (int st = 0; st < 4; ++st) { float o[16]; float ss = 0.f;
#pragma unroll
        for (int k = 0; k < 2; ++k) { float x[8], y[8]; unpack8(va[st][k], x); unpack8(vb[st][k], y);
#pragma unroll
            for (int t = 0; t < 8; ++t) { const float v = x[t] - y[t] * lam; o[8 * k + t] = v; ss += v * v; } }
        ss += pg8::xshfl<1>(ss); ss += pg8::xshfl<2>(ss); ss += pg8::xshfl<4>(ss); ss += pg8::xshfl<8>(ss);
        const float rstd = om * __builtin_amdgcn_rsqf(ss * (1.f / 256.f) + EPS);
#pragma unroll
        for (int k = 0; k < 2; ++k) { float y[8];
#pragma unroll
            for (int t = 0; t < 8; ++t) y[t] = o[8 * k + t] * rstd * gs[8 * k + t];
            *(v4u*)(OBo + e0 + (size_t)st * 32 * DM + 8 * k) = pack8(y); } }
}
__device__ __forceinline__ void mla_norm1(const float* __restrict__ ZMp, const float* __restrict__ gcq, const float* __restrict__ gckv, const float* __restrict__ gk, const float* __restrict__ cosm, const float* __restrict__ sinm,
                                          bf16* __restrict__ CQ, bf16* __restrict__ CKV, bf16* __restrict__ KRo, int gw, int ngw, int lane_in) {
    int lane = lane_in; asm volatile("" : "+v"(lane));
    const float gkr = gk[128 + lane];
    for (int row = gw; row < MT; row += ngw) {
        const float* zr = ZMp + (size_t)row * MLA_INP;
        f32x4 a[4], b[2]; float sa = 0.f, sb = 0.f;
#pragma unroll
        for (int j = 0; j < 4; ++j) { a[j] = ((const f32x4*)zr)[lane + 64 * j]; sa += (a[j].x * a[j].x + a[j].y * a[j].y) + (a[j].z * a[j].z + a[j].w * a[j].w); }
#pragma unroll
        for (int j = 0; j < 2; ++j) { b[j] = ((const f32x4*)(zr + MLA_QR))[lane + 64 * j]; sb += (b[j].x * b[j].x + b[j].y * b[j].y) + (b[j].z * b[j].z + b[j].w * b[j].w); }
        const float kx = zr[MLA_QR + MLA_KVR + lane];
        const float ra = 1.0f / sqrtf(wave_sum(sa) * (1.f / MLA_QR) + EPS), rb = 1.0f / sqrtf(wave_sum(sb) * (1.f / MLA_KVR) + EPS), rk = 1.0f / sqrtf(wave_sum(kx * kx) * (1.f / 64.f) + EPS);
        v2u* oa = (v2u*)(CQ + (size_t)row * MLA_QR) + lane; v2u* ob = (v2u*)(CKV + (size_t)row * MLA_KVR) + lane;
#pragma unroll
        for (int j = 0; j < 4; ++j) { const f32x4 g = ((const f32x4*)gcq)[lane + 64 * j]; v2u w; w.x = pk2(a[j].x * ra * g.x, a[j].y * ra * g.y); w.y = pk2(a[j].z * ra * g.z, a[j].w * ra * g.w); oa[64 * j] = w; }
#pragma unroll
        for (int j = 0; j < 2; ++j) { const f32x4 g = ((const f32x4*)gckv)[lane + 64 * j]; v2u w; w.x = pk2(b[j].x * rb * g.x, b[j].y * rb * g.y); w.y = pk2(b[j].z * rb * g.z, b[j].w * rb * g.w); ob[64 * j] = w; }
        const float y = kx * rk * gkr, pr = pg8::xswap32(y, lane), c = cosm[row * 32 + (lane & 31)], s = sinm[row * 32 + (lane & 31)];
        KRo[(size_t)row * 64 + lane] = (bf16)f2bf(lane < 32 ? y * c - pr * s : y * c + pr * s);
    }
}
__device__ __forceinline__ void mla_norm2(bf16* __restrict__ KVMp, const float* __restrict__ gk, int gw, int ngw, int lane_in) {
    int lane = lane_in; asm volatile("" : "+v"(lane));
    const int li = lane & 15;
    float gkn[8];
#pragma unroll
    for (int t = 0; t < 8; ++t) gkn[t] = gk[li * 8 + t];
    for (int row = gw; row < MT; row += ngw) {
        bf16* kr = KVMp + (size_t)row * MLA_KV;
        v4u rk[8];
#pragma unroll
        for (int it = 0; it < 8; ++it) { const int head = it * 4 + (lane >> 4); rk[it] = *(const v4u*)(kr + head * 256 + li * 8); }
#pragma unroll
        for (int it = 0; it < 8; ++it) {
            const int head = it * 4 + (lane >> 4);
            float z[8]; unpack8(rk[it], z);
            float sk = 0.f;
#pragma unroll
            for (int t = 0; t < 8; ++t) sk += z[t] * z[t];
            sk += pg8::xshfl<1>(sk); sk += pg8::xshfl<2>(sk); sk += pg8::xshfl<4>(sk); sk += pg8::xshfl<8>(sk);
            const float r2 = __builtin_amdgcn_rsqf(sk * (1.f / 128.f) + EPS);
#pragma unroll
            for (int t = 0; t < 8; ++t) z[t] = z[t] * r2 * gkn[t];
            *(v4u*)(kr + head * 256 + li * 8) = pack8(z);
        }
    }
}

#ifndef FUSE_KNORM_D
#define FUSE_KNORM_D 1
#endif
#ifndef FUSE_KNORM_M
#define FUSE_KNORM_M 1
#endif
#ifndef RES_BF16
#define RES_BF16 1
#endif
#ifndef STAGGER_CONV
#define STAGGER_CONV 1
#endif
#ifndef DIFF_PA
#define DIFF_PA 1
#endif
#ifndef DIFF_PAD
#define DIFF_PAD 2
#endif
#ifndef MLA_PA
#define MLA_PA 0
#endif
#ifndef DIFF_WIDE
#define DIFF_WIDE 1
#endif
#ifndef MLA_MFMA16
#define MLA_MFMA16 1
#endif
#if MLA_MFMA16
#define MLA_BODY attn_unit_dma3
#else
#define MLA_BODY attn_unit_dma
#endif
#ifndef DIFF_MFMA16
#define DIFF_MFMA16 1
#endif
#ifndef MLA_F8
#define MLA_F8 1
#endif
#ifndef GATE_F8
#define GATE_F8 1
#endif
#ifndef FUSE_COMBINE
#define FUSE_COMBINE 1
#endif
#ifndef DIFF_PVPIPE
#define DIFF_PVPIPE 1
#endif
#ifndef MLA_PVPIPE
#define MLA_PVPIPE 0
#endif
#ifndef ATT_DMA
#define ATT_DMA 1
#endif
#ifndef MLA_SDEPTH
#define MLA_SDEPTH 1
#endif
struct DiffCfg { static constexpr int LDQ = DIFF_IN, LDK = DIFF_IN, LDV = DIFF_IN, LDO = DM, LDKR = 64, NROPE = 0, SDEPTH = 2, VW = 256, PVPIPE = DIFF_PVPIPE; static constexpr bool QNORM = true; static constexpr float SCALE = 0.08838834764831845f; typedef bf16 OutT; };
struct MlaCfg  { static constexpr int LDQ = MLA_Q, LDK = MLA_KV, LDV = MLA_KV, LDO = DM, LDKR = 64, NROPE = 64, SDEPTH = MLA_SDEPTH, VW = 128, PVPIPE = MLA_PVPIPE; static constexpr bool QNORM = true; static constexpr float SCALE = 0.07216878364870323f; typedef bf16 OutT; };

__constant__ int TKIND[10][9] = {
    {6, 4096, 16384, 16384, 4, (int)(WS_W1T / MiB), 4, 1, 0}, {7, 16384, 4096, 4096, 4, (int)(WS_W2T / MiB), -1, 0, 0}, {8, 4096, 4096, 4096, 4, (int)(WS_WGT / MiB), 5, 1, 0}, {9, 256, 4096, 4096, 4, (int)(WS_WPT / MiB), -1, 0, 0},
    {10, 4096, 12288, 12288, 2, (int)(WS_DWIN / MiB), 3, 2, 0}, {11, 4096, 4096, 4096, 2, (int)(WS_DWOUT / MiB), -1, 0, 0}, {16, 4096, 1600, 1792, 2, (int)(WS_MWIN / MiB), 3, 2, 1}, {19, 1024, 6144, 6144, 2, (int)(WS_MWUQ / MiB), -1, 0, 0},
    {20, 512, 8192, 8192, 2, (int)(WS_MWUKV / MiB), -1, 0, 0}, {23, 4096, 4096, 4096, 2, (int)(WS_MWOUT / MiB), -1, 0, 0} };

__device__ __forceinline__ void xbar_fresh(const XcdBarrier& b) { XcdBarrier c = b; asm volatile("" : "+s"(c.bar)); asm volatile("" : "+s"(c.x)); xcd_barrier(c); }
#ifdef PROBE_BARX2
#define XBAR(b) do { xbar_fresh(b); xbar_fresh(b); } while (0)
#else
#define XBAR(b) xbar_fresh(b)
#endif
struct Args { const void* in[24]; float* out; unsigned char* ws; };

typedef const __attribute__((address_space(4))) unsigned char* kptr_t;
struct Ph { kptr_t kp; unsigned char* ws; float* X; int G, bx, vcu, gw, ngw, lane, tid; };
__device__ __forceinline__ Ph ph_begin() {
    Ph p; kptr_t kp = (kptr_t)__builtin_amdgcn_kernarg_segment_ptr(); asm volatile("" : "+s"(kp)); p.kp = kp;
    p.ws = *(unsigned char* const __attribute__((address_space(4)))*)(kp + 200); p.X = *(float* const __attribute__((address_space(4)))*)(kp + 192);
    int G = gridDim.x; asm volatile("" : "+s"(G)); int tid = my_tid(); asm volatile("" : "+v"(tid));
    int bxx = blockIdx.x; asm volatile("" : "+s"(bxx));
    p.G = G; p.bx = bxx; p.vcu = (G % 8 == 0) ? (p.bx % 8) * (G / 8) + p.bx / 8 : p.bx;
    p.tid = tid; p.lane = tid & 63; p.gw = p.vcu * NWAVES + __builtin_amdgcn_readfirstlane(tid >> 6); p.ngw = G * NWAVES;
    return p;
}
__device__ __forceinline__ const float* kin(const Ph& p, int k) { return *(const float* const __attribute__((address_space(4)))*)(p.kp + 8 * k); }
static_assert(sizeof(Args) == 208, "Args layout (kernarg offsets 8k, out at 192, ws at 200)");

#ifndef GEMM_ALIGN
#define GEMM_ALIGN true
#endif
#ifndef GEMM_SP2
#define GEMM_SP2 true
#endif
#ifdef SKIP_GEMM
#define GEMM_PHASE(EPI_T, EPI_OBJ, APTR, BPTR, MM, NN, KK) do {} while (0)
#else
#define GEMM_PHASE(EPI_T, EPI_OBJ, APTR, BPTR, MM, NN, KK) do { pg8::Gemm g_{(const pg8::bf16_t*)(APTR), (const pg8::bf16_t*)(BPTR), (MM), (NN), (KK)}; pg8::StaticOrder S_; S_.init((MM), (NN), P.G, P.bx); \
    const EPI_T E_ = EPI_OBJ; pg8::gemm_phase<EPI_T, pg8::StaticOrder, GEMM_ALIGN, GEMM_SP2>(L, g_, S_, E_); } while (0)
#define GEMM_PHASE_F8(EPI_T, EPI_OBJ, APTR, BPTR, MM, NN, KK) do { pg8::Gemm g_{(const pg8::bf16_t*)(APTR), (const pg8::bf16_t*)(BPTR), (MM), (NN), (KK)}; pg8::StaticOrder S_; S_.init((MM), (NN), P.G, P.bx); \
    const EPI_T E_ = EPI_OBJ; pg8::gemm_phase<EPI_T, pg8::StaticOrder, GEMM_ALIGN, GEMM_SP2, true>(L, g_, S_, E_); } while (0)
#endif
#define WSP(T, OFF) ((T*)(P.ws + (OFF)))
constexpr int RSTAB_OFF = LDSCTL_OFF + 1024;
static_assert(RSTAB_OFF + 1024 <= LDS_BYTES && RSTAB_OFF >= MISC_OFF + 128, "rstd table in spare LDS");
__device__ __forceinline__ pg8::RowScale rstd_table(const float* ssp, LAS unsigned char* L, const Ph& P, int M, int N) {
    LAS float* tab = (LAS float*)(L + RSTAB_OFF); pg8::RowScale r; r.tab = tab; r.ss = ssp; r.pm_tab = -1;
    pg8::StaticOrder S; S.init(M, N, P.G, P.bx); pg8::Unit u;
    if (S.next(0, u)) {
        const int t = P.tid, h = t & 1; const f32x4* p = (const f32x4*)(ssp + (size_t)(u.pm * 256 + (t >> 1)) * 64 + h * 32);
        f32x4 v[8];
#pragma unroll
        for (int k = 0; k < 8; ++k) v[k] = p[k];
        float s = 0.f;
#pragma unroll
        for (int k = 0; k < 8; ++k) s += (v[k][0] + v[k][1]) + (v[k][2] + v[k][3]);
        s += pg8::xshfl<1>(s);
        if (h == 0) tab[t >> 1] = 1.0f / sqrtf(s * (1.f / DM) + EPS);
        __syncthreads();
        r.pm_tab = u.pm;
    }
    return r;
}
#define SINGLE_ARG(...) __VA_ARGS__
constexpr int XT_OFF = 131072;
static_assert(XT_OFF >= pg8::STAGE_BYTES && XT_OFF + 8192 <= SCR_BYTES, "xt table");

__device__ __forceinline__ void convert_layer(const Ph& P, LAS unsigned char* L, int layer, int which = 0) {
    LAS float* scr = (LAS float*)(L + __builtin_amdgcn_readfirstlane(P.tid >> 6) * 16384);
    for (int kind = 0; kind < 10; ++kind) {
        const int ii = TKIND[kind][0], K = TKIND[kind][1], N = TKIND[kind][2], NP = TKIND[kind][3], Ly = TKIND[kind][4], gi = TKIND[kind][6], gmul = TKIND[kind][7], gadd = TKIND[kind][8]; const size_t off = (size_t)TKIND[kind][5] * MiB;
        const float* W = kin(P, ii); bf16* WT = (bf16*)(P.ws + off); const float* gain = gi >= 0 ? kin(P, gi) : (const float*)nullptr;
        const bool f8 = (GATE_F8 && kind == 2) || (MLA_F8 && kind == 9);
        if (layer < 0) { transpose_items(W, WT, K, N, NP, Ly, gain, gmul, gadd, scr, P.gw, P.ngw, P.lane, f8); continue; }
        int l;
        if (kind < 4) l = layer; else if (kind < 6) { if (layer & 1) continue; l = layer >> 1; } else { if (!(layer & 1)) continue; l = layer >> 1; }
        if (which) { const bool first = (kind == 4 || kind == 6); if ((which == 1) != first) continue; }
        transpose_items(W + (size_t)l * K * N, f8 ? (bf16*)((unsigned char*)WT + (size_t)l * NP * K) : WT + (size_t)l * NP * K, K, N, NP, 1, gain, 0, l * gmul + gadd, scr, P.gw, P.ngw, P.lane, f8);
    }
}
#ifndef P_STAGGER
#define P_STAGGER 1
#endif
__device__ __forceinline__ void cast_p(const Ph& P) {
    const int gt = P.vcu * (NWAVES * 64) + P.tid, ngt = P.G * NWAVES * 64;
    const float* p = kin(P, 1); bf16* pb = WSP(bf16, WS_PB);
    for (int idx = gt; idx < DEPTH * MT * PLED / 8; idx += ngt) { const f32x4 u0 = ((const f32x4*)p)[2 * (size_t)idx], u1 = ((const f32x4*)p)[2 * (size_t)idx + 1];
        v4u o; o.x = pk2(u0.x, u0.y); o.y = pk2(u0.z, u0.w); o.z = pk2(u1.x, u1.y); o.w = pk2(u1.z, u1.w); ((v4u*)pb)[idx] = o; }
}
__device__ __forceinline__ void ph_prologue(LAS unsigned char* L) {
    const Ph P = ph_begin();
    const int wave = __builtin_amdgcn_readfirstlane(P.tid >> 6);
#ifndef SKIP_TR
    if (STAGGER_CONV) convert_layer(P, L, 0, 1); else convert_layer(P, L, -1);
#endif
    const int gt = P.vcu * (NWAVES * 64) + P.tid, ngt = P.G * NWAVES * 64;
    for (int idx = gt; idx < 2 * (MLA_INP - MLA_IN) * DM / 8; idx += ngt) { const int l = idx / ((MLA_INP - MLA_IN) * DM / 8), r = idx % ((MLA_INP - MLA_IN) * DM / 8);
        *(v4u*)(WSP(bf16, WS_MWIN) + (size_t)l * MLA_INP * DM + (size_t)MLA_IN * DM + (size_t)r * 8) = (v4u){0u, 0u, 0u, 0u}; }
#if !P_STAGGER
    cast_p(P);
#endif
    { const int* positions = (const int*)kin(P, 2); float* cosd = WSP(float, WS_COSD); float* sind = WSP(float, WS_SIND); float* cosm = WSP(float, WS_COSM); float* sinm = WSP(float, WS_SINM);
      for (int idx = gt; idx < MT * 48; idx += ngt) { const int row = idx / 48, f = idx % 48; const int pos = positions[row];
        float c, s;
        if (f < 16) { rope_cs(pos, d_exp(-(double)(2 * f) / 32.0 * 13.122363377404328), c, s); cosd[row * 16 + f] = c; sind[row * 16 + f] = s; }
        else { const int f2 = f - 16; rope_cs(pos, d_exp(-(double)(2 * f2) / 64.0 * 13.122363377404328), c, s); cosm[row * 32 + f2] = c; sinm[row * 32 + f2] = s; } } }
    if (P.bx == 0 && wave == 0) { float* lamf = WSP(float, WS_LAM); const int lane = P.lane;
        for (int j = 0; j < 2; ++j) { const float* lm = kin(P, 14) + j * 4 * 128;
            const float s1 = wave_sum(lm[lane] * lm[128 + lane] + lm[64 + lane] * lm[192 + lane]), s2 = wave_sum(lm[256 + lane] * lm[384 + lane] + lm[320 + lane] * lm[448 + lane]);
            const double linit = (j == 0) ? 0.2 : 0.47071301834358416;
            if (lane == 0) lamf[j] = (float)(d_exp((double)s1) - d_exp((double)s2) + linit); }
        for (int j = 0; j < 2; ++j) { const float* gq = kin(P, 12) + j * 128; const float* gk = kin(P, 13) + j * 128; const float* mq = kin(P, 21) + j * 192; const float* mk = kin(P, 22) + j * 192;
            const float a = wave_max(fmaxf(fabsf(gq[lane]), fabsf(gq[64 + lane]))), b = wave_max(fmaxf(fabsf(gk[lane]), fabsf(gk[64 + lane])));
            const float an = wave_max(fmaxf(fabsf(mq[lane]), fabsf(mq[64 + lane]))), ar = wave_max(fabsf(mq[128 + lane])), bn = wave_max(fmaxf(fabsf(mk[lane]), fabsf(mk[64 + lane]))), br = wave_max(fabsf(mk[128 + lane]));
            const float Bd = 1.01f * (0.08838834764831845f * 1.4426950408889634f * 128.f) * a * b, Bm = 1.01f * (0.07216878364870323f * 1.4426950408889634f) * (128.f * an * bn + 64.f * ar * br);
            if (lane == 0) { lamf[4 + j] = Bd > 64.f ? Bd : 0.f; lamf[6 + j] = Bm > 64.f ? Bm : 0.f; } }
    }
    xb_rows(kin(P, 0), WSP(bf16, WS_HN), WSP(float, WS_SS), P.gw, P.ngw, P.lane);
}
__device__ __forceinline__ void ph_diff_win(LAS unsigned char* L, int j) { const Ph P = ph_begin();
    const pg8::RowScale rsc = rstd_table(WSP(float, WS_SS) + (size_t)(6 * j) * MT * 64, L, P, MT, DIFF_IN);
#if FUSE_KNORM_D
    GEMM_PHASE(SINGLE_ARG(pg8::EpiKN<1>), (pg8::EpiKN<1>{WSP(bf16, WS_Z), DIFF_IN, rsc, kin(P, 13) + j * 128, WSP(float, WS_COSD), WSP(float, WS_SIND), (LAS float*)(L + XT_OFF)}), WSP(bf16, WS_HN), WSP(bf16, WS_DWIN) + (size_t)j * DIFF_IN * DM, MT, DIFF_IN, DM); }
#else
    GEMM_PHASE(SINGLE_ARG(pg8::EpiBf16<0, true>), (pg8::EpiBf16<0, true>{WSP(bf16, WS_Z), DIFF_IN, rsc}), WSP(bf16, WS_HN), WSP(bf16, WS_DWIN) + (size_t)j * DIFF_IN * DM, MT, DIFF_IN, DM); }
#endif
__device__ __forceinline__ void ph_diff_qknorm(int j) { const Ph P = ph_begin();
    diff_k_norm_rope(WSP(bf16, WS_Z), kin(P, 13) + j * 128, WSP(float, WS_COSD), WSP(float, WS_SIND), P.gw, P.ngw, P.lane); }
__device__ __forceinline__ void ph_diff_attn(char* lds, LAS unsigned char* L, int conv_layer, int j) {
#ifndef SKIP_ATTD
    const Ph P = ph_begin(); int ui = 0; const bf16* Z = WSP(bf16, WS_Z); bf16* OPART = WSP(bf16, WS_OPART);
#if DIFF_WIDE
    static_assert(3 * att::SHM_K + 3 * 2 * att::SHM_V <= SCR_BYTES, "dma3d LDS map");
    const int wave_ = __builtin_amdgcn_readfirstlane(P.tid >> 6);
    for (int pi = P.vcu; pi < 512; pi += P.G) {
        const int qb = pi & 15, h = (pi >> 4) & 15, b = pi >> 8;
        const bf16* Zb = Z + (size_t)(b * SEQ) * DIFF_IN;
#pragma nounroll
        for (int c = 0; c < 2; ++c) {
            att::attn_unit_dma3d<DiffCfg>(Zb + (size_t)(qb * 256) * DIFF_IN + (h * 2 + c) * 128, Zb + 4096 + (h * 2 + c) * 128, Zb + 8192 + h * 256,
                                          OPART + (size_t)c * MT * DM + (size_t)(b * SEQ + qb * 256) * DM + h * 256, SEQ, lds, (LAS unsigned char*)lds,
                                          att::QNorm{kin(P, 12) + j * 128, WSP(float, WS_COSD) + (size_t)(b * SEQ + qb * 256) * 16, WSP(float, WS_SIND) + (size_t)(b * SEQ + qb * 256) * 16, WSP(float, WS_LAM)[4 + j]});
            if (STAGGER_CONV && conv_layer >= 0 && ui == (P.vcu & 3)) { __syncthreads(); if (conv_layer == 1) { convert_layer(P, L, 0, 2); if (P_STAGGER) cast_p(P); } convert_layer(P, L, conv_layer); __syncthreads(); }
            ++ui;
        }
        VM_WAIT(); __syncthreads();
#pragma nounroll
        for (int hf = 0; hf < 2; ++hf)
            diff_combine_pair(OPART, (size_t)(b * SEQ + qb * 256 + hf * 128), h, WSP(float, WS_LAM) + j, kin(P, 15) + j * 256, (j == 0) ? 0.8f : (float)(1.0 - 0.47071301834358416), WSP(bf16, WS_OB), wave_, P.lane);
    }
#elif DIFF_PA && DIFF_PAD == 2 && FUSE_COMBINE
    static_assert(att::Pa2Map<DiffCfg>::BYTES <= SCR_BYTES, "pa2 LDS map");
    const int wave_ = __builtin_amdgcn_readfirstlane(P.tid >> 6);
    for (int pi = P.vcu; pi < 1024; pi += P.G) {
        const int qb = pi & 31, h = (pi >> 5) & 15, b = pi >> 9;
        const bf16* Zb = Z + (size_t)(b * SEQ) * DIFF_IN;
#pragma nounroll
        for (int c = 0; c < 2; ++c) {
#if DIFF_MFMA16
            att::attn_unit_pa3<DiffCfg>(Zb + (size_t)(qb * 128) * DIFF_IN + (h * 2 + c) * 128, Zb + 4096 + (h * 2 + c) * 128, Zb + 8192 + h * 256,
                                        OPART + (size_t)c * MT * DM + (size_t)(b * SEQ + qb * 128) * DM + h * 256, SEQ, lds, (LAS unsigned char*)lds,
                                        att::QNorm{kin(P, 12) + j * 128, WSP(float, WS_COSD) + (size_t)(b * SEQ + qb * 128) * 16, WSP(float, WS_SIND) + (size_t)(b * SEQ + qb * 128) * 16, WSP(float, WS_LAM)[4 + j]});
#else
            att::attn_unit_pa2<DiffCfg>(Zb + (size_t)(qb * 128) * DIFF_IN + (h * 2 + c) * 128, Zb + 4096 + (h * 2 + c) * 128, Zb + 8192 + h * 256, nullptr, nullptr,
                                        OPART + (size_t)c * MT * DM + (size_t)(b * SEQ + qb * 128) * DM + h * 256, SEQ, lds, (LAS unsigned char*)lds,
                                        att::QNorm{kin(P, 12) + j * 128, WSP(float, WS_COSD) + (size_t)(b * SEQ + qb * 128) * 16, WSP(float, WS_SIND) + (size_t)(b * SEQ + qb * 128) * 16, WSP(float, WS_LAM)[4 + j]});
#endif
            if (STAGGER_CONV && conv_layer >= 0 && ui == (P.vcu & 7)) { __syncthreads(); if (conv_layer == 1) convert_layer(P, L, 0, 2); convert_layer(P, L, conv_layer); __syncthreads(); }
            ++ui;
        }
        VM_WAIT(); __syncthreads();
        diff_combine_pair(OPART, (size_t)(b * SEQ + qb * 128), h, WSP(float, WS_LAM) + j, kin(P, 15) + j * 256, (j == 0) ? 0.8f : (float)(1.0 - 0.47071301834358416), WSP(bf16, WS_OB), wave_, P.lane);
    }
#elif DIFF_PA
    for (int u = P.vcu; u < 2048; u += P.G) {
        const int qb = u & 31, c = (u >> 5) & 1, h = (u >> 6) & 15, b = u >> 10;
        const bf16* Zb = Z + (size_t)(b * SEQ) * DIFF_IN;
#if DIFF_PAD == 2
        static_assert(att::Pa2Map<DiffCfg>::BYTES <= SCR_BYTES, "pa2 LDS map");
        att::attn_unit_pa2<DiffCfg>(Zb + (size_t)(qb * 128) * DIFF_IN + (h * 2 + c) * 128, Zb + 4096 + (h * 2 + c) * 128, Zb + 8192 + h * 256, nullptr, nullptr,
                                    OPART + (size_t)c * MT * DM + (size_t)(b * SEQ + qb * 128) * DM + h * 256, SEQ, lds, (LAS unsigned char*)lds,
                                    att::QNorm{kin(P, 12) + j * 128, WSP(float, WS_COSD) + (size_t)(b * SEQ + qb * 128) * 16, WSP(float, WS_SIND) + (size_t)(b * SEQ + qb * 128) * 16, WSP(float, WS_LAM)[4 + j]});
        if (STAGGER_CONV && conv_layer >= 0 && ui == (P.vcu & 7)) { __syncthreads(); if (conv_layer == 1) convert_layer(P, L, 0, 2); convert_layer(P, L, conv_layer); __syncthreads(); }
#ifdef PROBE_CONVX2
        if (STAGGER_CONV && conv_layer >= 0 && ui == ((P.vcu + 4) & 7)) { __syncthreads(); convert_layer(P, L, conv_layer); __syncthreads(); }
#endif
        ++ui;
#elif DIFF_PAD
        att::attn_unit_pad<DiffCfg>(Zb + (size_t)(qb * 128) * DIFF_IN + (h * 2 + c) * 128, Zb + 4096 + (h * 2 + c) * 128, Zb + 8192 + h * 256,
                                    OPART + (size_t)c * MT * DM + (size_t)(b * SEQ + qb * 128) * DM + h * 256, SEQ, lds, (LAS unsigned char*)lds);
#else
        att::attn_unit_pa<DiffCfg>(Zb + (size_t)(qb * 128) * DIFF_IN + (h * 2 + c) * 128, Zb + 4096 + (h * 2 + c) * 128, Zb + 8192 + h * 256, nullptr, nullptr,
                                   OPART + (size_t)c * MT * DM + (size_t)(b * SEQ + qb * 128) * DM + h * 256, SEQ, lds);
#endif
    }
#else
    for (int u = P.vcu; u < 2048; u += P.G) {
        const int qb = u & 15, e = (u >> 4) & 1, c = (u >> 5) & 1, h = (u >> 6) & 15, b = u >> 10;
        const bf16* Zb = Z + (size_t)(b * SEQ) * DIFF_IN;
#if ATT_DMA
        att::attn_unit_dma<DiffCfg>(Zb + (size_t)(qb * 256) * DIFF_IN + (h * 2 + c) * 128, Zb + 4096 + (h * 2 + c) * 128, Zb + 8192 + h * 256 + e * 128, nullptr, nullptr,
                                OPART + (size_t)c * MT * DM + (size_t)(b * SEQ + qb * 256) * DM + h * 256 + e * 128, SEQ, lds, (LAS unsigned char*)lds,
                                att::QNorm{kin(P, 12) + j * 128, WSP(float, WS_COSD) + (size_t)(b * SEQ + qb * 256) * 16, WSP(float, WS_SIND) + (size_t)(b * SEQ + qb * 256) * 16});
#else
        att::attn_unit<DiffCfg>(Zb + (size_t)(qb * 256) * DIFF_IN + (h * 2 + c) * 128, Zb + 4096 + (h * 2 + c) * 128, Zb + 8192 + h * 256 + e * 128, nullptr, nullptr,
                                OPART + (size_t)c * MT * DM + (size_t)(b * SEQ + qb * 256) * DM + h * 256 + e * 128, SEQ, lds);
#endif
    }
#endif
#endif
}
__device__ __forceinline__ void ph_diff_combine(int j) { const Ph P = ph_begin();
    diff_combine(WSP(bf16, WS_OPART), WSP(float, WS_LAM) + j, kin(P, 15) + j * 256, (j == 0) ? 0.8f : (float)(1.0 - 0.47071301834358416), WSP(bf16, WS_OB), P.gw, P.ngw, P.lane); }
__device__ __forceinline__ void ph_wout(LAS unsigned char* L, size_t wofs, int i, bool f8 = false) { const Ph P = ph_begin();
#if RES_BF16
    if (f8) { GEMM_PHASE_F8(pg8::EpiResB, (pg8::EpiResB{WSP(bf16, WS_HN), WSP(bf16, WS_HN), DM, WSP(float, WS_SS) + (size_t)(3 * i + 1) * MT * 64, nullptr, 1.f / 2048.f}), P.ws + WS_OB8, P.ws + wofs, MT, DM, DM / 2); }
    else { GEMM_PHASE(pg8::EpiResB, (pg8::EpiResB{WSP(bf16, WS_HN), WSP(bf16, WS_HN), DM, WSP(float, WS_SS) + (size_t)(3 * i + 1) * MT * 64, nullptr, 1.f}), WSP(bf16, WS_OB), (bf16*)(P.ws + wofs), MT, DM, DM); } }
#else
    GEMM_PHASE(pg8::EpiRes, (pg8::EpiRes{i == 0 ? kin(P, 0) : (const float*)P.X, P.X, DM, WSP(bf16, WS_HN), WSP(float, WS_SS) + (size_t)(3 * i + 1) * MT * 64}), WSP(bf16, WS_OB), (bf16*)(P.ws + wofs), MT, DM, DM); }
#endif
__device__ __forceinline__ void ph_mla_win(LAS unsigned char* L, int j) { const Ph P = ph_begin();
    const pg8::RowScale rsc = rstd_table(WSP(float, WS_SS) + (size_t)(6 * j + 3) * MT * 64, L, P, MT, MLA_INP);
    GEMM_PHASE(pg8::EpiF32, (pg8::EpiF32{WSP(float, WS_ZM), MLA_INP, rsc}), WSP(bf16, WS_HN), WSP(bf16, WS_MWIN) + (size_t)j * MLA_INP * DM, MT, MLA_INP, DM); }
__device__ __forceinline__ void ph_mla_norm1(int j) { const Ph P = ph_begin();
    mla_norm1(WSP(float, WS_ZM), kin(P, 17) + j * MLA_QR, kin(P, 18) + j * MLA_KVR, kin(P, 22) + j * 192, WSP(float, WS_COSM), WSP(float, WS_SINM), WSP(bf16, WS_CQN), WSP(bf16, WS_CKVN), WSP(bf16, WS_KR), P.gw, P.ngw, P.lane); }
__device__ __forceinline__ void ph_mla_uq(LAS unsigned char* L, int j) { const Ph P = ph_begin();
    GEMM_PHASE(SINGLE_ARG(pg8::EpiBf16<0, false>), (pg8::EpiBf16<0, false>{WSP(bf16, WS_QM), MLA_Q, pg8::RowScale{}}), WSP(bf16, WS_CQN), WSP(bf16, WS_MWUQ) + (size_t)j * MLA_Q * MLA_QR, MT, MLA_Q, MLA_QR); }
__device__ __forceinline__ void ph_mla_ukv(LAS unsigned char* L, int j) { const Ph P = ph_begin();
#if FUSE_KNORM_M
    GEMM_PHASE(SINGLE_ARG(pg8::EpiKN<0>), (pg8::EpiKN<0>{WSP(bf16, WS_KVM), MLA_KV, pg8::RowScale{}, kin(P, 22) + j * 192, nullptr, nullptr, (LAS float*)(L + XT_OFF)}), WSP(bf16, WS_CKVN), WSP(bf16, WS_MWUKV) + (size_t)j * MLA_KV * MLA_KVR, MT, MLA_KV, MLA_KVR); }
#else
    GEMM_PHASE(SINGLE_ARG(pg8::EpiBf16<0, false>), (pg8::EpiBf16<0, false>{WSP(bf16, WS_KVM), MLA_KV, pg8::RowScale{}}), WSP(bf16, WS_CKVN), WSP(bf16, WS_MWUKV) + (size_t)j * MLA_KV * MLA_KVR, MT, MLA_KV, MLA_KVR); }
#endif
__device__ __forceinline__ void ph_mla_norm2(int j) { const Ph P = ph_begin();
    mla_norm2(WSP(bf16, WS_KVM), kin(P, 22) + j * 192, P.gw, P.ngw, P.lane); }
__device__ __forceinline__ void ph_mla_attn(char* lds, LAS unsigned char* L, int conv_layer, int j) {
#ifndef SKIP_ATTM
    const Ph P = ph_begin(); int ui = 0; const bf16* QMB = WSP(bf16, WS_QM); const bf16* KVMB = WSP(bf16, WS_KVM); const bf16* KRB = WSP(bf16, WS_KR); bf16* OBB = WSP(bf16, WS_OB);
#if MLA_PA
    for (int u = P.vcu; u < 2048; u += P.G) {
        const int qb = u & 31, h = (u >> 5) & 31, b = u >> 10;
        const bf16* Qp = QMB + (size_t)(b * SEQ + qb * 128) * MLA_Q + h * 192; const bf16* Kp = KVMB + (size_t)(b * SEQ) * MLA_KV + h * 256;
#if MLA_PA == 2
        static_assert(att::Pa2Map<MlaCfg>::BYTES <= SCR_BYTES, "pa2 LDS map");
        att::attn_unit_pa2<MlaCfg>(Qp, Kp, Kp + 128, Qp + 128, KRB + (size_t)(b * SEQ) * 64, OBB + (size_t)(b * SEQ + qb * 128) * DM + h * 128, SEQ, lds, (LAS unsigned char*)lds, att::QNorm{kin(P, 21) + j * 192, WSP(float, WS_COSM) + (size_t)(b * SEQ + qb * 128) * 32, WSP(float, WS_SINM) + (size_t)(b * SEQ + qb * 128) * 32});
#else
        att::attn_unit_pa<MlaCfg>(Qp, Kp, Kp + 128, Qp + 128, KRB + (size_t)(b * SEQ) * 64, OBB + (size_t)(b * SEQ + qb * 128) * DM + h * 128, SEQ, lds);
#endif
    }
#else
    for (int u = P.vcu; u < 1024; u += P.G) {
        const int qb = u & 15, h = (u >> 4) & 31, b = u >> 9;
        const bf16* Qp = QMB + (size_t)(b * SEQ + qb * 256) * MLA_Q + h * 192; const bf16* Kp = KVMB + (size_t)(b * SEQ) * MLA_KV + h * 256;
#if ATT_DMA
        att::MLA_BODY<MlaCfg>(Qp, Kp, Kp + 128, Qp + 128, KRB + (size_t)(b * SEQ) * 64, OBB + (size_t)(b * SEQ + qb * 256) * DM + h * 128, SEQ, lds, (LAS unsigned char*)lds,
                                   att::QNorm{kin(P, 21) + j * 192, WSP(float, WS_COSM) + (size_t)(b * SEQ + qb * 256) * 32, WSP(float, WS_SINM) + (size_t)(b * SEQ + qb * 256) * 32, WSP(float, WS_LAM)[6 + j]},
                                   (MLA_F8 && MLA_MFMA16) ? P.ws + WS_OB8 + (size_t)(b * SEQ + qb * 256) * DM + h * 128 : (unsigned char*)nullptr);
        if (STAGGER_CONV && conv_layer >= 0 && ui == (P.vcu & 3)) { __syncthreads(); convert_layer(P, L, conv_layer); __syncthreads(); }
        ++ui;
#else
        att::attn_unit<MlaCfg>(Qp, Kp, Kp + 128, Qp + 128, KRB + (size_t)(b * SEQ) * 64, OBB + (size_t)(b * SEQ + qb * 256) * DM + h * 128, SEQ, lds);
#endif
    }
#endif
#endif
}
__device__ __forceinline__ void ph_ple(LAS unsigned char* L, int i) { const Ph P = ph_begin();
    GEMM_PHASE(SINGLE_ARG(pg8::EpiBf16<0, false>), (pg8::EpiBf16<0, false>{WSP(bf16, WS_PLE), DM, pg8::RowScale{}}), WSP(bf16, WS_PB) + (size_t)i * MT * PLED, WSP(bf16, WS_WPT) + (size_t)i * DM * PLED, MT, DM, PLED); }
__device__ __forceinline__ void ph_w1(LAS unsigned char* L, int i) { const Ph P = ph_begin();
    const pg8::RowScale rsc = rstd_table(WSP(float, WS_SS) + (size_t)(3 * i + 1) * MT * 64, L, P, MT, FF);
    GEMM_PHASE(SINGLE_ARG(pg8::EpiBf16<1, true>), (pg8::EpiBf16<1, true>{WSP(bf16, WS_ACT), FF, rsc}), WSP(bf16, WS_HN), WSP(bf16, WS_W1T) + (size_t)i * FF * DM, MT, FF, DM); }
__device__ __forceinline__ void ph_w2(LAS unsigned char* L, int i) { const Ph P = ph_begin();
#if RES_BF16
    GEMM_PHASE(pg8::EpiResB, (pg8::EpiResB{WSP(bf16, WS_HN), WSP(bf16, WS_XB1), DM, WSP(float, WS_SS) + (size_t)(3 * i + 2) * MT * 64, GATE_F8 ? (unsigned char*)(P.ws + WS_X8) : (unsigned char*)nullptr, 1.f}), WSP(bf16, WS_ACT), WSP(bf16, WS_W2T) + (size_t)i * DM * FF, MT, DM, FF); }
#else
    GEMM_PHASE(pg8::EpiRes, (pg8::EpiRes{P.X, P.X, DM, WSP(bf16, WS_XB1), WSP(float, WS_SS) + (size_t)(3 * i + 2) * MT * 64}), WSP(bf16, WS_ACT), WSP(bf16, WS_W2T) + (size_t)i * DM * FF, MT, DM, FF); }
#endif
__device__ __forceinline__ void ph_gate(LAS unsigned char* L, int i) { const Ph P = ph_begin();
    const pg8::RowScale rsc = rstd_table(WSP(float, WS_SS) + (size_t)(3 * i + 2) * MT * 64, L, P, MT, DM);
#if RES_BF16
#if GATE_F8
    if (i == DEPTH - 1) { GEMM_PHASE_F8(SINGLE_ARG(pg8::EpiGateB<true>), (pg8::EpiGateB<true>{WSP(bf16, WS_XB1), WSP(bf16, WS_PLE), DM, rsc, nullptr, nullptr, P.X, 0.0078125f}), P.ws + WS_X8, P.ws + WS_WGT + (size_t)i * DM * DM, MT, DM, DM / 2); }
    else { GEMM_PHASE_F8(SINGLE_ARG(pg8::EpiGateB<false>), (pg8::EpiGateB<false>{WSP(bf16, WS_XB1), WSP(bf16, WS_PLE), DM, rsc, WSP(bf16, WS_HN), WSP(float, WS_SS) + (size_t)(3 * i + 3) * MT * 64, nullptr, 0.0078125f}), P.ws + WS_X8, P.ws + WS_WGT + (size_t)i * DM * DM, MT, DM, DM / 2); } }
#else
    if (i == DEPTH - 1) { GEMM_PHASE(SINGLE_ARG(pg8::EpiGateB<true>), (pg8::EpiGateB<true>{WSP(bf16, WS_XB1), WSP(bf16, WS_PLE), DM, rsc, nullptr, nullptr, P.X, 1.f}), WSP(bf16, WS_XB1), WSP(bf16, WS_WGT) + (size_t)i * DM * DM, MT, DM, DM); }
    else { GEMM_PHASE(SINGLE_ARG(pg8::EpiGateB<false>), (pg8::EpiGateB<false>{WSP(bf16, WS_XB1), WSP(bf16, WS_PLE), DM, rsc, WSP(bf16, WS_HN), WSP(float, WS_SS) + (size_t)(3 * i + 3) * MT * 64, nullptr, 1.f}), WSP(bf16, WS_XB1), WSP(bf16, WS_WGT) + (size_t)i * DM * DM, MT, DM, DM); } }
#endif
#else
    GEMM_PHASE(pg8::EpiGate, (pg8::EpiGate{P.X, P.X, WSP(bf16, WS_PLE), DM, rsc, WSP(bf16, WS_HN), WSP(float, WS_SS) + (size_t)(3 * i + 3) * MT * 64}), WSP(bf16, WS_XB1), WSP(bf16, WS_WGT) + (size_t)i * DM * DM, MT, DM, DM); }
#endif

__device__ __forceinline__ void ph_dummy(LAS unsigned char* L, size_t aofs, size_t bofs, int N, int K) { const Ph P = ph_begin();
    GEMM_PHASE(SINGLE_ARG(pg8::EpiBf16<0, false>), (pg8::EpiBf16<0, false>{WSP(bf16, WS_OPART), N, pg8::RowScale{}}), (bf16*)(P.ws + aofs), (bf16*)(P.ws + bofs), MT, N, K); }
__device__ __forceinline__ void ph_dummy_res(LAS unsigned char* L, size_t aofs, size_t bofs, int K) { const Ph P = ph_begin();
    GEMM_PHASE(pg8::EpiRes, (pg8::EpiRes{P.X, WSP(float, WS_OPART), DM, WSP(bf16, WS_OPART + 128 * MiB), WSP(float, WS_Z)}), (bf16*)(P.ws + aofs), (bf16*)(P.ws + bofs), MT, DM, K); }
__device__ __forceinline__ void ph_dummy_gate(LAS unsigned char* L, int i) { const Ph P = ph_begin();
    const pg8::RowScale rsc = rstd_table(WSP(float, WS_SS) + (size_t)(3 * i + 2) * MT * 64, L, P, MT, DM);
    GEMM_PHASE(pg8::EpiGate, (pg8::EpiGate{P.X, WSP(float, WS_OPART), WSP(bf16, WS_PLE), DM, rsc, WSP(bf16, WS_OPART + 128 * MiB), WSP(float, WS_Z)}), WSP(bf16, WS_XB1), WSP(bf16, WS_WGT) + (size_t)i * DM * DM, MT, DM, DM); }
__device__ __forceinline__ void mlp_part(const int i, LAS unsigned char* L, const XcdBarrier& bar) {
#ifdef PROBE_W2COLD
    ph_dummy(L, WS_ACT, WS_W2T + (size_t)((i + 2) & 3) * DM * FF * 2, DM, FF); XBAR(bar);
#endif
    ph_ple(L, i); ph_w1(L, i); XBAR(bar);
#ifdef PROBE_W1X2
    ph_w1(L, i); XBAR(bar);
#endif
    ph_w2(L, i); XBAR(bar);
#ifdef PROBE_RESD
    ph_dummy_res(L, WS_ACT, WS_W2T + (size_t)i * DM * FF * 2, FF); XBAR(bar);
#endif
#ifdef PROBE_RES4D
    ph_dummy_res(L, WS_OB, WS_DWOUT, DM); XBAR(bar);
#endif
#ifdef PROBE_GATED
    ph_dummy_gate(L, i); XBAR(bar);
#endif
#ifdef PROBE_W2D
    ph_dummy(L, WS_ACT, WS_W2T + (size_t)i * DM * FF * 2, DM, FF); XBAR(bar);
#endif
#ifdef PROBE_SQD
    ph_dummy(L, WS_HN, WS_WGT + (size_t)i * DM * DM * 2, DM, DM); XBAR(bar);
#endif
#ifdef PROBE_PLED
    ph_dummy(L, WS_PB + (size_t)i * MT * PLED * 2, WS_WPT + (size_t)i * DM * PLED * 2, DM, PLED); XBAR(bar);
#endif
    ph_gate(L, i); XBAR(bar);
}

__global__ void __launch_bounds__(NWAVES * 64, 2) mega_fwd(Args a) {
    extern __shared__ __attribute__((aligned(16))) unsigned char lds[];
    LAS unsigned char* L = (LAS unsigned char*)lds;
    volatile LAS unsigned* MISC = (volatile LAS unsigned*)(L + MISC_OFF);
    for (int u = threadIdx.x; u < (LDS_BYTES - LDSCTL_OFF) / 4; u += NWAVES * 64) ((LAS unsigned*)(L + LDSCTL_OFF))[u] = 0u;
    __syncthreads();
    static_assert(TIDTAB_LDS_OFF == LDSCTL_OFF + 2048 && TIDTAB_LDS_OFF + 256 <= LDS_BYTES, "tid table");
    if ((threadIdx.x & 63) == 0) *(volatile LAS int*)(L + TIDTAB_LDS_OFF + 4 * hw_slot()) = (int)(threadIdx.x >> 6);
    __syncthreads();
    XcdBarrier bar = xcd_barrier_post((unsigned*)(a.ws + WS_CTL) + CW_BAR, MISC + 8);
    bar.x = (unsigned)__builtin_amdgcn_readfirstlane((int)bar.x);

    ph_prologue(L);
#ifdef PROBE_P0X2
    XBAR(bar); ph_prologue(L);
#endif
    XBAR(bar);
    for (int j = 0; j < 2; ++j) {
        ph_diff_win(L, j); XBAR(bar);
#ifdef PROBE_DWINX2
        ph_diff_win(L, j); XBAR(bar);
#endif
#if !FUSE_KNORM_D
        ph_diff_qknorm(j); XBAR(bar);
#endif
        ph_diff_attn((char*)lds, L, 2 * j + 1, j); XBAR(bar);
#ifdef PROBE_ATTDX2
        ph_diff_attn((char*)lds, L, -1, j); XBAR(bar);
#endif
#if !(DIFF_WIDE || (DIFF_PA && DIFF_PAD == 2 && FUSE_COMBINE))
        ph_diff_combine(j); XBAR(bar);
#endif
#ifdef PROBE_COMBX2
        ph_diff_combine(j); XBAR(bar);
#endif
        ph_wout(L, WS_DWOUT + (size_t)j * DM * DM * 2, 2 * j); XBAR(bar);
        mlp_part(2 * j, L, bar);
        ph_mla_win(L, j); XBAR(bar);
#ifdef PROBE_MWINX2
        ph_mla_win(L, j); XBAR(bar);
#endif
        ph_mla_norm1(j); XBAR(bar);
#ifdef PROBE_N1X2
        ph_mla_norm1(j); XBAR(bar);
#endif
        ph_mla_uq(L, j); ph_mla_ukv(L, j); XBAR(bar);
#ifdef PROBE_UQKVX2
        ph_mla_uq(L, j); ph_mla_ukv(L, j); XBAR(bar);
#endif
#if !FUSE_KNORM_M
        ph_mla_norm2(j); XBAR(bar);
#endif
        ph_mla_attn((char*)lds, L, j == 0 ? 2 : -1, j); XBAR(bar);
#ifdef PROBE_ATTMX2
        ph_mla_attn((char*)lds, L, -1, j); XBAR(bar);
#endif
        ph_wout(L, MLA_F8 ? WS_MWOUT + (size_t)j * DM * DM : WS_MWOUT + (size_t)j * DM * DM * 2, 2 * j + 1, MLA_F8); XBAR(bar);
        mlp_part(2 * j + 1, L, bar);
    }
}

extern "C" void kernel_launch(void* const* d_in, const int* in_sizes, int n_in, void* d_out, int out_size, void* d_ws, size_t ws_size, hipStream_t stream) {
    static int grid = 0;
    if (grid == 0) {
        if (n_in != 24 || in_sizes[0] != MT * DM || out_size != MT * DM || ws_size < WS_END) { fprintf(stderr, "kernel_launch: shape mismatch: n_in %d in0 %d out %d ws %zu (need %zu)\n", n_in, n_in > 0 ? in_sizes[0] : -1, out_size, ws_size, (size_t)WS_END); grid = -1; return; }
        int dev = 0, cus = 0, per_cu = 0;
        if (hipGetDevice(&dev) != hipSuccess || hipDeviceGetAttribute(&cus, hipDeviceAttributeMultiprocessorCount, dev) != hipSuccess) { fprintf(stderr, "kernel_launch: device query failed\n"); grid = -1; return; }
        if (hipFuncSetAttribute((const void*)mega_fwd, hipFuncAttributeMaxDynamicSharedMemorySize, LDS_BYTES) != hipSuccess) { fprintf(stderr, "kernel_launch: hipFuncSetAttribute failed\n"); grid = -1; return; }
        if (hipOccupancyMaxActiveBlocksPerMultiprocessor(&per_cu, (const void*)mega_fwd, NWAVES * 64, LDS_BYTES) != hipSuccess || per_cu < 1) fprintf(stderr, "kernel_launch: note: occupancy query reports %d workgroups per CU\n", per_cu);
        (void)hipGetLastError();
        grid = cus;
    }
    if (grid < 0) return;
    if (hipMemsetAsync((char*)d_ws + WS_CTL, 0, CTL_ZERO_BYTES, stream) != hipSuccess) { fprintf(stderr, "kernel_launch: memset failed\n"); return; }
    Args a{};
    for (int i = 0; i < 24; ++i) a.in[i] = d_in[i];
    a.out = (float*)d_out; a.ws = (unsigned char*)d_ws;
    hipLaunchKernelGGL(mega_fwd, dim3(grid), dim3(NWAVES * 64), LDS_BYTES, stream, a);
    const hipError_t le = hipPeekAtLastError();
    if (le != hipSuccess) fprintf(stderr, "kernel_launch: launch failed: %s\n", hipGetErrorName(le));
}
```
